# Optimizing an MI355X kernel written in HIP

```python
import jax, jax.numpy as jnp
from jax import lax
import numpy as np

D_MODEL = 1024
BATCH = 2
SEQ = 8192
DEPTH = 1

EPS = 1e-6
N_HEADS_ATT = 8
N_KV_HEADS = 2
HEAD_DIM_ATT = 64
GROUP_SIZE = N_HEADS_ATT // N_KV_HEADS
WINDOW = 128
BLOCK = 128
N_HEADS_M = 4
HEAD_DIM_M = 128
CHUNK = 128
CONV_WIDTH = 3
ATT_Q = N_HEADS_ATT * HEAD_DIM_ATT
ATT_KV = N_KV_HEADS * HEAD_DIM_ATT
M_W = N_HEADS_M * HEAD_DIM_M
MIX_WIDTH = ATT_Q + M_W
N_GATES = 4 * N_HEADS_M
IN_SIZES = [ATT_Q, ATT_KV, ATT_KV, M_W, M_W, M_W, M_W, N_GATES]
IN_COLS = int(sum(IN_SIZES))
IN_SPLITS = [int(s) for s in np.cumsum(IN_SIZES)[:-1]]
D_FF = ((8 * D_MODEL // 3 + 255) // 256) * 256
N_MOD = 6

kernel_name = "hymba_style_attn_mlstm_encoder_layer"


def rms_norm(x, g):
    xf = x.astype(jnp.float32)
    out = xf * lax.rsqrt(jnp.mean(xf * xf, axis=-1, keepdims=True) + EPS)
    return (out * g.astype(jnp.float32)).astype(x.dtype)


def centred_dwconv(u, w, b):
    k = w.shape[0]
    pad = k // 2
    s = u.shape[1]
    up = jnp.pad(u, ((0, 0), (pad, pad), (0, 0)))
    out = up[:, 0:s] * w[0]
    for j in range(1, k):
        out = out + up[:, j:j + s] * w[j]
    return out + b


def banded_attention(q, k, v, sink):
    b, s, _, hd = q.shape
    nb = s // BLOCK
    qb = q.astype(jnp.float32).reshape(b, nb, BLOCK, N_KV_HEADS, GROUP_SIZE, hd)

    def key_blocks(t):
        tp = jnp.pad(t.astype(jnp.float32), ((0, 0), (BLOCK, BLOCK), (0, 0), (0, 0)))
        tp = tp.reshape(b, nb + 2, BLOCK, N_KV_HEADS, hd)
        return jnp.concatenate([tp[:, :-2], tp[:, 1:-1], tp[:, 2:]], axis=2)

    kb = key_blocks(k)
    vb = key_blocks(v)
    scores = jnp.einsum('bnqkgd,bnskd->bnkgqs', qb, kb) * (hd ** -0.5)
    qpos = jnp.arange(nb)[:, None] * BLOCK + jnp.arange(BLOCK)[None, :]
    kpos = jnp.arange(nb)[:, None] * BLOCK - BLOCK + jnp.arange(3 * BLOCK)[None]
    dist = jnp.abs(kpos[:, None, :] - qpos[:, :, None])
    valid = (dist <= WINDOW) & (kpos >= 0)[:, None, :] & (kpos < s)[:, None, :]
    slopes = 2.0 ** (-8.0 * (jnp.arange(N_HEADS_ATT, dtype=jnp.float32) + 1.0) / N_HEADS_ATT)
    slopes = slopes.reshape(N_KV_HEADS, GROUP_SIZE)
    logits = scores - slopes[None, None, :, :, None, None] * dist[None, :, None, None].astype(jnp.float32)
    logits = jnp.where(valid[None, :, None, None], logits, -jnp.inf)
    sink_l = sink.astype(jnp.float32).reshape(N_KV_HEADS, GROUP_SIZE)[None, None, :, :, None]
    mx = jnp.maximum(jnp.max(logits, axis=-1), sink_l)
    p = jnp.exp(logits - mx[..., None])
    den = jnp.sum(p, axis=-1) + jnp.exp(sink_l - mx)
    p = p / den[..., None]
    out = jnp.einsum('bnkgqs,bnskd->bnqkgd', p, vb)
    return out.reshape(b, s, N_HEADS_ATT * hd)


def mlstm_chunkwise(q, k, v, i_pre, f_pre):
    b, s, h, d = q.shape
    nc = s // CHUNK

    def blocks(t):
        t = t.reshape((b, nc, CHUNK, h) + t.shape[3:])
        return jnp.moveaxis(t, 3, 2)

    qc = blocks(q) * (d ** -0.5)
    kc = blocks(k)
    vc = blocks(v)
    ig = blocks(i_pre)
    logf = blocks(jax.nn.log_sigmoid(f_pre))
    bcum = jnp.cumsum(logf, axis=-1)
    b_last = bcum[..., -1]
    a = b_last[..., None] - bcum + ig
    a_max = jnp.max(a, axis=-1)
    w = jnp.exp(a - a_max[..., None])
    kv_c = jnp.einsum('bchs,bchsk,bchsv->bchkv', w, kc, vc)
    n_c = jnp.einsum('bchs,bchsk->bchk', w, kc)

    def step(carry, inp):
        c_st, n_st, m_st = carry
        bl, am, kv, nn = inp
        m_new = jnp.maximum(bl + m_st, am)
        decay = jnp.exp(bl + m_st - m_new)
        inj = jnp.exp(am - m_new)
        c_new = decay[..., None, None] * c_st + inj[..., None, None] * kv
        n_new = decay[..., None] * n_st + inj[..., None] * nn
        return (c_new, n_new, m_new), (c_st, n_st, m_st)

    init = (jnp.zeros((b, h, d, d), jnp.float32),
            jnp.zeros((b, h, d), jnp.float32),
            jnp.zeros((b, h), jnp.float32))
    xs = (jnp.moveaxis(b_last, 1, 0), jnp.moveaxis(a_max, 1, 0),
          jnp.moveaxis(kv_c, 1, 0), jnp.moveaxis(n_c, 1, 0))
    _, (c_prev, n_prev, m_prev) = lax.scan(step, init, xs)
    c_prev = jnp.moveaxis(c_prev, 0, 1)
    n_prev = jnp.moveaxis(n_prev, 0, 1)
    m_prev = jnp.moveaxis(m_prev, 0, 1)

    tril = jnp.tril(jnp.ones((CHUNK, CHUNK), dtype=bool))
    dlog = bcum[..., :, None] - bcum[..., None, :] + ig[..., None, :]
    dlog = jnp.where(tril, dlog, -jnp.inf)
    g = bcum + m_prev[..., None]
    m_t = jnp.maximum(g, jnp.max(dlog, axis=-1))
    dw = jnp.exp(dlog - m_t[..., None])
    sc = jnp.einsum('bchtd,bchsd->bchts', qc, kc) * dw
    inter = jnp.exp(g - m_t)
    num = (jnp.einsum('bchts,bchsv->bchtv', sc, vc)
           + inter[..., None] * jnp.einsum('bchtk,bchkv->bchtv', qc, c_prev))
    den = jnp.sum(sc, axis=-1) + inter * jnp.einsum('bchtk,bchk->bcht', qc, n_prev)
    hout = num / jnp.maximum(jnp.abs(den), jnp.exp(-m_t))[..., None]
    return jnp.moveaxis(hout, 2, 3).reshape(b, s, h, d)


def hybrid_layer(x, c, w_mod, b_mod, g_norm1, w_in, conv_w, conv_b, b_gates, sink,
                 g_attn_out, g_mlstm_out, w_out, g_norm2, w_ffn_in, w_ffn_out):
    b, s, _ = x.shape
    mod = jax.nn.silu(c) @ w_mod + b_mod
    shift1, scale1, gate1, shift2, scale2, gate2 = [m[:, None, :] for m in jnp.split(mod, N_MOD, axis=-1)]

    hmix = rms_norm(x, g_norm1) * (1.0 + scale1) + shift1
    proj = hmix @ w_in
    q_a, k_a, v_a, q_m, k_m, v_m, o_m, gates = jnp.split(proj, IN_SPLITS, axis=-1)

    att = banded_attention(q_a.reshape(b, s, N_HEADS_ATT, HEAD_DIM_ATT),
                           k_a.reshape(b, s, N_KV_HEADS, HEAD_DIM_ATT),
                           v_a.reshape(b, s, N_KV_HEADS, HEAD_DIM_ATT), sink)
    att = rms_norm(att, g_attn_out).astype(x.dtype)

    qk = jax.nn.silu(centred_dwconv(jnp.concatenate([q_m, k_m], axis=-1), conv_w, conv_b))
    q_m, k_m = jnp.split(qk, 2, axis=-1)
    gates = gates.astype(jnp.float32) + b_gates.astype(jnp.float32)
    i_f, f_f, i_b, f_b = jnp.split(gates, 4, axis=-1)
    qm = q_m.astype(jnp.float32).reshape(b, s, N_HEADS_M, HEAD_DIM_M)
    km = k_m.astype(jnp.float32).reshape(b, s, N_HEADS_M, HEAD_DIM_M)
    vm = v_m.astype(jnp.float32).reshape(b, s, N_HEADS_M, HEAD_DIM_M)
    flip = lambda t: jnp.flip(t, axis=1)
    h_fwd = mlstm_chunkwise(qm, km, vm, i_f, f_f)
    h_bwd = flip(mlstm_chunkwise(flip(qm), flip(km), flip(vm), flip(i_b), flip(f_b)))
    h_m = rms_norm(h_fwd + h_bwd, g_mlstm_out.reshape(N_HEADS_M, HEAD_DIM_M))
    h_m = (jax.nn.sigmoid(o_m.astype(jnp.float32)) * h_m.reshape(b, s, M_W)).astype(x.dtype)

    mix = jnp.concatenate([att, h_m], axis=-1) @ w_out
    x = x + gate1 * mix

    hff = rms_norm(x, g_norm2) * (1.0 + scale2) + shift2
    gte, up = jnp.split(hff @ w_ffn_in, 2, axis=-1)
    ff = (jax.nn.silu(gte) * up) @ w_ffn_out
    return x + gate2 * ff


def setup_inputs(seed: int = 0) -> dict:
    key = jax.random.key(seed)
    ks = jax.random.split(key, 20)
    nrm = lambda k, shape, scale: jax.random.normal(k, shape, jnp.float32) * scale
    gain = lambda k, shape: 1.0 + 0.02 * jax.random.normal(k, shape, jnp.float32)
    fb = jnp.linspace(3.0, 6.0, N_HEADS_M, dtype=jnp.float32)
    b_gates = jnp.concatenate([
        nrm(ks[8], (DEPTH, N_HEADS_M), 0.1),
        fb + nrm(ks[9], (DEPTH, N_HEADS_M), 0.1),
        nrm(ks[10], (DEPTH, N_HEADS_M), 0.1),
        fb + nrm(ks[11], (DEPTH, N_HEADS_M), 0.1),
    ], axis=-1)
    return {
        "x": nrm(ks[0], (BATCH, SEQ, D_MODEL), 1.0),
        "c": nrm(ks[1], (BATCH, D_MODEL), 1.0),
        "w_mod": nrm(ks[2], (DEPTH, D_MODEL, N_MOD * D_MODEL), D_MODEL ** -0.5),
        "b_mod": nrm(ks[3], (DEPTH, N_MOD * D_MODEL), 0.02),
        "g_norm1": gain(ks[4], (DEPTH, D_MODEL)),
        "w_in": nrm(ks[5], (DEPTH, D_MODEL, IN_COLS), D_MODEL ** -0.5),
        "conv_w": nrm(ks[6], (DEPTH, CONV_WIDTH, 2 * M_W), CONV_WIDTH ** -0.5),
        "conv_b": nrm(ks[7], (DEPTH, 2 * M_W), 0.02),
        "b_gates": b_gates,
        "sink": nrm(ks[12], (DEPTH, N_HEADS_ATT), 0.5),
        "g_attn_out": gain(ks[13], (DEPTH, ATT_Q)),
        "g_mlstm_out": gain(ks[14], (DEPTH, M_W)),
        "w_out": nrm(ks[15], (DEPTH, MIX_WIDTH, D_MODEL), MIX_WIDTH ** -0.5),
        "g_norm2": gain(ks[16], (DEPTH, D_MODEL)),
        "w_ffn_in": nrm(ks[17], (DEPTH, D_MODEL, 2 * D_FF), D_MODEL ** -0.5),
        "w_ffn_out": nrm(ks[18], (DEPTH, D_FF, D_MODEL), D_FF ** -0.5),
        "g_final": gain(ks[19], (D_MODEL,)),
    }


def reference(x, c, w_mod, b_mod, g_norm1, w_in, conv_w, conv_b, b_gates, sink,
              g_attn_out, g_mlstm_out, w_out, g_norm2, w_ffn_in, w_ffn_out, g_final):
    for l in range(DEPTH):
        x = hybrid_layer(x, c, w_mod[l], b_mod[l], g_norm1[l], w_in[l], conv_w[l], conv_b[l],
                         b_gates[l], sink[l], g_attn_out[l], g_mlstm_out[l], w_out[l],
                         g_norm2[l], w_ffn_in[l], w_ffn_out[l])
    return rms_norm(x, g_final)
```

```cpp
#include <hip/hip_runtime.h>
#include <hip/hip_cooperative_groups.h>
#include <cstdio>
#include <cstdint>
namespace cg = cooperative_groups;
namespace pg8 {
#define PG8_LAS __attribute__((address_space(3)))
typedef unsigned short bf16_t;
typedef short bf16x8 __attribute__((ext_vector_type(8)));
typedef float f32x4 __attribute__((ext_vector_type(4)));
typedef unsigned u32x4 __attribute__((ext_vector_type(4)));
constexpr int BM = 256, BK = 64, HALF = 128, HTB = HALF * BK * 2  , STAGE_BYTES = 8 * HTB, NXCD = 8, WGM = 8;

__host__ __device__ __forceinline__ int lds_byte(int r, int c) { const int st = (r >> 4) * 2 + (c >> 5), rr = r & 15, cc = c & 31, ob = rr * 64 + cc * 2; return st * 1024 + (ob ^ (((ob >> 9) & 1) << 5)); }
__host__ __device__ __forceinline__ void stage_rc(int b, int& R, int& C) { const int st = b / 1024, sb = b % 1024, swz = sb ^ (((sb >> 9) & 1) << 5); R = (st >> 1) * 16 + swz / 64; C = (st & 1) * 32 + (swz % 64) / 2; }
__host__ __device__ __forceinline__ int perm32(int rho) { const int n = rho >> 4, i = rho & 15; return 8 * (i >> 2) + 4 * n + (i & 3); }

struct Unit { int pm, pn; };
struct Gemm { const bf16_t* A; const bf16_t* Bt; int M, N, K; };

struct StaticOrder {
    int nM, nN, nwg, G, c, wgm;
    __host__ __device__ void init(int M, int N, int G_, int c_, int wgm_ = WGM) { nM = M / BM; nN = N / BM; nwg = nM * nN; G = G_; c = c_; wgm = wgm_; }
    __host__ __device__ bool next(int i, Unit& u) const {
        const long L = (long)i * G + c; if (L >= nwg) return false;
        int wgid = (int)L; { const int q = nwg / NXCD, r = nwg % NXCD, xcd = wgid % NXCD, off = wgid / NXCD; wgid = (xcd < r ? xcd * (q + 1) : r * (q + 1) + (xcd - r) * q) + off; }
        const int nig = wgm * nN, gid = wgid / nig, fm = gid * wgm, gsz = (nM - fm) < wgm ? (nM - fm) : wgm;
        u.pm = fm + ((wgid % nig) % gsz); u.pn = (wgid % nig) / gsz; return true;
    }
    __device__ __forceinline__ void a_ready(const Unit&) const {}
    __device__ __forceinline__ void done(const Unit&) const {}
};

__device__ __forceinline__ unsigned cvt_pk_bf16(float lo, float hi) { unsigned r; asm volatile("v_cvt_pk_bf16_f32 %0, %1, %2" : "=v"(r) : "v"(lo), "v"(hi)); return r; }
typedef float f32x2 __attribute__((ext_vector_type(2)));
template <class Epi, class Sched, bool ALIGN_EPI = false, bool SP2 = false>
__device__ __forceinline__ void gemm_phase(PG8_LAS unsigned char* lds, const Gemm g, const Sched& S, const Epi& E) {
    const int tid = threadIdx.x, wid = __builtin_amdgcn_readfirstlane(tid >> 6), lane = tid & 63, wr = wid >> 2, wc = wid & 3, fr = lane & 15, fq = lane >> 4;
    const int K = g.K, nt = K / BK;
    unsigned voffA[2], voffB[2];
#pragma unroll
    for (int i = 0; i < 2; ++i) { int R, C; stage_rc(tid * 16 + i * 8192, R, C); const int Rb = Epi::PERM ? ((R & ~31) + perm32(R & 31)) : R;
        voffA[i] = (unsigned)(R * K + C) * 2u; voffB[i] = (unsigned)(Rb * K + C) * 2u; }
    const size_t kstep = (size_t)(BK * 2);
    const size_t hstep = (size_t)HALF * K * 2;
    const size_t tstep = 2 * hstep;
    const unsigned ldsw = (unsigned)wid * 1024u;
    const int aoff = lds_byte(wr * 64 + fr, fq * 8), boff = lds_byte(wc * 32 + fr, fq * 8);
#define PG8_SA(b, h) (((b) * 2 + (h)) * HTB)
#define PG8_SB(b, h) ((4 + (b) * 2 + (h)) * HTB)
#define PG8_STAGE(bufoff, gbase, voff) do { _Pragma("unroll") for (int _i = 0; _i < 2; ++_i) \
        __builtin_amdgcn_global_load_lds((const unsigned*)((const char*)(gbase) + (voff)[_i]), (PG8_LAS unsigned*)(lds + (bufoff) + ldsw + _i * 8192), 16, 0, 0); } while (0)
#define PG8_LDA(dst, b, h) do { _Pragma("unroll") for (int m = 0; m < 4; ++m) _Pragma("unroll") for (int k = 0; k < 2; ++k) dst[m][k] = *(const PG8_LAS bf16x8*)(lds + PG8_SA(b, h) + aoff + m * 2048 + k * 1024); } while (0)
#define PG8_LDB(dst, b, h) do { _Pragma("unroll") for (int n = 0; n < 2; ++n) _Pragma("unroll") for (int k = 0; k < 2; ++k) dst[n][k] = *(const PG8_LAS bf16x8*)(lds + PG8_SB(b, h) + boff + n * 2048 + k * 1024); } while (0)
#define PG8_MMA(ai, bj, At, Bt) do { __builtin_amdgcn_s_setprio(1); _Pragma("unroll") for (int m = 0; m < 4; ++m) _Pragma("unroll") for (int n = 0; n < 2; ++n) _Pragma("unroll") for (int k = 0; k < 2; ++k) \
        acc[ai][bj][m][n] = __builtin_amdgcn_mfma_f32_16x16x32_bf16(Bt[n][k], At[m][k], acc[ai][bj][m][n], 0, 0, 0); __builtin_amdgcn_s_setprio(0); } while (0)
#define PG8_WAIT_V(n) asm volatile("s_waitcnt vmcnt(" #n ")" ::: "memory")
#define PG8_WAIT_L(n) asm volatile("s_waitcnt lgkmcnt(" #n ")" ::: "memory")
#define PG8_BAR __builtin_amdgcn_s_barrier()
#define PG8_SCHED __builtin_amdgcn_sched_barrier(0)
    Unit cur, nxt; int ui = 0;
    if (!S.next(0, cur)) return;
    f32x4 acc[2][2][4][2];
#pragma unroll
    for (int a = 0; a < 2; ++a)
#pragma unroll
        for (int b = 0; b < 2; ++b)
#pragma unroll
            for (int m = 0; m < 4; ++m)
#pragma unroll
                for (int n = 0; n < 2; ++n) acc[a][b][m][n] = (f32x4){0.f, 0.f, 0.f, 0.f};
    bf16x8 At[4][2], B0[2][2], B1[2][2];
    const char* cA = (const char*)g.A + (size_t)cur.pm * tstep; const char* cB = (const char*)g.Bt + (size_t)cur.pn * tstep;
    S.a_ready(cur);
    if constexpr (SP2) {
        PG8_STAGE(PG8_SB(0, 0), cB, voffB); PG8_STAGE(PG8_SB(0, 1), cB + hstep, voffB); PG8_STAGE(PG8_SA(0, 0), cA, voffA); PG8_STAGE(PG8_SA(0, 1), cA + hstep, voffA);
        if (wr == 1) PG8_BAR;
        PG8_WAIT_V(2); PG8_BAR;
        PG8_STAGE(PG8_SB(1, 0), cB + kstep, voffB); PG8_STAGE(PG8_SA(1, 0), cA + kstep, voffA); PG8_STAGE(PG8_SB(1, 1), cB + hstep + kstep, voffB);
        PG8_WAIT_V(6); PG8_BAR;
    } else {
        PG8_STAGE(PG8_SB(0, 0), cB, voffB); PG8_STAGE(PG8_SA(0, 0), cA, voffA); PG8_STAGE(PG8_SB(0, 1), cB + hstep, voffB); PG8_STAGE(PG8_SA(0, 1), cA + hstep, voffA);
        if (wr == 1) PG8_BAR;
        PG8_WAIT_V(4); PG8_BAR;
        PG8_STAGE(PG8_SB(1, 0), cB + kstep, voffB); PG8_STAGE(PG8_SA(1, 0), cA + kstep, voffA); PG8_STAGE(PG8_SB(1, 1), cB + hstep + kstep, voffB);
        PG8_WAIT_V(6); PG8_BAR;
    }
    for (;;) {
        const bool has_next = S.next(ui + 1, nxt);
        const char* nA = has_next ? (const char*)g.A + (size_t)nxt.pm * tstep : cA; const char* nB = has_next ? (const char*)g.Bt + (size_t)nxt.pn * tstep : cB;
        for (int t = 0; t < nt; t += 2) {
            const bool last = (t == nt - 2);
            const char* a1 = cA + (size_t)(t + 1) * kstep;
            const char* a2 = last ? nA : cA + (size_t)(t + 2) * kstep; const char* b2 = last ? nB : cB + (size_t)(t + 2) * kstep;
            const char* a3 = a2 + kstep; const char* b3 = b2 + kstep;
            if (last && has_next) S.a_ready(nxt);
            if constexpr (SP2) {
            PG8_LDB(B0, 0, 0); PG8_LDB(B1, 0, 1); PG8_SCHED; PG8_LDA(At, 0, 0); PG8_STAGE(PG8_SA(1, 1), a1 + hstep, voffA);
            PG8_WAIT_V(8); PG8_WAIT_L(0); PG8_BAR; PG8_MMA(0, 0, At, B0); PG8_MMA(0, 1, At, B1); PG8_BAR; PG8_SCHED;
            PG8_LDA(At, 0, 1); PG8_STAGE(PG8_SB(0, 0), b2, voffB); PG8_STAGE(PG8_SB(0, 1), b2 + hstep, voffB); PG8_STAGE(PG8_SA(0, 0), a2, voffA);
            PG8_WAIT_V(8); PG8_WAIT_L(0); PG8_BAR; PG8_MMA(1, 0, At, B0); PG8_MMA(1, 1, At, B1); PG8_BAR; PG8_SCHED;
            PG8_LDB(B0, 1, 0); PG8_LDB(B1, 1, 1); PG8_SCHED; PG8_LDA(At, 1, 0); PG8_STAGE(PG8_SA(0, 1), a2 + hstep, voffA);
            PG8_WAIT_V(8); PG8_WAIT_L(0); PG8_BAR; PG8_MMA(0, 0, At, B0); PG8_MMA(0, 1, At, B1); PG8_BAR; PG8_SCHED;
            PG8_LDA(At, 1, 1); PG8_STAGE(PG8_SB(1, 0), b3, voffB); PG8_STAGE(PG8_SB(1, 1), b3 + hstep, voffB); PG8_STAGE(PG8_SA(1, 0), a3, voffA);
            PG8_WAIT_V(8); PG8_WAIT_L(0); PG8_BAR; PG8_MMA(1, 0, At, B0); PG8_MMA(1, 1, At, B1); PG8_BAR; PG8_SCHED;
            } else {
            PG8_LDB(B0, 0, 0); PG8_SCHED; PG8_LDA(At, 0, 0); PG8_STAGE(PG8_SA(1, 1), a1 + hstep, voffA);
            PG8_WAIT_L(8); PG8_BAR; PG8_WAIT_L(0); PG8_MMA(0, 0, At, B0); PG8_BAR; PG8_SCHED;
            PG8_LDB(B1, 0, 1); PG8_STAGE(PG8_SB(0, 0), b2, voffB);
            PG8_BAR; PG8_WAIT_L(0); PG8_MMA(0, 1, At, B1); PG8_BAR;
            PG8_LDA(At, 0, 1); PG8_STAGE(PG8_SA(0, 0), a2, voffA);
            PG8_BAR; PG8_WAIT_L(0); PG8_MMA(1, 0, At, B0); PG8_BAR; PG8_SCHED;
            PG8_STAGE(PG8_SB(0, 1), b2 + hstep, voffB);
            PG8_WAIT_V(6); PG8_BAR; PG8_MMA(1, 1, At, B1); PG8_BAR;
            PG8_LDB(B0, 1, 0); PG8_SCHED; PG8_LDA(At, 1, 0); PG8_STAGE(PG8_SA(0, 1), a2 + hstep, voffA);
            PG8_WAIT_L(8); PG8_BAR; PG8_WAIT_L(0); PG8_MMA(0, 0, At, B0); PG8_BAR; PG8_SCHED;
            PG8_LDB(B1, 1, 1); PG8_STAGE(PG8_SB(1, 0), b3, voffB);
            PG8_BAR; PG8_WAIT_L(0); PG8_MMA(0, 1, At, B1); PG8_BAR;
            PG8_LDA(At, 1, 1); PG8_STAGE(PG8_SA(1, 0), a3, voffA);
            PG8_BAR; PG8_WAIT_L(0); PG8_MMA(1, 0, At, B0); PG8_BAR; PG8_SCHED;
            PG8_STAGE(PG8_SB(1, 1), b3 + hstep, voffB);
            PG8_WAIT_V(6); PG8_BAR; PG8_MMA(1, 1, At, B1); PG8_BAR;
            }
        }
        if constexpr (ALIGN_EPI) { if (wr == 0) PG8_BAR; }
        if constexpr (!Epi::AFTER_DRAIN) { E(acc, cur, wr, wc, fr, fq); S.done(cur); }
        if (!has_next) break;
#pragma unroll
        for (int a = 0; a < 2; ++a)
#pragma unroll
            for (int b = 0; b < 2; ++b)
#pragma unroll
                for (int m = 0; m < 4; ++m)
#pragma unroll
                    for (int n = 0; n < 2; ++n) acc[a][b][m][n] = (f32x4){0.f, 0.f, 0.f, 0.f};
        cur = nxt; cA = nA; cB = nB; ++ui;
        if constexpr (ALIGN_EPI) { if (wr == 1) PG8_BAR; }
    }
    PG8_WAIT_V(0);
    if constexpr (!ALIGN_EPI) { if (wr == 0) PG8_BAR; }
    PG8_BAR;
    if constexpr (Epi::AFTER_DRAIN) { E.fused(acc, cur, wr, wc, fr, fq, lds, wid, lane); S.done(cur); }
#undef PG8_SA
#undef PG8_SB
#undef PG8_STAGE
#undef PG8_LDA
#undef PG8_LDB
#undef PG8_MMA
#undef PG8_WAIT_V
#undef PG8_WAIT_L
#undef PG8_BAR
#undef PG8_SCHED
}
}

#define LAS __attribute__((address_space(3)))
typedef unsigned short bf16_t;
typedef short bf16x8 __attribute__((ext_vector_type(8)));
typedef float f32x4 __attribute__((ext_vector_type(4)));
typedef unsigned u32x4 __attribute__((ext_vector_type(4)));
typedef unsigned u32x2 __attribute__((ext_vector_type(2)));
typedef float f32x2_t __attribute__((ext_vector_type(2)));
typedef __bf16 bf16x2_t __attribute__((ext_vector_type(2)));

constexpr int SEQ = 8192, NB = 2, M = NB * SEQ, D = 1024, NPROJ = 3072, NIN = 2832, DFF = 2816, NMOD = 6144;
constexpr float EPS = 1e-6f;
constexpr int NTHREADS = 512, NWAVES = 8;
constexpr int LDS_BYTES = 147456;
constexpr int NPHASES = 11;

constexpr size_t MiB = 1u << 20;
constexpr size_t WS_MOD = 0;
constexpr size_t WS_SC = 256 * 1024;
constexpr size_t WS_MPREV = 320 * 1024;
constexpr size_t WS_ATTSS = 384 * 1024;
constexpr size_t WS_SS2 = 640 * 1024;
constexpr size_t WS_SS3 = 704 * 1024;
constexpr size_t WS_BAR = 512 * 1024;
constexpr size_t WS_CNT = 512 * 1024 + 16384;
constexpr size_t WS_GATES = 1 * MiB;
constexpr size_t WS_GV = 2 * MiB;
constexpr size_t WS_NC = 3 * MiB;
constexpr size_t WS_NPREV = 4 * MiB;
constexpr size_t WS_WIN = 6 * MiB;
constexpr size_t WS_WOUT = 12 * MiB;
constexpr size_t WS_WFI = 14 * MiB;
constexpr size_t WS_WFO = 25 * MiB;
constexpr size_t WS_PROJ = 32 * MiB;
constexpr size_t WS_QM = 128 * MiB;
constexpr size_t WS_KM = 144 * MiB;
constexpr size_t WS_XN = 160 * MiB;
constexpr size_t WS_A2 = 192 * MiB;
constexpr size_t WS_END = 224 * MiB;

struct Params {
    const float *x, *c, *w_mod, *b_mod, *g_norm1, *w_in, *conv_w, *conv_b, *b_gates, *sink, *g_attn_out, *g_mlstm_out, *w_out, *g_norm2, *w_ffn_in, *w_ffn_out, *g_final;
    float* out; unsigned char* ws; int ph_lo, ph_hi;
};

__device__ __forceinline__ float bf2f(unsigned h) { return __uint_as_float(h << 16); }
__device__ __forceinline__ unsigned pk2(float lo, float hi) { f32x2_t v = {lo, hi}; bf16x2_t b = __builtin_convertvector(v, bf16x2_t); return __builtin_bit_cast(unsigned, b); }
__device__ __forceinline__ float wave_sum(float v) {
#pragma unroll
    for (int o = 1; o < 64; o <<= 1) v += __shfl_xor(v, o);
    return v;
}
__device__ __forceinline__ float quad_sum(float v) { v += __shfl_xor(v, 16); v += __shfl_xor(v, 32); return v; }
__device__ __forceinline__ float quad_max(float v) { v = fmaxf(v, __shfl_xor(v, 16)); v = fmaxf(v, __shfl_xor(v, 32)); return v; }
__device__ __forceinline__ float silu_f(float v) { return v * __builtin_amdgcn_rcpf(1.0f + __expf(-v)); }
__device__ __forceinline__ float sigmoid_f(float v) { return __builtin_amdgcn_rcpf(1.0f + __expf(-v)); }
__device__ __forceinline__ float logsig_f(float f) { return fminf(f, 0.f) - log1pf(expf(-fabsf(f))); }
__device__ __forceinline__ f32x4 mfma16(bf16x8 a, bf16x8 b, f32x4 c) { return __builtin_amdgcn_mfma_f32_16x16x32_bf16(a, b, c, 0, 0, 0); }
__device__ __forceinline__ bf16x8 mk8(unsigned a, unsigned b, unsigned c, unsigned d) { u32x4 v = {a, b, c, d}; return __builtin_bit_cast(bf16x8, v); }

struct EpiProj {
    static constexpr bool PERM = true, AFTER_DRAIN = false;
    bf16_t* O; float* gates; const float* b_gates;
    __device__ __forceinline__ void operator()(const f32x4 (&acc)[2][2][4][2], const pg8::Unit& u, int wr, int wc, int fr, int fq) const {
        const int row0 = u.pm * 256 + wr * 64 + fr; const int col0 = u.pn * 256 + wc * 32 + 8 * fq;
        if (u.pn != 11)
#pragma unroll
        for (int ai = 0; ai < 2; ++ai)
#pragma unroll
            for (int m = 0; m < 4; ++m) { bf16_t* rowp = O + (size_t)(row0 + ai * 128 + m * 16) * NPROJ + col0;
#pragma unroll
                for (int bj = 0; bj < 2; ++bj) { const f32x4 v0 = acc[ai][bj][m][0], v1 = acc[ai][bj][m][1];
                    u32x4 w; w.x = pk2(v0[0], v0[1]); w.y = pk2(v0[2], v0[3]); w.z = pk2(v1[0], v1[1]); w.w = pk2(v1[2], v1[3]);
                    *(u32x4*)(rowp + bj * 128) = w; } }
        if (u.pn == 11 && wc == 0 && fq < 2) {
            const f32x4 b0 = *(const f32x4*)(b_gates + 8 * fq), b1 = *(const f32x4*)(b_gates + 8 * fq + 4);
#pragma unroll
            for (int ai = 0; ai < 2; ++ai)
#pragma unroll
                for (int m = 0; m < 4; ++m) { float* gp = gates + (size_t)(row0 + ai * 128 + m * 16) * 16 + 8 * fq;
                    *(f32x4*)gp = acc[ai][0][m][0] + b0; *(f32x4*)(gp + 4) = acc[ai][0][m][1] + b1; }
        }
    }
};
struct EpiResid {
    static constexpr bool PERM = false, AFTER_DRAIN = false;
    const float* base; float* out; const float* gate;
    const float* rowss;
    __device__ __forceinline__ void operator()(const f32x4 (&acc)[2][2][4][2], const pg8::Unit& u, int wr, int wc, int fr, int fq) const {
        const int col0 = u.pn * 256 + wc * 32 + 4 * fq; const int b = u.pm >> 5;
        float rs[2][4];
#pragma unroll
        for (int ai = 0; ai < 2; ++ai)
#pragma unroll
            for (int m = 0; m < 4; ++m) rs[ai][m] = rowss ? rsqrtf(rowss[u.pm * 256 + ai * 128 + wr * 64 + m * 16 + fr] * (1.0f / 512.0f) + EPS) : 1.0f;
#pragma unroll
        for (int bj = 0; bj < 2; ++bj)
#pragma unroll
            for (int n = 0; n < 2; ++n) { const f32x4 g = *(const f32x4*)(gate + b * NMOD + col0 + bj * 128 + n * 16);
#pragma unroll
                for (int ai = 0; ai < 2; ++ai)
#pragma unroll
                    for (int m = 0; m < 4; ++m) { const size_t off = (size_t)(u.pm * 256 + ai * 128 + wr * 64 + m * 16 + fr) * D + col0 + bj * 128 + n * 16;
                        const f32x4 bs = *(const f32x4*)(base + off); *(f32x4*)(out + off) = bs + (g * rs[ai][m]) * acc[ai][bj][m][n]; } }
    }
};
struct EpiResidNorm {
    static constexpr bool PERM = false, AFTER_DRAIN = true;
    const float* base; float* out; const float* gate; const float* rowss;
    float* SS; unsigned* CNT; const float* gcol; const float* mod_scale; const float* mod_shift; bf16_t* XN;
    const bf16_t* base_bf; bf16_t* x1_bf;
    __device__ __forceinline__ void fused(f32x4 (&acc)[2][2][4][2], const pg8::Unit& u, int wr, int wc, int fr, int fq, PG8_LAS unsigned char* lds, int wid, int lane) const {
        const int col0 = u.pn * 256 + wc * 32 + 4 * fq; const int b = u.pm >> 5; const int rowb = u.pm * 256 + wr * 64 + fr;
        f32x4 gq[2][2];
#pragma unroll
        for (int bj = 0; bj < 2; ++bj)
#pragma unroll
            for (int n = 0; n < 2; ++n) gq[bj][n] = *(const f32x4*)(gate + b * NMOD + col0 + bj * 128 + n * 16);
#pragma unroll
        for (int ai = 0; ai < 2; ++ai)
#pragma unroll
            for (int mp = 0; mp < 2; ++mp) {
                f32x4 bs[2][2][2]; float rsv[2];
#pragma unroll
                for (int mi = 0; mi < 2; ++mi) { const int row = rowb + ai * 128 + (mp * 2 + mi) * 16; rsv[mi] = rowss ? rowss[row] : 0.f;
#pragma unroll
                    for (int bj = 0; bj < 2; ++bj)
#pragma unroll
                        for (int n = 0; n < 2; ++n) { const unsigned off = (unsigned)(row * D + col0 + bj * 128 + n * 16);
                            if (base_bf) { const u32x2 q = *(const u32x2*)(base_bf + off); bs[mi][bj][n] = (f32x4){bf2f(q.x & 0xffffu), bf2f(q.x >> 16), bf2f(q.y & 0xffffu), bf2f(q.y >> 16)}; }
                            else bs[mi][bj][n] = *(const f32x4*)(base + off); } }
#pragma unroll
                for (int mi = 0; mi < 2; ++mi) { const int m = mp * 2 + mi; const int row = rowb + ai * 128 + m * 16;
                    const float rs1 = rowss ? rsqrtf(rsv[mi] * (1.0f / 512.0f) + EPS) : 1.0f; float ssp = 0.f;
#pragma unroll
                    for (int bj = 0; bj < 2; ++bj)
#pragma unroll
                        for (int n = 0; n < 2; ++n) { const f32x4 v = bs[mi][bj][n] + (gq[bj][n] * rs1) * acc[ai][bj][m][n]; acc[ai][bj][m][n] = v;
                            ssp += (v[0] * v[0] + v[1] * v[1]) + (v[2] * v[2] + v[3] * v[3]);
                            asm volatile("" : "+v"(acc[ai][bj][m][n])); }
                    const float sq = quad_sum(ssp); if (fq == 0) __hip_atomic_fetch_add(SS + row, sq, __ATOMIC_RELAXED, __HIP_MEMORY_SCOPE_AGENT); }
                asm volatile("" ::: "memory"); }
        asm volatile("s_waitcnt vmcnt(0)" ::: "memory");
        __syncthreads();
        if (threadIdx.x == 0) { unsigned* cp = CNT + u.pm * 16;
            __builtin_amdgcn_fence(__ATOMIC_RELEASE, "agent");
            __hip_atomic_fetch_add(cp, 1u, __ATOMIC_RELAXED, __HIP_MEMORY_SCOPE_AGENT);
            unsigned spins = 0;
            while (__hip_atomic_load(cp, __ATOMIC_RELAXED, __HIP_MEMORY_SCOPE_AGENT) < 4u && ++spins < (1u << 22)) __builtin_amdgcn_s_sleep(1);
            __builtin_amdgcn_fence(__ATOMIC_ACQUIRE, "agent"); }
        __syncthreads();
        int rowc = rowb; asm volatile("" : "+v"(rowc));
        float rstd[2][4];
#pragma unroll
        for (int ai = 0; ai < 2; ++ai)
#pragma unroll
            for (int m = 0; m < 4; ++m) rstd[ai][m] = rsqrtf(__hip_atomic_load(SS + rowc + ai * 128 + m * 16, __ATOMIC_RELAXED, __HIP_MEMORY_SCOPE_AGENT) * (1.0f / D) + EPS);
#pragma unroll
        for (int bj = 0; bj < 2; ++bj)
#pragma unroll
            for (int n = 0; n < 2; ++n) { const int col = col0 + bj * 128 + n * 16; f32x4 gc = *(const f32x4*)(gcol + col); f32x4 sh = {0.f, 0.f, 0.f, 0.f};
                if (XN) { gc = gc * (1.0f + *(const f32x4*)(mod_scale + b * NMOD + col)); sh = *(const f32x4*)(mod_shift + b * NMOD + col); }
#pragma unroll
                for (int ai = 0; ai < 2; ++ai)
#pragma unroll
                    for (int m = 0; m < 4; ++m) { const unsigned off = (unsigned)((rowc + ai * 128 + m * 16) * D + col); const f32x4 v = acc[ai][bj][m][n] * rstd[ai][m] * gc + sh;
                        if (XN) { { const f32x4 a = acc[ai][bj][m][n]; u32x2 q; q.x = pk2(a[0], a[1]); q.y = pk2(a[2], a[3]); *(u32x2*)(x1_bf + off) = q; } u32x2 w; w.x = pk2(v[0], v[1]); w.y = pk2(v[2], v[3]); *(u32x2*)(XN + off) = w; } else *(f32x4*)(out + off) = v; } }
    }
};
struct EpiSwiglu {
    static constexpr bool PERM = true, AFTER_DRAIN = false;
    bf16_t* O;
    __device__ __forceinline__ void operator()(const f32x4 (&acc)[2][2][4][2], const pg8::Unit& u, int wr, int wc, int fr, int fq) const {
        const int row0 = u.pm * 256 + wr * 64 + fr; const int col0 = u.pn * 128 + wc * 32 + 8 * fq;
#pragma unroll
        for (int ai = 0; ai < 2; ++ai)
#pragma unroll
            for (int m = 0; m < 4; ++m) { float r[8];
#pragma unroll
                for (int n = 0; n < 2; ++n)
#pragma unroll
                    for (int e = 0; e < 4; ++e) { const float g = acc[ai][0][m][n][e], up = acc[ai][1][m][n][e]; r[n * 4 + e] = silu_f(g) * up; }
                u32x4 w; w.x = pk2(r[0], r[1]); w.y = pk2(r[2], r[3]); w.z = pk2(r[4], r[5]); w.w = pk2(r[6], r[7]);
                *(u32x4*)(O + (size_t)(row0 + ai * 128 + m * 16) * DFF + col0) = w; }
    }
};

__device__ __forceinline__ void transpose_item(const float* W, int K, int N, bf16_t* WT, int drow0, int k0, int n0, LAS float* scr, int lane) {
    const int kr = lane >> 3, nq = (lane & 7) * 4; f32x4 v[8];
#pragma unroll
    for (int i = 0; i < 8; ++i) { const f32x4 z = {0.f, 0.f, 0.f, 0.f}; v[i] = (n0 + nq < N) ? *(const f32x4*)(W + (size_t)(k0 + kr + 8 * i) * N + n0 + nq) : z; }
#pragma unroll
    for (int i = 0; i < 8; ++i) { LAS float* d = scr + (kr + 8 * i) * 33 + nq; d[0] = v[i][0]; d[1] = v[i][1]; d[2] = v[i][2]; d[3] = v[i][3]; }
    const int c = lane & 7;
#pragma unroll
    for (int j = 0; j < 4; ++j) { const int n = (lane >> 3) + 8 * j; const LAS float* s = scr + (8 * c) * 33 + n;
        u32x4 o; o.x = pk2(s[0 * 33], s[1 * 33]); o.y = pk2(s[2 * 33], s[3 * 33]); o.z = pk2(s[4 * 33], s[5 * 33]); o.w = pk2(s[6 * 33], s[7 * 33]);
        *(u32x4*)(WT + (size_t)(drow0 + n) * K + k0 + 8 * c) = o; }
}

__device__ __forceinline__ void phase0(const Params& P, LAS unsigned char* lds, int tid, int wave, int lane) {
    unsigned char* ws = P.ws;
    float* MOD = (float*)(ws + WS_MOD);
    LAS float* red = (LAS float*)(lds + 81920);
    for (int item = blockIdx.x; item < NMOD / 32; item += gridDim.x) {
        const int col0 = item * 32 + (lane & 7) * 4; const int r = lane >> 3;
        f32x4 a0 = {0.f, 0.f, 0.f, 0.f}, a1 = {0.f, 0.f, 0.f, 0.f};
#pragma unroll 4
        for (int i = 0; i < 16; ++i) { const int k = wave * 128 + r + 8 * i; const f32x4 w = *(const f32x4*)(P.w_mod + (size_t)k * NMOD + col0);
            const float s0 = silu_f(P.c[k]), s1 = silu_f(P.c[D + k]); a0 += s0 * w; a1 += s1 * w; }
#pragma unroll
        for (int e = 0; e < 4; ++e) {
#pragma unroll
            for (int o = 8; o < 64; o <<= 1) { a0[e] += __shfl_xor(a0[e], o); a1[e] += __shfl_xor(a1[e], o); } }
        if (lane < 8) {
#pragma unroll
            for (int e = 0; e < 4; ++e) { red[(wave * 8 + lane) * 8 + e] = a0[e]; red[(wave * 8 + lane) * 8 + 4 + e] = a1[e]; } }
        __syncthreads();
        if (tid < 64) { const int q = tid >> 3, e = tid & 7; float s = 0.f;
#pragma unroll
            for (int w = 0; w < 8; ++w) s += red[(w * 8 + q) * 8 + e];
            const int b = e >> 2, col = item * 32 + q * 4 + (e & 3); MOD[b * NMOD + col] = s + P.b_mod[col]; }
        __syncthreads();
    }
    LAS float* scr = (LAS float*)(lds + wave * 8704);
    const int gw = blockIdx.x * NWAVES + wave, NGW = gridDim.x * NWAVES;
    bf16_t* WIN = (bf16_t*)(ws + WS_WIN); bf16_t* WOUT = (bf16_t*)(ws + WS_WOUT); bf16_t* WFI = (bf16_t*)(ws + WS_WFI); bf16_t* WFO = (bf16_t*)(ws + WS_WFO);
    constexpr int NB_IN = 88, I_IN = 16 * NB_IN, I_OUT = 16 * 32, I_FI = 16 * 176, I_FO = 44 * 32;
    if ((int)gridDim.x > NMOD / 32) { const int xw = ((int)blockIdx.x - NMOD / 32) * NWAVES + wave; if (xw >= 0 && xw < 16) transpose_item(P.w_in, D, NIN, WIN, 88 * 32, xw * 64, 88 * 32, scr, lane); }
    else if (gw < 16) transpose_item(P.w_in, D, NIN, WIN, 88 * 32, gw * 64, 88 * 32, scr, lane);
    for (int it = gw; it < I_IN + I_OUT + I_FI + I_FO; it += NGW) {
        int r = it;
        if (r < I_IN) { const int kb = r / NB_IN, nb = r % NB_IN; transpose_item(P.w_in, D, NIN, WIN, nb * 32, kb * 64, nb * 32, scr, lane); continue; } r -= I_IN;
        if (r < I_OUT) { const int kb = r / 32, nb = r % 32; transpose_item(P.w_out, D, D, WOUT, nb * 32, kb * 64, nb * 32, scr, lane); continue; } r -= I_OUT;
        if (r < I_FI) { const int kb = r / 176, nb = r % 176; const int n0 = nb * 32; const int np = n0 < DFF ? n0 : n0 - DFF;
            const int drow0 = (np / 128) * 256 + (n0 < DFF ? 0 : 128) + (np % 128);
            transpose_item(P.w_ffn_in, D, 2 * DFF, WFI, drow0, kb * 64, n0, scr, lane); continue; } r -= I_FI;
        { const int kb = r / 32, nb = r % 32; transpose_item(P.w_ffn_out, DFF, D, WFO, nb * 32, kb * 64, nb * 32, scr, lane); }
    }
}

__device__ __forceinline__ void norm_mod_phase(const float* X, const float* g, const float* MOD, int shift_off, int scale_off, bf16_t* XN, int wave, int lane) {
    const int gw = blockIdx.x * NWAVES + wave, NGW = gridDim.x * NWAVES;
    int curb = -1; f32x4 A[4], B[4];
    for (int m = gw; m < M; m += 2 * NGW) {
        const int b = m >> 13; const int m2 = m + NGW;
        if (b != curb) { curb = b;
#pragma unroll
            for (int j = 0; j < 4; ++j) { const int col = 4 * lane + 256 * j; const f32x4 gv = *(const f32x4*)(g + col), sc = *(const f32x4*)(MOD + b * NMOD + scale_off + col);
                A[j] = gv * (1.0f + sc); B[j] = *(const f32x4*)(MOD + b * NMOD + shift_off + col); } }
        f32x4 v[4], w[4]; float ss = 0.f, ss2 = 0.f;
#pragma unroll
        for (int j = 0; j < 4; ++j) { v[j] = *(const f32x4*)(X + (size_t)m * D + 4 * lane + 256 * j); w[j] = *(const f32x4*)(X + (size_t)m2 * D + 4 * lane + 256 * j); }
#pragma unroll
        for (int j = 0; j < 4; ++j) { ss += (v[j][0] * v[j][0] + v[j][1] * v[j][1]) + (v[j][2] * v[j][2] + v[j][3] * v[j][3]); ss2 += (w[j][0] * w[j][0] + w[j][1] * w[j][1]) + (w[j][2] * w[j][2] + w[j][3] * w[j][3]); }
        const float rstd = rsqrtf(wave_sum(ss) * (1.0f / D) + EPS), rstd2 = rsqrtf(wave_sum(ss2) * (1.0f / D) + EPS);
#pragma unroll
        for (int j = 0; j < 4; ++j) { const f32x4 o = v[j] * rstd * A[j] + B[j]; u32x2 p; p.x = pk2(o[0], o[1]); p.y = pk2(o[2], o[3]);
            *(u32x2*)(XN + (size_t)m * D + 4 * lane + 256 * j) = p;
            const f32x4 o2 = w[j] * rstd2 * A[j] + B[j]; u32x2 p2; p2.x = pk2(o2[0], o2[1]); p2.y = pk2(o2[2], o2[3]);
            *(u32x2*)(XN + (size_t)m2 * D + 4 * lane + 256 * j) = p2; }
    }
}
__device__ __forceinline__ void final_norm_phase(float* X, const float* g, int wave, int lane) {
    const int gw = blockIdx.x * NWAVES + wave, NGW = gridDim.x * NWAVES;
    f32x4 A[4];
#pragma unroll
    for (int j = 0; j < 4; ++j) A[j] = *(const f32x4*)(g + 4 * lane + 256 * j);
    for (int m = gw; m < M; m += NGW) {
        f32x4 v[4]; float ss = 0.f;
#pragma unroll
        for (int j = 0; j < 4; ++j) { v[j] = *(const f32x4*)(X + (size_t)m * D + 4 * lane + 256 * j); ss += (v[j][0] * v[j][0] + v[j][1] * v[j][1]) + (v[j][2] * v[j][2] + v[j][3] * v[j][3]); }
        const float rstd = rsqrtf(wave_sum(ss) * (1.0f / D) + EPS);
#pragma unroll
        for (int j = 0; j < 4; ++j) *(f32x4*)(X + (size_t)m * D + 4 * lane + 256 * j) = v[j] * rstd * A[j];
    }
}

typedef short v4i16_t __attribute__((ext_vector_type(4)));
__device__ __forceinline__ u32x2 tr_read(const LAS bf16_t* p) { return __builtin_bit_cast(u32x2, __builtin_amdgcn_ds_read_tr16_b64_v4i16((LAS v4i16_t*)p)); }

constexpr float ATT_C1 = 0.125f * 1.4426950408889634f;
template <bool MASK, int KT_LO, int KT_HI>
__device__ __forceinline__ void attn_chunk(const int kc, const LAS bf16_t* Ks, const LAS bf16_t* Vs, bf16x8 (&qf)[2][2], f32x4 (&o)[4][2], float (&m_run)[2], float (&l_run)[2],
                                           const float fbase, const float sl8, const int fr, const int fq, const int troff, const bool q_reload, const bf16_t* qnext) {
    f32x4 s[4][2];
    float fb = fbase; asm volatile("" : "+v"(fb));
#pragma unroll
    for (int kt = KT_LO; kt < KT_HI; ++kt) { const LAS bf16_t* kp = Ks + (kc * 64 + kt * 16 + fr) * 72 + fq * 8;
        const bf16x8 a0 = *(const LAS bf16x8*)kp, a1 = *(const LAS bf16x8*)(kp + 32);
#pragma unroll
        for (int qt = 0; qt < 2; ++qt) { const f32x4 z = {0.f, 0.f, 0.f, 0.f}; s[kt][qt] = mfma16(a1, qf[qt][1], mfma16(a0, qf[qt][0], z)); } }
    if (q_reload) {
#pragma unroll
        for (int qt = 0; qt < 2; ++qt)
#pragma unroll
            for (int kk = 0; kk < 2; ++kk) qf[qt][kk] = *(const bf16x8*)(qnext + (size_t)qt * 16 * NPROJ + kk * 32); }
    unsigned pb[2][4][2];
#pragma unroll
    for (int qt = 0; qt < 2; ++qt) {
        float cmax = -1e30f;
#pragma unroll
        for (int kt = KT_LO; kt < KT_HI; ++kt)
#pragma unroll
            for (int i = 0; i < 4; ++i) { const float rel = fb + (float)(kc * 64 + kt * 16 + i - qt * 16); const float ar = fabsf(rel);
                float lg = fmaf(-sl8, ar, s[kt][qt][i]); if (MASK) lg = (ar <= 128.0f) ? lg : -1e30f; s[kt][qt][i] = lg; cmax = fmaxf(cmax, lg); }
        cmax = quad_max(cmax);
        const float m_new = fmaxf(m_run[qt], cmax), alpha = __builtin_amdgcn_exp2f((m_run[qt] - m_new) * ATT_C1), mc = m_new * ATT_C1; m_run[qt] = m_new;
        float psum = 0.f;
#pragma unroll
        for (int kt = KT_LO; kt < KT_HI; ++kt) { float p[4];
#pragma unroll
            for (int i = 0; i < 4; ++i) { p[i] = __builtin_amdgcn_exp2f(fmaf(s[kt][qt][i], ATT_C1, -mc)); psum += p[i]; }
            pb[qt][kt][0] = pk2(p[0], p[1]); pb[qt][kt][1] = pk2(p[2], p[3]); }
        l_run[qt] = l_run[qt] * alpha + psum;
#pragma unroll
        for (int dt = 0; dt < 4; ++dt) o[dt][qt] *= alpha;
    }
#pragma unroll
    for (int ks = KT_LO / 2; ks < KT_HI / 2; ++ks)
#pragma unroll
        for (int dt = 0; dt < 4; ++dt) { const LAS bf16_t* vp = Vs + (kc * 64 + ks * 32) * 80 + troff + dt * 16;
            const u32x2 lo = tr_read(vp), hi = tr_read(vp + 16 * 80); const bf16x8 a = mk8(lo.x, lo.y, hi.x, hi.y);
#pragma unroll
            for (int qt = 0; qt < 2; ++qt) o[dt][qt] = mfma16(a, mk8(pb[qt][2 * ks][0], pb[qt][2 * ks][1], pb[qt][2 * ks + 1][0], pb[qt][2 * ks + 1][1]), o[dt][qt]); }
}

__device__ __forceinline__ void attn_phase(const Params& P, LAS unsigned char* lds, int tid, int wave, int lane, const bool do_atomic) {
    LAS bf16_t* Ks = (LAS bf16_t*)lds;
    LAS bf16_t* Vs = (LAS bf16_t*)(lds + 46080);
    const bf16_t* PROJ = (const bf16_t*)(P.ws + WS_PROJ);
    bf16_t* A2 = (bf16_t*)(P.ws + WS_A2); float* ATTSS = (float*)(P.ws + WS_ATTSS);
    const int fr = lane & 15, fq = lane >> 4, g = wave >> 1, r = wave & 1;
    const int troff = (fq * 4 + ((lane >> 2) & 3)) * 80 + (lane & 3) * 4;
    const float fbase = (float)(fq * 4 - 128 - r * 32 - fr);
    const int G = gridDim.x;
    int u = (G % 8 == 0) ? ((int)blockIdx.x % 8) * (G / 8) + (int)blockIdx.x / 8 : (int)blockIdx.x; if (u >= 512) return;
    u32x4 rk[5], rv[5];
#define AT_LOADS(uu, kvh_) do { const int b_ = (uu) >> 7, t0_ = ((uu) & 127) * 64, kb_ = t0_ - 128; \
        _Pragma("unroll") for (int i = 0; i < 5; ++i) { const int cidx = tid + 512 * i, key = cidx >> 3, part = cidx & 7, tok = kb_ + key; const u32x4 z = {0u, 0u, 0u, 0u}; rk[i] = z; rv[i] = z; \
            if (tok >= 0 && tok < SEQ) { const bf16_t* rowp = PROJ + (size_t)(b_ * SEQ + tok) * NPROJ; rk[i] = *(const u32x4*)(rowp + 512 + (kvh_) * 64 + part * 8); rv[i] = *(const u32x4*)(rowp + 640 + (kvh_) * 64 + part * 8); } } \
        } while (0)
    AT_LOADS(u, 0);
    bf16x8 qf[2][2];
    { const int b0 = u >> 7, t00 = (u & 127) * 64;
#pragma unroll
      for (int qt = 0; qt < 2; ++qt)
#pragma unroll
          for (int kk = 0; kk < 2; ++kk) qf[qt][kk] = *(const bf16x8*)(PROJ + (size_t)(b0 * SEQ + t00 + r * 32 + qt * 16 + fr) * NPROJ + g * 64 + kk * 32 + fq * 8); }
    for (;;) {
        const int b = u >> 7, qb = u & 127, t0 = qb * 64;
        const int kc_lo = qb == 0 ? 2 : (qb == 1 ? 1 : 0), kc_hi = qb == 127 ? 3 : (qb == 126 ? 4 : 5);
        const int un = u + G; const bool more = un < 512;
#pragma unroll 1
        for (int kvh = 0; kvh < 2; ++kvh) {
            __syncthreads();
#pragma unroll
            for (int i = 0; i < 5; ++i) { const int cidx = tid + 512 * i, key = cidx >> 3, part = cidx & 7; *(LAS u32x4*)(Ks + key * 72 + part * 8) = rk[i]; *(LAS u32x4*)(Vs + key * 80 + part * 8) = rv[i]; }
            __syncthreads();
            const bool qnx = (kvh == 0) || more; const int un_b = un >> 7, un_t0 = (un & 127) * 64;
            const bf16_t* qnext = (kvh == 0) ? PROJ + (size_t)(b * SEQ + t0 + r * 32 + fr) * NPROJ + (4 + g) * 64 + fq * 8
                                             : PROJ + (size_t)(un_b * SEQ + un_t0 + r * 32 + fr) * NPROJ + g * 64 + fq * 8;
            if (!qnx) qnext = PROJ;
            if (kvh == 0) { AT_LOADS(u, 1); } else if (more) { AT_LOADS(un, 0); }
            const int h = kvh * 4 + g;
            const float sl8 = 8.0f * exp2f(-(float)(h + 1));
            float m_run[2], l_run[2]; f32x4 o[4][2];
#pragma unroll
            for (int qt = 0; qt < 2; ++qt) { m_run[qt] = 8.0f * P.sink[h]; l_run[qt] = (fq == 0) ? 1.0f : 0.0f;
#pragma unroll
                for (int dt = 0; dt < 4; ++dt) o[dt][qt] = (f32x4){0.f, 0.f, 0.f, 0.f}; }
            if (r == 0) {
                if (kc_lo <= 0) attn_chunk<true, 0, 4>(0, Ks, Vs, qf, o, m_run, l_run, fbase, sl8, fr, fq, troff, qnx && (kc_hi == 1), qnext);
                if (kc_lo <= 1) attn_chunk<false, 0, 4>(1, Ks, Vs, qf, o, m_run, l_run, fbase, sl8, fr, fq, troff, qnx && (kc_hi == 2), qnext);
                attn_chunk<false, 0, 4>(2, Ks, Vs, qf, o, m_run, l_run, fbase, sl8, fr, fq, troff, qnx && (kc_hi == 3), qnext);
                if (kc_hi > 3) attn_chunk<false, 0, 4>(3, Ks, Vs, qf, o, m_run, l_run, fbase, sl8, fr, fq, troff, qnx && (kc_hi == 4), qnext);
                if (kc_hi > 4) attn_chunk<true, 0, 2>(4, Ks, Vs, qf, o, m_run, l_run, fbase, sl8, fr, fq, troff, qnx && (kc_hi == 5), qnext);
            } else {
                if (kc_lo <= 0) attn_chunk<true, 2, 4>(0, Ks, Vs, qf, o, m_run, l_run, fbase, sl8, fr, fq, troff, qnx && (kc_hi == 1), qnext);
                if (kc_lo <= 1) attn_chunk<false, 0, 4>(1, Ks, Vs, qf, o, m_run, l_run, fbase, sl8, fr, fq, troff, qnx && (kc_hi == 2), qnext);
                attn_chunk<false, 0, 4>(2, Ks, Vs, qf, o, m_run, l_run, fbase, sl8, fr, fq, troff, qnx && (kc_hi == 3), qnext);
                if (kc_hi > 3) attn_chunk<false, 0, 4>(3, Ks, Vs, qf, o, m_run, l_run, fbase, sl8, fr, fq, troff, qnx && (kc_hi == 4), qnext);
                if (kc_hi > 4) attn_chunk<true, 0, 4>(4, Ks, Vs, qf, o, m_run, l_run, fbase, sl8, fr, fq, troff, qnx && (kc_hi == 5), qnext);
            }
#pragma unroll
            for (int qt = 0; qt < 2; ++qt) { const float inv = 1.0f / quad_sum(l_run[qt]); float ss = 0.f;
                const int rr = r * 32 + qt * 16 + fr; const size_t mrow = (size_t)(b * SEQ + t0 + rr);
                bf16_t* orow = A2 + mrow * D;
#pragma unroll
                for (int dt = 0; dt < 4; ++dt) { const f32x4 v = o[dt][qt] * inv; ss += (v[0] * v[0] + v[1] * v[1]) + (v[2] * v[2] + v[3] * v[3]);
                    const int col = h * 64 + dt * 16 + fq * 4; const f32x4 gv = *(const f32x4*)(P.g_attn_out + col); const f32x4 w4 = v * gv;
                    u32x2 w; w.x = pk2(w4[0], w4[1]); w.y = pk2(w4[2], w4[3]); *(u32x2*)(orow + col) = w; }
                ss = quad_sum(ss);
                if (fq == 0 && do_atomic) __hip_atomic_fetch_add(ATTSS + mrow, ss, __ATOMIC_RELAXED, __HIP_MEMORY_SCOPE_AGENT); }
        }
        if (!more) break;
        u = un;
    }
#undef AT_LOADS
}

__device__ __forceinline__ float scan_up_add(float v, int lane) {
#pragma unroll
    for (int o = 1; o < 64; o <<= 1) { const float t = __shfl_up(v, o); v += (lane >= o) ? t : 0.f; }
    return v;
}
__device__ __forceinline__ float scan_down_add(float v, int lane) {
#pragma unroll
    for (int o = 1; o < 64; o <<= 1) { const float t = __shfl_down(v, o); v += (lane + o < 64) ? t : 0.f; }
    return v;
}
__device__ __forceinline__ float scan_up_max(float v, int lane) {
#pragma unroll
    for (int o = 1; o < 64; o <<= 1) { const float t = __shfl_up(v, o); v = (lane >= o) ? fmaxf(v, t) : v; }
    return v;
}
__device__ __forceinline__ float scan_down_max(float v, int lane) {
#pragma unroll
    for (int o = 1; o < 64; o <<= 1) { const float t = __shfl_down(v, o); v = (lane + o < 64) ? fmaxf(v, t) : v; }
    return v;
}
__device__ __forceinline__ float wave_max(float v) {
#pragma unroll
    for (int o = 1; o < 64; o <<= 1) v = fmaxf(v, __shfl_xor(v, o));
    return v;
}
__device__ __forceinline__ void conv8(const u32x4& x0, const u32x4& x1, const u32x4& x2, const float* cw, const float* cb, int ch0, float (&r8)[8]) {
#pragma unroll
    for (int e2 = 0; e2 < 2; ++e2) { const f32x4 w0 = *(const f32x4*)(cw + ch0 + 4 * e2), w1 = *(const f32x4*)(cw + 1024 + ch0 + 4 * e2), w2 = *(const f32x4*)(cw + 2048 + ch0 + 4 * e2), bb = *(const f32x4*)(cb + ch0 + 4 * e2);
#pragma unroll
        for (int e = 0; e < 4; ++e) { const int ee = e2 * 4 + e; const unsigned sh = 16 * (ee & 1);
            const float a0 = bf2f((x0[ee >> 1] >> sh) & 0xffffu), a1 = bf2f((x1[ee >> 1] >> sh) & 0xffffu), a2 = bf2f((x2[ee >> 1] >> sh) & 0xffffu);
            float v = a0 * w0[e]; v += a1 * w1[e]; v += a2 * w2[e]; v += bb[e]; r8[ee] = silu_f(v); } }
}
__device__ __forceinline__ void mstate_unit(const Params& P, LAS unsigned char* lds, int unit, int tid, int wave, int lane) {
    const int b = unit >> 8, c = (unit >> 2) & 63, h = unit & 3;
    LAS bf16_t* Kwf = (LAS bf16_t*)lds; LAS bf16_t* Kwb = (LAS bf16_t*)(lds + 36864); LAS bf16_t* Vs = (LAS bf16_t*)(lds + 73728);
    LAS float* wf = (LAS float*)(lds + 110592); LAS float* wb = wf + 128;
    unsigned char* ws = P.ws;
    const bf16_t* PROJ = (const bf16_t*)(ws + WS_PROJ); const float* GATES = (const float*)(ws + WS_GATES);
    float* GV = (float*)(ws + WS_GV); float* SC = (float*)(ws + WS_SC); float* NC = (float*)(ws + WS_NC); bf16_t* KVC = (bf16_t*)P.out;
    bf16_t* QM = (bf16_t*)(ws + WS_QM); bf16_t* KM = (bf16_t*)(ws + WS_KM);
    const size_t m0 = (size_t)b * SEQ + (size_t)c * 128;
    const int fr = lane & 15, fq = lane >> 4;
    __syncthreads();
    float gi0 = 0.f, gf0 = 0.f, gi1 = 0.f, gf1 = 0.f;
    if (wave < 2) { const float* gp = GATES + (m0 + lane) * 16 + wave * 8 + h; gi0 = gp[0]; gf0 = gp[4]; gi1 = gp[64 * 16]; gf1 = gp[64 * 16 + 4]; }
    u32x4 xk[3][3], xv[3];
#define MS_LOAD(it, j) do { const int idx = tid + 512 * (it), s = idx >> 4, part = idx & 15; const int t = c * 128 + s; const bf16_t* rowm = PROJ + (m0 + s) * NPROJ; \
        const int pk = 1280 + h * 128 + part * 8; const u32x4 z = {0u, 0u, 0u, 0u}; \
        xk[j][1] = *(const u32x4*)(rowm + pk); xv[j] = *(const u32x4*)(rowm + 1792 + h * 128 + part * 8); \
        xk[j][0] = z; xk[j][2] = z; \
        if (t > 0) { xk[j][0] = *(const u32x4*)(rowm - NPROJ + pk); } \
        if (t < SEQ - 1) { xk[j][2] = *(const u32x4*)(rowm + NPROJ + pk); } } while (0)
    MS_LOAD(0, 0); MS_LOAD(1, 1);
    if (wave < 2) {
        const float l0 = logsig_f(gf0), l1 = logsig_f(gf1); float p0, p1, tot;
        if (wave == 0) { p0 = scan_up_add(l0, lane); const float t0 = __shfl(p0, 63); p1 = scan_up_add(l1, lane) + t0; tot = __shfl(p1, 63); }
        else { p1 = scan_down_add(l1, lane); const float t1 = __shfl(p1, 0); p0 = scan_down_add(l0, lane) + t1; tot = __shfl(p0, 0); }
        const float u0 = gi0 - p0, u1 = gi1 - p1; const float umax = wave_max(fmaxf(u0, u1));
        LAS float* wv = wave ? wb : wf; wv[lane] = __expf(u0 - umax); wv[64 + lane] = __expf(u1 - umax);
        float* gv = GV + (size_t)unit * 512 + wave * 128; gv[lane] = u0; gv[64 + lane] = u1; gv[256 + lane] = p0; gv[256 + 64 + lane] = p1;
        if (lane == 0) { float* sc = SC + unit * 4 + wave * 2; sc[0] = tot; sc[1] = tot + umax; }
    }
    __syncthreads();
#define MS_COMPUTE(it, j) do { const int idx = tid + 512 * (it), s = idx >> 4, part = idx & 15; const float wfs = wf[s], wbs = wb[s]; float r8[8]; \
        conv8(xk[j][0], xk[j][1], xk[j][2], P.conv_w, P.conv_b, 512 + h * 128 + part * 8, r8); \
        { u32x4 w; w.x = pk2(r8[0], r8[1]); w.y = pk2(r8[2], r8[3]); w.z = pk2(r8[4], r8[5]); w.w = pk2(r8[6], r8[7]); *(u32x4*)(KM + (m0 + s) * 512 + h * 128 + part * 8) = w; \
          u32x4 a; a.x = pk2(r8[0] * wfs, r8[1] * wfs); a.y = pk2(r8[2] * wfs, r8[3] * wfs); a.z = pk2(r8[4] * wfs, r8[5] * wfs); a.w = pk2(r8[6] * wfs, r8[7] * wfs); *(LAS u32x4*)(Kwf + s * 144 + part * 8) = a; \
          u32x4 bq; bq.x = pk2(r8[0] * wbs, r8[1] * wbs); bq.y = pk2(r8[2] * wbs, r8[3] * wbs); bq.z = pk2(r8[4] * wbs, r8[5] * wbs); bq.w = pk2(r8[6] * wbs, r8[7] * wbs); *(LAS u32x4*)(Kwb + s * 144 + part * 8) = bq; } \
        *(LAS u32x4*)(Vs + s * 144 + part * 8) = xv[j]; } while (0)
    MS_LOAD(2, 2); MS_COMPUTE(0, 0);
    MS_LOAD(3, 0); MS_COMPUTE(1, 1);
    MS_COMPUTE(2, 2); MS_COMPUTE(3, 0);
#undef MS_LOAD
#undef MS_COMPUTE
    __syncthreads();
    {
        const int dir = wave >> 2, wq = wave & 3, vt0 = wq * 2; const LAS bf16_t* Kw = dir ? Kwb : Kwf;
        const int troff = (fq * 4 + ((lane >> 2) & 3)) * 144 + (lane & 3) * 4;
        const unsigned onev = (fr == 0) ? 0x3f803f80u : 0u; const bf16x8 ones = mk8(onev, onev, onev, onev);
        f32x4 acc[2][8], nacc[2];
#pragma unroll
        for (int vi = 0; vi < 2; ++vi) { nacc[vi] = (f32x4){0.f, 0.f, 0.f, 0.f};
#pragma unroll
            for (int kt = 0; kt < 8; ++kt) acc[vi][kt] = (f32x4){0.f, 0.f, 0.f, 0.f}; }
#pragma unroll
        for (int ks = 0; ks < 4; ++ks) { const LAS bf16_t* vp = Vs + ks * 32 * 144 + troff + vt0 * 16; const LAS bf16_t* kp = Kw + ks * 32 * 144 + troff;
            const u32x2 l0 = tr_read(vp), h0 = tr_read(vp + 16 * 144), l1 = tr_read(vp + 16), h1 = tr_read(vp + 16 * 144 + 16);
            const bf16x8 a0 = mk8(l0.x, l0.y, h0.x, h0.y), a1 = mk8(l1.x, l1.y, h1.x, h1.y);
#pragma unroll
            for (int kt = 0; kt < 8; ++kt) { const u32x2 bl = tr_read(kp + kt * 16), bh = tr_read(kp + 16 * 144 + kt * 16); const bf16x8 bb = mk8(bl.x, bl.y, bh.x, bh.y);
                acc[0][kt] = mfma16(a0, bb, acc[0][kt]); acc[1][kt] = mfma16(a1, bb, acc[1][kt]);
                if ((kt >> 1) == wq) nacc[kt & 1] = mfma16(ones, bb, nacc[kt & 1]); } }
        bf16_t* outp = KVC + (size_t)(unit * 2 + dir) * 16384;
#pragma unroll
        for (int vi = 0; vi < 2; ++vi)
#pragma unroll
            for (int kt = 0; kt < 8; ++kt)
#pragma unroll
                for (int i = 0; i < 4; i += 2) { const unsigned pq = pk2(acc[vi][kt][i], acc[vi][kt][i + 1]);
                    outp[((vt0 + vi) * 16 + fq * 4 + i) * 128 + kt * 16 + fr] = (bf16_t)(pq & 0xffffu); outp[((vt0 + vi) * 16 + fq * 4 + i + 1) * 128 + kt * 16 + fr] = (bf16_t)(pq >> 16); }
        if (fq == 0) { float* np = NC + (size_t)(unit * 2 + dir) * 128 + wq * 32 + fr; np[0] = nacc[0][0]; np[16] = nacc[1][0]; }
    }
}

__device__ __forceinline__ void scan_phase(const Params& P, int tid) {
    unsigned char* ws = P.ws;
    const bf16_t* KVC = (const bf16_t*)P.out; const float* SC = (const float*)(ws + WS_SC); const float* NC = (const float*)(ws + WS_NC);
    bf16_t* CPREV = (bf16_t*)(ws + WS_XN); float* NPREV = (float*)(ws + WS_NPREV); float* MPREV = (float*)(ws + WS_MPREV);
    for (int blk = blockIdx.x; blk < 256; blk += gridDim.x) {
        const int seq = blk >> 4, e2 = (blk & 15) * NTHREADS + tid, b = seq >> 3, h = (seq >> 1) & 3, dir = seq & 1;
        const int off = (e2 >> 6) * 128 + (e2 & 63) * 2;
        const bool do_n = e2 < 128;
        float c0 = 0.f, c1 = 0.f, nst = 0.f, mst = 0.f;
        for (int jb = 0; jb < 64; jb += 16) {
            f32x2_t kv[16]; float bl[16], am[16], nn[16];
#pragma unroll
            for (int u = 0; u < 16; ++u) { const int j = jb + u, cidx = dir ? 63 - j : j, unit = (b * 64 + cidx) * 4 + h;
                { const unsigned pq = *(const unsigned*)(KVC + (size_t)(unit * 2 + dir) * 16384 + off); kv[u] = (f32x2_t){bf2f(pq & 0xffffu), bf2f(pq >> 16)}; }
                bl[u] = SC[unit * 4 + dir * 2]; am[u] = SC[unit * 4 + dir * 2 + 1]; nn[u] = do_n ? NC[(size_t)(unit * 2 + dir) * 128 + e2] : 0.f; }
#pragma unroll
            for (int u = 0; u < 16; ++u) { const int j = jb + u, cidx = dir ? 63 - j : j, unit = (b * 64 + cidx) * 4 + h;
                *(unsigned*)(CPREV + (size_t)(unit * 2 + dir) * 16384 + off) = pk2(c0, c1);
                if (do_n) NPREV[(size_t)(unit * 2 + dir) * 128 + e2] = nst;
                if (e2 == 0) MPREV[unit * 2 + dir] = mst;
                const float m_new = fmaxf(bl[u] + mst, am[u]); const float dec = __expf(bl[u] + mst - m_new), inj = __expf(am[u] - m_new);
                c0 = dec * c0 + inj * kv[u][0]; c1 = dec * c1 + inj * kv[u][1]; nst = dec * nst + inj * nn[u]; mst = m_new; }
        }
    }
}

__device__ __forceinline__ void mout_unit(const Params& P, LAS unsigned char* lds, int unit, int tid, int wave, int lane) {
    const int b = unit >> 8, c = (unit >> 2) & 63, h = unit & 3;
    LAS bf16_t* Ks = (LAS bf16_t*)lds;
    LAS bf16_t* Vs = (LAS bf16_t*)(lds + 34816);
    LAS bf16_t* Cf = (LAS bf16_t*)(lds + 71680);
    LAS bf16_t* Cb = (LAS bf16_t*)(lds + 106496);
    LAS float* fa = (LAS float*)(lds + 141312);
    LAS float* uf = fa; LAS float* ub = fa + 128; LAS float* Mf = fa + 256; LAS float* Mb = fa + 384; LAS float* inf_ = fa + 512; LAS float* inb = fa + 640;
    LAS float* emf = fa + 768; LAS float* emb = fa + 896; LAS float* npf = fa + 1024; LAS float* npb = fa + 1152;
    unsigned char* ws = P.ws;
    const bf16_t* PROJ = (const bf16_t*)(ws + WS_PROJ); const bf16_t* QM = (const bf16_t*)(ws + WS_QM); const bf16_t* KM = (const bf16_t*)(ws + WS_KM);
    const bf16_t* CPREV = (const bf16_t*)(ws + WS_XN); const float* NPREV = (const float*)(ws + WS_NPREV); const float* MPREV = (const float*)(ws + WS_MPREV);
    const float* GV = (const float*)(ws + WS_GV); bf16_t* A2 = (bf16_t*)(ws + WS_A2);
    const size_t m0 = (size_t)b * SEQ + (size_t)c * 128;
    const int fr = lane & 15, fq = lane >> 4;
    const int t = wave * 16 + fr;
    __syncthreads();
    u32x4 rk[4], rv[4], rcf[4], rcb[4];
#pragma unroll
    for (int it = 0; it < 4; ++it) { const int idx = tid + 512 * it, s = idx >> 4, part = idx & 15;
        rk[it] = *(const u32x4*)(KM + (m0 + s) * 512 + h * 128 + part * 8); rv[it] = *(const u32x4*)(PROJ + (m0 + s) * NPROJ + 1792 + h * 128 + part * 8);
        rcf[it] = *(const u32x4*)(CPREV + (size_t)(unit * 2) * 16384 + s * 128 + part * 8); rcb[it] = *(const u32x4*)(CPREV + (size_t)(unit * 2 + 1) * 16384 + s * 128 + part * 8); }
    u32x4 xq[4][3];
    { const int pos = c * 128 + t; const bf16_t* rowq = PROJ + (m0 + t) * NPROJ + 768 + h * 128 + fq * 8;
#pragma unroll
      for (int kk = 0; kk < 4; ++kk) { const u32x4 z = {0u, 0u, 0u, 0u}; xq[kk][1] = *(const u32x4*)(rowq + kk * 32); xq[kk][0] = z; xq[kk][2] = z;
          if (pos > 0) xq[kk][0] = *(const u32x4*)(rowq - NPROJ + kk * 32); if (pos < SEQ - 1) xq[kk][2] = *(const u32x4*)(rowq + NPROJ + kk * 32); } }
    if (wave < 2) {
        const float* gv = GV + (size_t)unit * 512 + wave * 128; const float u0 = gv[lane], u1 = gv[64 + lane], bc0 = gv[256 + lane], bc1 = gv[256 + 64 + lane];
        const float mp = MPREV[unit * 2 + wave]; float a0, a1;
        if (wave == 0) { a0 = fmaxf(scan_up_max(u0, lane), mp); const float cr = __shfl(a0, 63); a1 = fmaxf(scan_up_max(u1, lane), cr); }
        else { a1 = fmaxf(scan_down_max(u1, lane), mp); const float cr = __shfl(a1, 0); a0 = fmaxf(scan_down_max(u0, lane), cr); }
        LAS float* ua = wave ? ub : uf; LAS float* Ma = wave ? Mb : Mf; LAS float* ia = wave ? inb : inf_; LAS float* ea = wave ? emb : emf;
        ua[lane] = u0; ua[64 + lane] = u1; Ma[lane] = a0; Ma[64 + lane] = a1; ia[lane] = __expf(mp - a0); ia[64 + lane] = __expf(mp - a1);
        ea[lane] = __expf(-(bc0 + a0)); ea[64 + lane] = __expf(-(bc1 + a1));
    } else if (wave == 2) { npf[lane] = NPREV[(size_t)(unit * 2) * 128 + lane]; npf[64 + lane] = NPREV[(size_t)(unit * 2) * 128 + 64 + lane];
        npb[lane] = NPREV[(size_t)(unit * 2 + 1) * 128 + lane]; npb[64 + lane] = NPREV[(size_t)(unit * 2 + 1) * 128 + 64 + lane]; }
#pragma unroll
    for (int it = 0; it < 4; ++it) { const int idx = tid + 512 * it, s = idx >> 4, part = idx & 15;
        *(LAS u32x4*)(Ks + s * 136 + part * 8) = rk[it]; *(LAS u32x4*)(Vs + s * 144 + part * 8) = rv[it];
        *(LAS u32x4*)(Cf + s * 136 + part * 8) = rcf[it]; *(LAS u32x4*)(Cb + s * 136 + part * 8) = rcb[it]; }
    __syncthreads();
    bf16x8 qf[4];
#pragma unroll
    for (int kk = 0; kk < 4; ++kk) { float r8[8]; conv8(xq[kk][0], xq[kk][1], xq[kk][2], P.conv_w, P.conv_b, h * 128 + kk * 32 + fq * 8, r8);
        const float sc = 0.08838834764831845f;
        qf[kk] = mk8(pk2(r8[0] * sc, r8[1] * sc), pk2(r8[2] * sc, r8[3] * sc), pk2(r8[4] * sc, r8[5] * sc), pk2(r8[6] * sc, r8[7] * sc)); }
    float qnf = 0.f, qnb = 0.f;
#pragma unroll
    for (int kk = 0; kk < 4; ++kk) { const u32x4 qq = __builtin_bit_cast(u32x4, qf[kk]);
#pragma unroll
        for (int j = 0; j < 8; ++j) { const float qv = bf2f((qq[j >> 1] >> (16 * (j & 1))) & 0xffffu); const int d = kk * 32 + fq * 8 + j; qnf += qv * npf[d]; qnb += qv * npb[d]; } }
    qnf = quad_sum(qnf); qnb = quad_sum(qnb);
    f32x4 sT[8];
#pragma unroll
    for (int st = 0; st < 8; ++st) { f32x4 a = {0.f, 0.f, 0.f, 0.f};
#pragma unroll
        for (int kk = 0; kk < 4; ++kk) a = mfma16(*(const LAS bf16x8*)(Ks + (st * 16 + fr) * 136 + kk * 32 + fq * 8), qf[kk], a);
        sT[st] = a; }
    const int troff = (fq * 4 + ((lane >> 2) & 3)) * 144 + (lane & 3) * 4;
    f32x4 hsum[8];
#pragma unroll
    for (int vt = 0; vt < 8; ++vt) hsum[vt] = (f32x4){0.f, 0.f, 0.f, 0.f};
#pragma unroll 1
    for (int dir = 0; dir < 2; ++dir) {
        f32x4 acc[8];
        const LAS bf16_t* Cp = dir ? Cb : Cf;
#pragma unroll
        for (int vt = 0; vt < 8; ++vt) { f32x4 a = {0.f, 0.f, 0.f, 0.f};
#pragma unroll
            for (int kk = 0; kk < 4; ++kk) a = mfma16(*(const LAS bf16x8*)(Cp + (vt * 16 + fr) * 136 + kk * 32 + fq * 8), qf[kk], a);
            acc[vt] = a; }
        const float inter = dir ? inb[t] : inf_[t], Mt = dir ? Mb[t] : Mf[t];
#pragma unroll
        for (int vt = 0; vt < 8; ++vt) acc[vt] *= inter;
        float den = 0.f; unsigned pk[8][2];
#pragma unroll
        for (int st = 0; st < 8; ++st) { const f32x4 uu = *(const LAS f32x4*)((dir ? ub : uf) + st * 16 + fq * 4); float p[4];
#pragma unroll
            for (int i = 0; i < 4; ++i) { const int s = st * 16 + fq * 4 + i; const bool ok = dir ? (s >= t) : (s <= t); const float w = ok ? __expf(uu[i] - Mt) : 0.f; p[i] = sT[st][i] * w; den += p[i]; }
            pk[st][0] = pk2(p[0], p[1]); pk[st][1] = pk2(p[2], p[3]); }
        den = quad_sum(den) + inter * (dir ? qnb : qnf);
        const int ks_lo = dir ? (wave >> 1) : 0, ks_hi = dir ? 3 : (wave >> 1);
#pragma unroll
        for (int ks = 0; ks < 4; ++ks) if (ks >= ks_lo && ks <= ks_hi) { const bf16x8 bfrag = mk8(pk[2 * ks][0], pk[2 * ks][1], pk[2 * ks + 1][0], pk[2 * ks + 1][1]);
            const LAS bf16_t* vp = Vs + ks * 32 * 144 + troff;
#pragma unroll
            for (int vt = 0; vt < 8; ++vt) { const u32x2 lo = tr_read(vp + vt * 16), hi = tr_read(vp + 16 * 144 + vt * 16);
                acc[vt] = mfma16(mk8(lo.x, lo.y, hi.x, hi.y), bfrag, acc[vt]); } }
        const float rd = 1.0f / fmaxf(fabsf(den), dir ? emb[t] : emf[t]);
#pragma unroll
        for (int vt = 0; vt < 8; ++vt) hsum[vt] += acc[vt] * rd;
    }
    float ss = 0.f;
#pragma unroll
    for (int vt = 0; vt < 8; ++vt) { const f32x4 v = hsum[vt]; ss += (v[0] * v[0] + v[1] * v[1]) + (v[2] * v[2] + v[3] * v[3]); }
    const float rstd = rsqrtf(quad_sum(ss) * (1.0f / 128.0f) + EPS) * sqrtf(((const float*)(ws + WS_ATTSS))[m0 + t] * (1.0f / 512.0f) + EPS);
#pragma unroll
    for (int vt = 0; vt < 8; ++vt) { const int v0 = h * 128 + vt * 16 + fq * 4; const f32x4 gv = *(const f32x4*)(P.g_mlstm_out + v0);
        const u32x2 om = *(const u32x2*)(PROJ + (m0 + t) * NPROJ + 2304 + v0);
        const float o0 = sigmoid_f(bf2f(om.x & 0xffffu)), o1 = sigmoid_f(bf2f(om.x >> 16)), o2 = sigmoid_f(bf2f(om.y & 0xffffu)), o3 = sigmoid_f(bf2f(om.y >> 16));
        const f32x4 v = hsum[vt] * rstd * gv; u32x2 w; w.x = pk2(v[0] * o0, v[1] * o1); w.y = pk2(v[2] * o2, v[3] * o3);
        *(u32x2*)(A2 + (m0 + t) * D + 512 + v0) = w; }
}

#define XB_TMO      128
#define XB_XCNT(j)  (256  + 64 * (j))
#define XB_XSUB(j)  (1280 + 64 * (j))
#define XB_XGEN(j)  (2304 + 64 * (j))
#define XB_TOP      3328
#define XB_TOPGEN   3392
#define XCD_BAR_WORDS 3456
#define XB_SPIN_CAP (1u << 18)

__device__ __forceinline__ unsigned xb_ld(unsigned* p)              { return __hip_atomic_load(p, __ATOMIC_RELAXED, __HIP_MEMORY_SCOPE_AGENT); }
__device__ __forceinline__ unsigned xb_add(unsigned* p, unsigned v) { return __hip_atomic_fetch_add(p, v, __ATOMIC_RELAXED, __HIP_MEMORY_SCOPE_AGENT); }
__device__ __forceinline__ unsigned xb_xcc_id() { return (unsigned)__builtin_amdgcn_s_getreg((3 << 11) | 20) & 0xFu; }
#define XB_SPIN(cond, bar) do { unsigned _sp = 0; while (cond) { __builtin_amdgcn_s_sleep(1); \
    if ((++_sp & 255u) == 0u) { if (xb_ld(&(bar)[XB_TMO])) break; if (_sp > XB_SPIN_CAP) { atomicAdd(&(bar)[XB_TMO], 1u); break; } } } } while (0)

struct XcdBarrier {
    unsigned* bar; unsigned x;
    volatile LAS unsigned* st;
};

__device__ __forceinline__ XcdBarrier xcd_barrier_post(unsigned* bar, volatile LAS unsigned* st) {
    XcdBarrier b; b.bar = bar; b.x = xb_xcc_id(); b.st = st;
    if (threadIdx.x == 0) (void)xb_add(&bar[XB_XCNT(b.x)], 1u);
    return b;
}
__device__ __forceinline__ void xcd_barrier_complete(unsigned* bar, unsigned x, unsigned& nloc, unsigned& nx) {
    const unsigned G = gridDim.x * gridDim.y * gridDim.z;
    unsigned sum, cnt, mine, sp = 0u;
    for (;;) {
        sum = 0u; cnt = 0u; mine = 0u;
#pragma unroll
        for (unsigned j = 0; j < 16; ++j) { const unsigned c = xb_ld(&bar[XB_XCNT(j)]); sum += c; cnt += (c > 0u) ? 1u : 0u; mine = (j == x) ? c : mine; }
        if (sum == G) break;
        __builtin_amdgcn_s_sleep(1);
        if ((++sp & 255u) == 0u) { if (xb_ld(&bar[XB_TMO])) break; if (sp > XB_SPIN_CAP) { atomicAdd(&bar[XB_TMO], 1u); break; } }
    }
    nloc = mine > 0u ? mine : 1u; nx = cnt > 0u ? cnt : 1u;
}

__device__ __forceinline__ void xcd_barrier(const XcdBarrier& b) {
    asm volatile("s_waitcnt vmcnt(0)" ::: "memory");
    __syncthreads();
    if (threadIdx.x == 0) {
        unsigned* bar = b.bar;
        __builtin_amdgcn_s_waitcnt(0);
        unsigned nloc = b.st[0], nx = b.st[1];
        if (nloc == 0u) { xcd_barrier_complete(bar, b.x, nloc, nx); b.st[0] = nloc; b.st[1] = nx; }
        const unsigned old = xb_add(&bar[XB_XSUB(b.x)], 1u);
        const unsigned gen = old / nloc;
        if (old + 1u == (gen + 1u) * nloc) {
            __builtin_amdgcn_fence(__ATOMIC_RELEASE, "agent");
            asm volatile("s_waitcnt vmcnt(0)" ::: "memory");
            const unsigned og = xb_add(&bar[XB_TOP], 1u);
            const unsigned tg = og / nx;
            if (og + 1u == (tg + 1u) * nx) xb_add(&bar[XB_TOPGEN], 1u);
            else XB_SPIN(xb_ld(&bar[XB_TOPGEN]) == tg, bar);
            __builtin_amdgcn_fence(__ATOMIC_ACQUIRE, "agent");
            xb_add(&bar[XB_XGEN(b.x)], 1u);
            asm volatile("s_waitcnt vmcnt(0)" ::: "memory");
        } else {
            XB_SPIN(xb_ld(&bar[XB_XGEN(b.x)]) == gen, bar);
            __builtin_amdgcn_fence(__ATOMIC_ACQUIRE, "agent");
            asm volatile("s_waitcnt vmcnt(0)" ::: "memory");
        }
    }
    __syncthreads();
}

__global__ void __launch_bounds__(NTHREADS) hybrid_fwd(Params P) {
    extern __shared__ __attribute__((aligned(16))) unsigned char lds_raw[];
    LAS unsigned char* lds = (LAS unsigned char*)lds_raw;
    cg::grid_group grid = cg::this_grid();
    const int tid = threadIdx.x, lane = tid & 63, wave = __builtin_amdgcn_readfirstlane(tid >> 6);
    volatile LAS unsigned* bst = (volatile LAS unsigned*)(lds + LDS_BYTES - 64);
    if (tid < 2) bst[tid] = 0u;
    __syncthreads();
    XcdBarrier bar = xcd_barrier_post((unsigned*)(P.ws + WS_BAR), bst);
    if (P.ph_lo < 0) grid.sync();
    unsigned char* ws = P.ws;
    const int vcu = ((int)gridDim.x % 8 == 0) ? ((int)blockIdx.x % 8) * ((int)gridDim.x / 8) + (int)blockIdx.x / 8 : (int)blockIdx.x;
    const float* MOD = (const float*)(ws + WS_MOD);
    bf16_t* XN = (bf16_t*)(ws + WS_XN);
#ifndef WGM_P2
#define WGM_P2 8
#endif
#ifndef WGM_P6
#define WGM_P6 8
#endif
#ifndef WGM_P8
#define WGM_P8 2
#endif
#ifndef WGM_P9
#define WGM_P9 8
#endif
#ifndef DUP_MASK
#define DUP_MASK 0
#endif
#ifndef PH_MASK
#define PH_MASK 0x7ff
#endif
#define IN(k) (((PH_MASK >> (k)) & 1) && P.ph_lo <= (k) && (k) < P.ph_hi)
#define SEAM(k) do { if (IN(k) && IN((k) + 1)) xcd_barrier(bar); } while (0)
    if (IN(0)) { for (int rep = 0; rep < 1 + ((DUP_MASK >> 0) & 1); ++rep) { phase0(P, lds, tid, wave, lane); __syncthreads(); } } SEAM(0);
    if (IN(1)) { for (int i = blockIdx.x * NTHREADS + tid; i < M; i += gridDim.x * NTHREADS) { ((float*)(ws + WS_ATTSS))[i] = 0.f; ((float*)(ws + WS_SS2))[i] = 0.f; ((float*)(ws + WS_SS3))[i] = 0.f; }
        for (int rep = 0; rep < 1 + ((DUP_MASK >> 1) & 1); ++rep) norm_mod_phase(P.x, P.g_norm1, MOD, 0, 1024, XN, wave, lane); } SEAM(1);
    if (IN(2)) for (int rep = 0; rep < 1 + ((DUP_MASK >> 2) & 1); ++rep) {
        pg8::Gemm g{XN, (const bf16_t*)(ws + WS_WIN), M, NPROJ, D}; pg8::StaticOrder S; S.init(M, NPROJ, (int)gridDim.x, (int)blockIdx.x, WGM_P2);
        EpiProj E{(bf16_t*)(ws + WS_PROJ), (float*)(ws + WS_GATES), P.b_gates};
        pg8::gemm_phase<EpiProj, pg8::StaticOrder, true, true>(lds, g, S, E);
    } SEAM(2);
    if (IN(3)) {
        for (int rep = 0; rep < 1 + ((DUP_MASK >> 11) & 1); ++rep) attn_phase(P, lds, tid, wave, lane, rep == 0);
        for (int rep = 0; rep < 1 + ((DUP_MASK >> 12) & 1); ++rep)
        for (int u = vcu; u < 512; u += gridDim.x) mstate_unit(P, lds, u, tid, wave, lane);
    } SEAM(3);
    if (IN(4)) { for (int rep = 0; rep < 1 + ((DUP_MASK >> 4) & 1); ++rep) scan_phase(P, tid); } SEAM(4);
    if (IN(5)) { for (int rep = 0; rep < 1 + ((DUP_MASK >> 5) & 1); ++rep) for (int u = vcu; u < 512; u += gridDim.x) mout_unit(P, lds, u, tid, wave, lane); } SEAM(5);
    if (IN(6)) for (int rep = 0; rep < 1 + ((DUP_MASK >> 6) & 1); ++rep) {
        __syncthreads();
        pg8::Gemm g{(const bf16_t*)(ws + WS_A2), (const bf16_t*)(ws + WS_WOUT), M, D, D}; pg8::StaticOrder S; S.init(M, D, (int)gridDim.x, (int)blockIdx.x, WGM_P6);
        EpiResidNorm E{P.x, P.out, MOD + 2048, (const float*)(ws + WS_ATTSS), (float*)(ws + WS_SS2), (unsigned*)(ws + WS_CNT), P.g_norm2, MOD + 4096, MOD + 3072, XN, nullptr, (bf16_t*)(ws + WS_QM)};
        pg8::gemm_phase<EpiResidNorm, pg8::StaticOrder, false, true>(lds, g, S, E);
    } do { if (IN(6) && IN(8)) xcd_barrier(bar); } while (0);
    if (IN(8)) for (int rep = 0; rep < 1 + ((DUP_MASK >> 8) & 1); ++rep) {
        pg8::Gemm g{XN, (const bf16_t*)(ws + WS_WFI), M, 2 * DFF, D}; pg8::StaticOrder S; S.init(M, 2 * DFF, (int)gridDim.x, (int)blockIdx.x, WGM_P8);
        EpiSwiglu E{(bf16_t*)(ws + WS_PROJ)};
        pg8::gemm_phase<EpiSwiglu, pg8::StaticOrder, true, true>(lds, g, S, E);
    } SEAM(8);
    if (IN(9)) {
        pg8::Gemm g{(const bf16_t*)(ws + WS_PROJ), (const bf16_t*)(ws + WS_WFO), M, D, DFF}; pg8::StaticOrder S; S.init(M, D, (int)gridDim.x, (int)blockIdx.x, WGM_P9);
        EpiResidNorm E{nullptr, P.out, MOD + 5120, nullptr, (float*)(ws + WS_SS3), (unsigned*)(ws + WS_CNT) + 1024, P.g_final, nullptr, nullptr, nullptr, (const bf16_t*)(ws + WS_QM), nullptr};
        pg8::gemm_phase<EpiResidNorm, pg8::StaticOrder, false, true>(lds, g, S, E);
    }
#undef IN
#undef SEAM
}

#ifndef MK_LAUNCHES
#define MK_LAUNCHES 1
#endif
extern "C" void kernel_launch(void* const* d_in, const int* in_sizes, int n_in, void* d_out, int out_size, void* d_ws, size_t ws_size, hipStream_t stream) {
    static int ready = 0;
    if (!ready) {
        if (n_in != 17 || out_size != M * D || ws_size < WS_END) { fprintf(stderr, "kernel_launch: unexpected shapes (n_in %d out %d ws %zu)\n", n_in, out_size, ws_size); ready = -1; return; }
        if (hipFuncSetAttribute((const void*)hybrid_fwd, hipFuncAttributeMaxDynamicSharedMemorySize, LDS_BYTES) != hipSuccess) { fprintf(stderr, "kernel_launch: hipFuncSetAttribute failed\n"); ready = -1; return; }
        ready = 1;
    }
    if (ready < 0) return;
    Params p{};
    const float** pp = (const float**)&p;
    for (int i = 0; i < 17; ++i) pp[i] = (const float*)d_in[i];
    p.out = (float*)d_out; p.ws = (unsigned char*)d_ws;
    (void)hipMemsetAsync((unsigned char*)d_ws + WS_BAR, 0, 32768, stream);
#if MK_LAUNCHES == 1
    p.ph_lo = 0; p.ph_hi = NPHASES;
    void* args[] = {&p};
    hipError_t e = hipLaunchCooperativeKernel((const void*)hybrid_fwd, dim3(256), dim3(NTHREADS), args, LDS_BYTES, stream);
    if (e != hipSuccess) fprintf(stderr, "cooperative launch failed: %s\n", hipGetErrorString(e));
#else
    for (int k = 0; k < NPHASES; ++k) { p.ph_lo = k; p.ph_hi = k + 1; void* args[] = {&p};
        hipError_t e = hipLaunchCooperativeKernel((const void*)hybrid_fwd, dim3(256), dim3(NTHREADS), args, LDS_BYTES, stream);
        if (e != hipSuccess) fprintf(stderr, "launch %d failed: %s\n", k, hipGetErrorString(e)); }
#endif
}
```

```cpp
#include <hip/hip_runtime.h>
#include <hip/hip_cooperative_groups.h>
#include <cstdio>
#include <cstdint>
namespace cg = cooperative_groups;
namespace pg8 {
#define PG8_LAS __attribute__((address_space(3)))
typedef unsigned short bf16_t;
typedef short bf16x8 __attribute__((ext_vector_type(8)));
typedef float f32x4 __attribute__((ext_vector_type(4)));
typedef unsigned u32x4 __attribute__((ext_vector_type(4)));
constexpr int BM = 256, BK = 64, HALF = 128, HTB = HALF * BK * 2  , STAGE_BYTES = 8 * HTB, NXCD = 8, WGM = 8;

__host__ __device__ __forceinline__ int lds_byte(int r, int c) { const int st = (r >> 4) * 2 + (c >> 5), rr = r & 15, cc = c & 31, ob = rr * 64 + cc * 2; return st * 1024 + (ob ^ (((ob >> 9) & 1) << 5)); }
__host__ __device__ __forceinline__ void stage_rc(int b, int& R, int& C) { const int st = b / 1024, sb = b % 1024, swz = sb ^ (((sb >> 9) & 1) << 5); R = (st >> 1) * 16 + swz / 64; C = (st & 1) * 32 + (swz % 64) / 2; }
__host__ __device__ __forceinline__ int perm32(int rho) { const int n = rho >> 4, i = rho & 15; return 8 * (i >> 2) + 4 * n + (i & 3); }

struct Unit { int pm, pn; };
struct Gemm { const bf16_t* A; const bf16_t* Bt; int M, N, K; };

struct StaticOrder {
    int nM, nN, nwg, G, c, wgm;
    __host__ __device__ void init(int M, int N, int G_, int c_, int wgm_ = WGM) { nM = M / BM; nN = N / BM; nwg = nM * nN; G = G_; c = c_; wgm = wgm_; }
    __host__ __device__ bool next(int i, Unit& u) const {
        const long L = (long)i * G + c; if (L >= nwg) return false;
        int wgid = (int)L; { const int q = nwg / NXCD, r = nwg % NXCD, xcd = wgid % NXCD, off = wgid / NXCD; wgid = (xcd < r ? xcd * (q + 1) : r * (q + 1) + (xcd - r) * q) + off; }
        const int nig = wgm * nN, gid = wgid / nig, fm = gid * wgm, gsz = (nM - fm) < wgm ? (nM - fm) : wgm;
        u.pm = fm + ((wgid % nig) % gsz); u.pn = (wgid % nig) / gsz; return true;
    }
    __device__ __forceinline__ void a_ready(const Unit&) const {}
    __device__ __forceinline__ void done(const Unit&) const {}
};

__device__ __forceinline__ unsigned cvt_pk_bf16(float lo, float hi) { unsigned r; asm volatile("v_cvt_pk_bf16_f32 %0, %1, %2" : "=v"(r) : "v"(lo), "v"(hi)); return r; }
typedef float f32x2 __attribute__((ext_vector_type(2)));
template <class Epi, class Sched, bool ALIGN_EPI = false, bool SP2 = false>
__device__ __forceinline__ void gemm_phase(PG8_LAS unsigned char* lds, const Gemm g, const Sched& S, const Epi& E) {
    const int tid = threadIdx.x, wid = __builtin_amdgcn_readfirstlane(tid >> 6), lane = tid & 63, wr = wid >> 2, wc = wid & 3, fr = lane & 15, fq = lane >> 4;
    const int K = g.K, nt = K / BK;
    unsigned voffA[2], voffB[2];
#pragma unroll
    for (int i = 0; i < 2; ++i) { int R, C; stage_rc(tid * 16 + i * 8192, R, C); const int Rb = Epi::PERM ? ((R & ~31) + perm32(R & 31)) : R;
        voffA[i] = (unsigned)(R * K + C) * 2u; voffB[i] = (unsigned)(Rb * K + C) * 2u; }
    const size_t kstep = (size_t)(BK * 2);
    const size_t hstep = (size_t)HALF * K * 2;
    const size_t tstep = 2 * hstep;
    const unsigned ldsw = (unsigned)wid * 1024u;
    const int aoff = lds_byte(wr * 64 + fr, fq * 8), boff = lds_byte(wc * 32 + fr, fq * 8);
#define PG8_SA(b, h) (((b) * 2 + (h)) * HTB)
#define PG8_SB(b, h) ((4 + (b) * 2 + (h)) * HTB)
#define PG8_STAGE(bufoff, gbase, voff) do { _Pragma("unroll") for (int _i = 0; _i < 2; ++_i) \
        __builtin_amdgcn_global_load_lds((const unsigned*)((const char*)(gbase) + (voff)[_i]), (PG8_LAS unsigned*)(lds + (bufoff) + ldsw + _i * 8192), 16, 0, 0); } while (0)
#define PG8_LDA(dst, b, h) do { _Pragma("unroll") for (int m = 0; m < 4; ++m) _Pragma("unroll") for (int k = 0; k < 2; ++k) dst[m][k] = *(const PG8_LAS bf16x8*)(lds + PG8_SA(b, h) + aoff + m * 2048 + k * 1024); } while (0)
#define PG8_LDB(dst, b, h) do { _Pragma("unroll") for (int n = 0; n < 2; ++n) _Pragma("unroll") for (int k = 0; k < 2; ++k) dst[n][k] = *(const PG8_LAS bf16x8*)(lds + PG8_SB(b, h) + boff + n * 2048 + k * 1024); } while (0)
#define PG8_MMA(ai, bj, At, Bt) do { __builtin_amdgcn_s_setprio(1); _Pragma("unroll") for (int m = 0; m < 4; ++m) _Pragma("unroll") for (int n = 0; n < 2; ++n) _Pragma("unroll") for (int k = 0; k < 2; ++k) \
        acc[ai][bj][m][n] = __builtin_amdgcn_mfma_f32_16x16x32_bf16(Bt[n][k], At[m][k], acc[ai][bj][m][n], 0, 0, 0); __builtin_amdgcn_s_setprio(0); } while (0)
#define PG8_WAIT_V(n) asm volatile("s_waitcnt vmcnt(" #n ")" ::: "memory")
#define PG8_WAIT_L(n) asm volatile("s_waitcnt lgkmcnt(" #n ")" ::: "memory")
#define PG8_BAR __builtin_amdgcn_s_barrier()
#define PG8_SCHED __builtin_amdgcn_sched_barrier(0)
    Unit cur, nxt; int ui = 0;
    if (!S.next(0, cur)) return;
    f32x4 acc[2][2][4][2];
#pragma unroll
    for (int a = 0; a < 2; ++a)
#pragma unroll
        for (int b = 0; b < 2; ++b)
#pragma unroll
            for (int m = 0; m < 4; ++m)
#pragma unroll
                for (int n = 0; n < 2; ++n) acc[a][b][m][n] = (f32x4){0.f, 0.f, 0.f, 0.f};
    bf16x8 At[4][2], B0[2][2], B1[2][2];
    const char* cA = (const char*)g.A + (size_t)cur.pm * tstep; const char* cB = (const char*)g.Bt + (size_t)cur.pn * tstep;
    S.a_ready(cur);
    if constexpr (SP2) {
        PG8_STAGE(PG8_SB(0, 0), cB, voffB); PG8_STAGE(PG8_SB(0, 1), cB + hstep, voffB); PG8_STAGE(PG8_SA(0, 0), cA, voffA); PG8_STAGE(PG8_SA(0, 1), cA + hstep, voffA);
        if (wr == 1) PG8_BAR;
        PG8_WAIT_V(2); PG8_BAR;
        PG8_STAGE(PG8_SB(1, 0), cB + kstep, voffB); PG8_STAGE(PG8_SA(1, 0), cA + kstep, voffA); PG8_STAGE(PG8_SB(1, 1), cB + hstep + kstep, voffB);
        PG8_WAIT_V(6); PG8_BAR;
    } else {
        PG8_STAGE(PG8_SB(0, 0), cB, voffB); PG8_STAGE(PG8_SA(0, 0), cA, voffA); PG8_STAGE(PG8_SB(0, 1), cB + hstep, voffB); PG8_STAGE(PG8_SA(0, 1), cA + hstep, voffA);
        if (wr == 1) PG8_BAR;
        PG8_WAIT_V(4); PG8_BAR;
        PG8_STAGE(PG8_SB(1, 0), cB + kstep, voffB); PG8_STAGE(PG8_SA(1, 0), cA + kstep, voffA); PG8_STAGE(PG8_SB(1, 1), cB + hstep + kstep, voffB);
        PG8_WAIT_V(6); PG8_BAR;
    }
    for (;;) {
        const bool has_next = S.next(ui + 1, nxt);
        const char* nA = has_next ? (const char*)g.A + (size_t)nxt.pm * tstep : cA; const char* nB = has_next ? (const char*)g.Bt + (size_t)nxt.pn * tstep : cB;
        for (int t = 0; t < nt; t += 2) {
            const bool last = (t == nt - 2);
            const char* a1 = cA + (size_t)(t + 1) * kstep;
            const char* a2 = last ? nA : cA + (size_t)(t + 2) * kstep; const char* b2 = last ? nB : cB + (size_t)(t + 2) * kstep;
            const char* a3 = a2 + kstep; const char* b3 = b2 + kstep;
            if (last && has_next) S.a_ready(nxt);
            if constexpr (SP2) {
            PG8_LDB(B0, 0, 0); PG8_LDB(B1, 0, 1); PG8_SCHED; PG8_LDA(At, 0, 0); PG8_STAGE(PG8_SA(1, 1), a1 + hstep, voffA);
            PG8_WAIT_V(8); PG8_WAIT_L(0); PG8_BAR; PG8_MMA(0, 0, At, B0); PG8_MMA(0, 1, At, B1); PG8_BAR; PG8_SCHED;
            PG8_LDA(At, 0, 1); PG8_STAGE(PG8_SB(0, 0), b2, voffB); PG8_STAGE(PG8_SB(0, 1), b2 + hstep, voffB); PG8_STAGE(PG8_SA(0, 0), a2, voffA);
            PG8_WAIT_V(8); PG8_WAIT_L(0); PG8_BAR; PG8_MMA(1, 0, At, B0); PG8_MMA(1, 1, At, B1); PG8_BAR; PG8_SCHED;
            PG8_LDB(B0, 1, 0); PG8_LDB(B1, 1, 1); PG8_SCHED; PG8_LDA(At, 1, 0); PG8_STAGE(PG8_SA(0, 1), a2 + hstep, voffA);
            PG8_WAIT_V(8); PG8_WAIT_L(0); PG8_BAR; PG8_MMA(0, 0, At, B0); PG8_MMA(0, 1, At, B1); PG8_BAR; PG8_SCHED;
            PG8_LDA(At, 1, 1); PG8_STAGE(PG8_SB(1, 0), b3, voffB); PG8_STAGE(PG8_SB(1, 1), b3 + hstep, voffB); PG8_STAGE(PG8_SA(1, 0), a3, voffA);
            PG8_WAIT_V(8); PG8_WAIT_L(0); PG8_BAR; PG8_MMA(1, 0, At, B0); PG8_MMA(1, 1, At, B1); PG8_BAR; PG8_SCHED;
            } else {
            PG8_LDB(B0, 0, 0); PG8_SCHED; PG8_LDA(At, 0, 0); PG8_STAGE(PG8_SA(1, 1), a1 + hstep, voffA);
            PG8_WAIT_L(8); PG8_BAR; PG8_WAIT_L(0); PG8_MMA(0, 0, At, B0); PG8_BAR; PG8_SCHED;
            PG8_LDB(B1, 0, 1); PG8_STAGE(PG8_SB(0, 0), b2, voffB);
            PG8_BAR; PG8_WAIT_L(0); PG8_MMA(0, 1, At, B1); PG8_BAR;
            PG8_LDA(At, 0, 1); PG8_STAGE(PG8_SA(0, 0), a2, voffA);
            PG8_BAR; PG8_WAIT_L(0); PG8_MMA(1, 0, At, B0); PG8_BAR; PG8_SCHED;
            PG8_STAGE(PG8_SB(0, 1), b2 + hstep, voffB);
            PG8_WAIT_V(6); PG8_BAR; PG8_MMA(1, 1, At, B1); PG8_BAR;
            PG8_LDB(B0, 1, 0); PG8_SCHED; PG8_LDA(At, 1, 0); PG8_STAGE(PG8_SA(0, 1), a2 + hstep, voffA);
            PG8_WAIT_L(8); PG8_BAR; PG8_WAIT_L(0); PG8_MMA(0, 0, At, B0); PG8_BAR; PG8_SCHED;
            PG8_LDB(B1, 1, 1); PG8_STAGE(PG8_SB(1, 0), b3, voffB);
            PG8_BAR; PG8_WAIT_L(0); PG8_MMA(0, 1, At, B1); PG8_BAR;
            PG8_LDA(At, 1, 1); PG8_STAGE(PG8_SA(1, 0), a3, voffA);
            PG8_BAR; PG8_WAIT_L(0); PG8_MMA(1, 0, At, B0); PG8_BAR; PG8_SCHED;
            PG8_STAGE(PG8_SB(1, 1), b3 + hstep, voffB);
            PG8_WAIT_V(6); PG8_BAR; PG8_MMA(1, 1, At, B1); PG8_BAR;
            }
        }
        if constexpr (ALIGN_EPI) { if (wr == 0) PG8_BAR; }
        if constexpr (!Epi::AFTER_DRAIN) { E(acc, cur, wr, wc, fr, fq); S.done(cur); }
        if (!has_next) break;
#pragma unroll
        for (int a = 0; a < 2; ++a)
#pragma unroll
            for (int b = 0; b < 2; ++b)
#pragma unroll
                for (int m = 0; m < 4; ++m)
#pragma unroll
                    for (int n = 0; n < 2; ++n) acc[a][b][m][n] = (f32x4){0.f, 0.f, 0.f, 0.f};
        cur = nxt; cA = nA; cB = nB; ++ui;
        if constexpr (ALIGN_EPI) { if (wr == 1) PG8_BAR; }
    }
    PG8_WAIT_V(0);
    if constexpr (!ALIGN_EPI) { if (wr == 0) PG8_BAR; }
    PG8_BAR;
    if constexpr (Epi::AFTER_DRAIN) { E.fused(acc, cur, wr, wc, fr, fq, lds, wid, lane); S.done(cur); }
#undef PG8_SA
#undef PG8_SB
#undef PG8_STAGE
#undef PG8_LDA
#undef PG8_LDB
#undef PG8_MMA
#undef PG8_WAIT_V
#undef PG8_WAIT_L
#undef PG8_BAR
#undef PG8_SCHED
}
}

#define LAS __attribute__((address_space(3)))
typedef unsigned short bf16_t;
typedef short bf16x8 __attribute__((ext_vector_type(8)));
typedef float f32x4 __attribute__((ext_vector_type(4)));
typedef unsigned u32x4 __attribute__((ext_vector_type(4)));
typedef unsigned u32x2 __attribute__((ext_vector_type(2)));
typedef float f32x2_t __attribute__((ext_vector_type(2)));
typedef __bf16 bf16x2_t __attribute__((ext_vector_type(2)));

constexpr int SEQ = 8192, NB = 2, M = NB * SEQ, D = 1024, NPROJ = 3072, NIN = 2832, DFF = 2816, NMOD = 6144;
constexpr float EPS = 1e-6f;
constexpr int NTHREADS = 512, NWAVES = 8;
constexpr int LDS_BYTES = 147456;
constexpr int NPHASES = 11;

constexpr size_t MiB = 1u << 20;
constexpr size_t WS_MOD = 0;
constexpr size_t WS_SC = 256 * 1024;
constexpr size_t WS_MPREV = 320 * 1024;
constexpr size_t WS_ATTSS = 384 * 1024;
constexpr size_t WS_SS2 = 640 * 1024;
constexpr size_t WS_SS3 = 704 * 1024;
constexpr size_t WS_BAR = 512 * 1024;
constexpr size_t WS_CNT = 512 * 1024 + 16384;
constexpr size_t WS_GATES = 1 * MiB;
constexpr size_t WS_GV = 2 * MiB;
constexpr size_t WS_NC = 3 * MiB;
constexpr size_t WS_NPREV = 4 * MiB;
constexpr size_t WS_WIN = 6 * MiB;
constexpr size_t WS_WOUT = 12 * MiB;
constexpr size_t WS_WFI = 14 * MiB;
constexpr size_t WS_WFO = 25 * MiB;
constexpr size_t WS_PROJ = 32 * MiB;
constexpr size_t WS_QM = 128 * MiB;
constexpr size_t WS_KM = 144 * MiB;
constexpr size_t WS_XN = 160 * MiB;
constexpr size_t WS_A2 = 192 * MiB;
constexpr size_t WS_END = 224 * MiB;

struct Params {
    const float *x, *c, *w_mod, *b_mod, *g_norm1, *w_in, *conv_w, *conv_b, *b_gates, *sink, *g_attn_out, *g_mlstm_out, *w_out, *g_norm2, *w_ffn_in, *w_ffn_out, *g_final;
    float* out; unsigned char* ws; int ph_lo, ph_hi;
};

__device__ __forceinline__ float bf2f(unsigned h) { return __uint_as_float(h << 16); }
__device__ __forceinline__ unsigned pk2(float lo, float hi) { f32x2_t v = {lo, hi}; bf16x2_t b = __builtin_convertvector(v, bf16x2_t); return __builtin_bit_cast(unsigned, b); }
__device__ __forceinline__ float wave_sum(float v) {
#pragma unroll
    for (int o = 1; o < 64; o <<= 1) v += __shfl_xor(v, o);
    return v;
}
__device__ __forceinline__ float quad_sum(float v) { v += __shfl_xor(v, 16); v += __shfl_xor(v, 32); return v; }
__device__ __forceinline__ float quad_max(float v) { v = fmaxf(v, __shfl_xor(v, 16)); v = fmaxf(v, __shfl_xor(v, 32)); return v; }
__device__ __forceinline__ float silu_f(float v) { return v * __builtin_amdgcn_rcpf(1.0f + __expf(-v)); }
__device__ __forceinline__ float sigmoid_f(float v) { return __builtin_amdgcn_rcpf(1.0f + __expf(-v)); }
__device__ __forceinline__ float logsig_f(float f) { return fminf(f, 0.f) - log1pf(expf(-fabsf(f))); }
__device__ __forceinline__ f32x4 mfma16(bf16x8 a, bf16x8 b, f32x4 c) { return __builtin_amdgcn_mfma_f32_16x16x32_bf16(a, b, c, 0, 0, 0); }
__device__ __forceinline__ bf16x8 mk8(unsigned a, unsigned b, unsigned c, unsigned d) { u32x4 v = {a, b, c, d}; return __builtin_bit_cast(bf16x8, v); }

struct EpiProj {
    static constexpr bool PERM = true, AFTER_DRAIN = false;
    bf16_t* O; float* gates; const float* b_gates;
    __device__ __forceinline__ void operator()(const f32x4 (&acc)[2][2][4][2], const pg8::Unit& u, int wr, int wc, int fr, int fq) const {
        const int row0 = u.pm * 256 + wr * 64 + fr; const int col0 = u.pn * 256 + wc * 32 + 8 * fq;
        if (u.pn != 11)
#pragma unroll
        for (int ai = 0; ai < 2; ++ai)
#pragma unroll
            for (int m = 0; m < 4; ++m) { bf16_t* rowp = O + (size_t)(row0 + ai * 128 + m * 16) * NPROJ + col0;
#pragma unroll
                for (int bj = 0; bj < 2; ++bj) { const f32x4 v0 = acc[ai][bj][m][0], v1 = acc[ai][bj][m][1];
                    u32x4 w; w.x = pk2(v0[0], v0[1]); w.y = pk2(v0[2], v0[3]); w.z = pk2(v1[0], v1[1]); w.w = pk2(v1[2], v1[3]);
                    *(u32x4*)(rowp + bj * 128) = w; } }
        if (u.pn == 11 && wc == 0 && fq < 2) {
            const f32x4 b0 = *(const f32x4*)(b_gates + 8 * fq), b1 = *(const f32x4*)(b_gates + 8 * fq + 4);
#pragma unroll
            for (int ai = 0; ai < 2; ++ai)
#pragma unroll
                for (int m = 0; m < 4; ++m) { float* gp = gates + (size_t)(row0 + ai * 128 + m * 16) * 16 + 8 * fq;
                    *(f32x4*)gp = acc[ai][0][m][0] + b0; *(f32x4*)(gp + 4) = acc[ai][0][m][1] + b1; }
        }
    }
};
struct EpiResid {
    static constexpr bool PERM = false, AFTER_DRAIN = false;
    const float* base; float* out; const float* gate;
    const float* rowss;
    __device__ __forceinline__ void operator()(const f32x4 (&acc)[2][2][4][2], const pg8::Unit& u, int wr, int wc, int fr, int fq) const {
        const int col0 = u.pn * 256 + wc * 32 + 4 * fq; const int b = u.pm >> 5;
        float rs[2][4];
#pragma unroll
        for (int ai = 0; ai < 2; ++ai)
#pragma unroll
            for (int m = 0; m < 4; ++m) rs[ai][m] = rowss ? rsqrtf(rowss[u.pm * 256 + ai * 128 + wr * 64 + m * 16 + fr] * (1.0f / 512.0f) + EPS) : 1.0f;
#pragma unroll
        for (int bj = 0; bj < 2; ++bj)
#pragma unroll
            for (int n = 0; n < 2; ++n) { const f32x4 g = *(const f32x4*)(gate + b * NMOD + col0 + bj * 128 + n * 16);
#pragma unroll
                for (int ai = 0; ai < 2; ++ai)
#pragma unroll
                    for (int m = 0; m < 4; ++m) { const size_t off = (size_t)(u.pm * 256 + ai * 128 + wr * 64 + m * 16 + fr) * D + col0 + bj * 128 + n * 16;
                        const f32x4 bs = *(const f32x4*)(base + off); *(f32x4*)(out + off) = bs + (g * rs[ai][m]) * acc[ai][bj][m][n]; } }
    }
};
struct EpiResidNorm {
    static constexpr bool PERM = false, AFTER_DRAIN = true;
    const float* base; float* out; const float* gate; const float* rowss;
    float* SS; unsigned* CNT; const float* gcol; const float* mod_scale; const float* mod_shift; bf16_t* XN;
    const bf16_t* base_bf; bf16_t* x1_bf;
    __device__ __forceinline__ void fused(f32x4 (&acc)[2][2][4][2], const pg8::Unit& u, int wr, int wc, int fr, int fq, PG8_LAS unsigned char* lds, int wid, int lane) const {
        const int col0 = u.pn * 256 + wc * 32 + 4 * fq; const int b = u.pm >> 5; const int rowb = u.pm * 256 + wr * 64 + fr;
        f32x4 gq[2][2];
#pragma unroll
        for (int bj = 0; bj < 2; ++bj)
#pragma unroll
            for (int n = 0; n < 2; ++n) gq[bj][n] = *(const f32x4*)(gate + b * NMOD + col0 + bj * 128 + n * 16);
#pragma unroll
        for (int ai = 0; ai < 2; ++ai)
#pragma unroll
            for (int mp = 0; mp < 2; ++mp) {
                f32x4 bs[2][2][2]; float rsv[2];
#pragma unroll
                for (int mi = 0; mi < 2; ++mi) { const int row = rowb + ai * 128 + (mp * 2 + mi) * 16; rsv[mi] = rowss ? rowss[row] : 0.f;
#pragma unroll
                    for (int bj = 0; bj < 2; ++bj)
#pragma unroll
                        for (int n = 0; n < 2; ++n) { const unsigned off = (unsigned)(row * D + col0 + bj * 128 + n * 16);
                            if (base_bf) { const u32x2 q = *(const u32x2*)(base_bf + off); bs[mi][bj][n] = (f32x4){bf2f(q.x & 0xffffu), bf2f(q.x >> 16), bf2f(q.y & 0xffffu), bf2f(q.y >> 16)}; }
                            else bs[mi][bj][n] = *(const f32x4*)(base + off); } }
#pragma unroll
                for (int mi = 0; mi < 2; ++mi) { const int m = mp * 2 + mi; const int row = rowb + ai * 128 + m * 16;
                    const float rs1 = rowss ? rsqrtf(rsv[mi] * (1.0f / 512.0f) + EPS) : 1.0f; float ssp = 0.f;
#pragma unroll
                    for (int bj = 0; bj < 2; ++bj)
#pragma unroll
                        for (int n = 0; n < 2; ++n) { const f32x4 v = bs[mi][bj][n] + (gq[bj][n] * rs1) * acc[ai][bj][m][n]; acc[ai][bj][m][n] = v;
                            ssp += (v[0] * v[0] + v[1] * v[1]) + (v[2] * v[2] + v[3] * v[3]);
                            asm volatile("" : "+v"(acc[ai][bj][m][n])); }
                    const float sq = quad_sum(ssp); if (fq == 0) __hip_atomic_fetch_add(SS + row, sq, __ATOMIC_RELAXED, __HIP_MEMORY_SCOPE_AGENT); }
                asm volatile("" ::: "memory"); }
        asm volatile("s_waitcnt vmcnt(0)" ::: "memory");
        __syncthreads();
        if (threadIdx.x == 0) { unsigned* cp = CNT + u.pm * 16;
            __builtin_amdgcn_fence(__ATOMIC_RELEASE, "agent");
            __hip_atomic_fetch_add(cp, 1u, __ATOMIC_RELAXED, __HIP_MEMORY_SCOPE_AGENT);
            unsigned spins = 0;
            while (__hip_atomic_load(cp, __ATOMIC_RELAXED, __HIP_MEMORY_SCOPE_AGENT) < 4u && ++spins < (1u << 22)) __builtin_amdgcn_s_sleep(1);
            __builtin_amdgcn_fence(__ATOMIC_ACQUIRE, "agent"); }
        __syncthreads();
        int rowc = rowb; asm volatile("" : "+v"(rowc));
        float rstd[2][4];
#pragma unroll
        for (int ai = 0; ai < 2; ++ai)
#pragma unroll
            for (int m = 0; m < 4; ++m) rstd[ai][m] = rsqrtf(__hip_atomic_load(SS + rowc + ai * 128 + m * 16, __ATOMIC_RELAXED, __HIP_MEMORY_SCOPE_AGENT) * (1.0f / D) + EPS);
#pragma unroll
        for (int bj = 0; bj < 2; ++bj)
#pragma unroll
            for (int n = 0; n < 2; ++n) { const int col = col0 + bj * 128 + n * 16; f32x4 gc = *(const f32x4*)(gcol + col); f32x4 sh = {0.f, 0.f, 0.f, 0.f};
                if (XN) { gc = gc * (1.0f + *(const f32x4*)(mod_scale + b * NMOD + col)); sh = *(const f32x4*)(mod_shift + b * NMOD + col); }
#pragma unroll
                for (int ai = 0; ai < 2; ++ai)
#pragma unroll
                    for (int m = 0; m < 4; ++m) { const unsigned off = (unsigned)((rowc + ai * 128 + m * 16) * D + col); const f32x4 v = acc[ai][bj][m][n] * rstd[ai][m] * gc + sh;
                        if (XN) { { const f32x4 a = acc[ai][bj][m][n]; u32x2 q; q.x = pk2(a[0], a[1]); q.y = pk2(a[2], a[3]); *(u32x2*)(x1_bf + off) = q; } u32x2 w; w.x = pk2(v[0], v[1]); w.y = pk2(v[2], v[3]); *(u32x2*)(XN + off) = w; } else *(f32x4*)(out + off) = v; } }
    }
};
struct EpiSwiglu {
    static constexpr bool PERM = true, AFTER_DRAIN = false;
    bf16_t* O;
    __device__ __forceinline__ void operator()(const f32x4 (&acc)[2][2][4][2], const pg8::Unit& u, int wr, int wc, int fr, int fq) const {
        const int row0 = u.pm * 256 + wr * 64 + fr; const int col0 = u.pn * 128 + wc * 32 + 8 * fq;
#pragma unroll
        for (int ai = 0; ai < 2; ++ai)
#pragma unroll
            for (int m = 0; m < 4; ++m) { float r[8];
#pragma unroll
                for (int n = 0; n < 2; ++n)
#pragma unroll
                    for (int e = 0; e < 4; ++e) { const float g = acc[ai][0][m][n][e], up = acc[ai][1][m][n][e]; r[n * 4 + e] = silu_f(g) * up; }
                u32x4 w; w.x = pk2(r[0], r[1]); w.y = pk2(r[2], r[3]); w.z = pk2(r[4], r[5]); w.w = pk2(r[6], r[7]);
                *(u32x4*)(O + (size_t)(row0 + ai * 128 + m * 16) * DFF + col0) = w; }
    }
};

__device__ __forceinline__ void transpose_item(const float* W, int K, int N, bf16_t* WT, int drow0, int k0, int n0, LAS float* scr, int lane) {
    const int kr = lane >> 3, nq = (lane & 7) * 4; f32x4 v[8];
#pragma unroll
    for (int i = 0; i < 8; ++i) { const f32x4 z = {0.f, 0.f, 0.f, 0.f}; v[i] = (n0 + nq < N) ? *(const f32x4*)(W + (size_t)(k0 + kr + 8 * i) * N + n0 + nq) : z; }
#pragma unroll
    for (int i = 0; i < 8; ++i) { LAS float* d = scr + (kr + 8 * i) * 33 + nq; d[0] = v[i][0]; d[1] = v[i][1]; d[2] = v[i][2]; d[3] = v[i][3]; }
    const int c = lane & 7;
#pragma unroll
    for (int j = 0; j < 4; ++j) { const int n = (lane >> 3) + 8 * j; const LAS float* s = scr + (8 * c) * 33 + n;
        u32x4 o; o.x = pk2(s[0 * 33], s[1 * 33]); o.y = pk2(s[2 * 33], s[3 * 33]); o.z = pk2(s[4 * 33], s[5 * 33]); o.w = pk2(s[6 * 33], s[7 * 33]);
        *(u32x4*)(WT + (size_t)(drow0 + n) * K + k0 + 8 * c) = o; }
}

__device__ __forceinline__ void phase0(const Params& P, LAS unsigned char* lds, int tid, int wave, int lane) {
    unsigned char* ws = P.ws;
    float* MOD = (float*)(ws + WS_MOD);
    LAS float* red = (LAS float*)(lds + 81920);
    for (int item = blockIdx.x; item < NMOD / 32; item += gridDim.x) {
        const int col0 = item * 32 + (lane & 7) * 4; const int r = lane >> 3;
        f32x4 a0 = {0.f, 0.f, 0.f, 0.f}, a1 = {0.f, 0.f, 0.f, 0.f};
#pragma unroll 4
        for (int i = 0; i < 16; ++i) { const int k = wave * 128 + r + 8 * i; const f32x4 w = *(const f32x4*)(P.w_mod + (size_t)k * NMOD + col0);
            const float s0 = silu_f(P.c[k]), s1 = silu_f(P.c[D + k]); a0 += s0 * w; a1 += s1 * w; }
#pragma unroll
        for (int e = 0; e < 4; ++e) {
#pragma unroll
            for (int o = 8; o < 64; o <<= 1) { a0[e] += __shfl_xor(a0[e], o); a1[e] += __shfl_xor(a1[e], o); } }
        if (lane < 8) {
#pragma unroll
            for (int e = 0; e < 4; ++e) { red[(wave * 8 + lane) * 8 + e] = a0[e]; red[(wave * 8 + lane) * 8 + 4 + e] = a1[e]; } }
        __syncthreads();
        if (tid < 64) { const int q = tid >> 3, e = tid & 7; float s = 0.f;
#pragma unroll
            for (int w = 0; w < 8; ++w) s += red[(w * 8 + q) * 8 + e];
            const int b = e >> 2, col = item * 32 + q * 4 + (e & 3); MOD[b * NMOD + col] = s + P.b_mod[col]; }
        __syncthreads();
    }
    LAS float* scr = (LAS float*)(lds + wave * 8704);
    const int gw = blockIdx.x * NWAVES + wave, NGW = gridDim.x * NWAVES;
    bf16_t* WIN = (bf16_t*)(ws + WS_WIN); bf16_t* WOUT = (bf16_t*)(ws + WS_WOUT); bf16_t* WFI = (bf16_t*)(ws + WS_WFI); bf16_t* WFO = (bf16_t*)(ws + WS_WFO);
    constexpr int NB_IN = 88, I_IN = 16 * NB_IN, I_OUT = 16 * 32, I_FI = 16 * 176, I_FO = 44 * 32;
    if ((int)gridDim.x > NMOD / 32) { const int xw = ((int)blockIdx.x - NMOD / 32) * NWAVES + wave; if (xw >= 0 && xw < 16) transpose_item(P.w_in, D, NIN, WIN, 88 * 32, xw * 64, 88 * 32, scr, lane); }
    else if (gw < 16) transpose_item(P.w_in, D, NIN, WIN, 88 * 32, gw * 64, 88 * 32, scr, lane);
    for (int it = gw; it < I_IN + I_OUT + I_FI + I_FO; it += NGW) {
        int r = it;
        if (r < I_IN) { const int kb = r / NB_IN, nb = r % NB_IN; transpose_item(P.w_in, D, NIN, WIN, nb * 32, kb * 64, nb * 32, scr, lane); continue; } r -= I_IN;
        if (r < I_OUT) { const int kb = r / 32, nb = r % 32; transpose_item(P.w_out, D, D, WOUT, nb * 32, kb * 64, nb * 32, scr, lane); continue; } r -= I_OUT;
        if (r < I_FI) { const int kb = r / 176, nb = r % 176; const int n0 = nb * 32; const int np = n0 < DFF ? n0 : n0 - DFF;
            const int drow0 = (np / 128) * 256 + (n0 < DFF ? 0 : 128) + (np % 128);
            transpose_item(P.w_ffn_in, D, 2 * DFF, WFI, drow0, kb * 64, n0, scr, lane); continue; } r -= I_FI;
        { const int kb = r / 32, nb = r % 32; transpose_item(P.w_ffn_out, DFF, D, WFO, nb * 32, kb * 64, nb * 32, scr, lane); }
    }
}

__device__ __forceinline__ void norm_mod_phase(const float* X, const float* g, const float* MOD, int shift_off, int scale_off, bf16_t* XN, int wave, int lane) {
    const int gw = blockIdx.x * NWAVES + wave, NGW = gridDim.x * NWAVES;
    int curb = -1; f32x4 A[4], B[4];
    for (int m = gw; m < M; m += 2 * NGW) {
        const int b = m >> 13; const int m2 = m + NGW;
        if (b != curb) { curb = b;
#pragma unroll
            for (int j = 0; j < 4; ++j) { const int col = 4 * lane + 256 * j; const f32x4 gv = *(const f32x4*)(g + col), sc = *(const f32x4*)(MOD + b * NMOD + scale_off + col);
                A[j] = gv * (1.0f + sc); B[j] = *(const f32x4*)(MOD + b * NMOD + shift_off + col); } }
        f32x4 v[4], w[4]; float ss = 0.f, ss2 = 0.f;
#pragma unroll
        for (int j = 0; j < 4; ++j) { v[j] = *(const f32x4*)(X + (size_t)m * D + 4 * lane + 256 * j); w[j] = *(const f32x4*)(X + (size_t)m2 * D + 4 * lane + 256 * j); }
#pragma unroll
        for (int j = 0; j < 4; ++j) { ss += (v[j][0] * v[j][0] + v[j][1] * v[j][1]) + (v[j][2] * v[j][2] + v[j][3] * v[j][3]); ss2 += (w[j][0] * w[j][0] + w[j][1] * w[j][1]) + (w[j][2] * w[j][2] + w[j][3] * w[j][3]); }
        const float rstd = rsqrtf(wave_sum(ss) * (1.0f / D) + EPS), rstd2 = rsqrtf(wave_sum(ss2) * (1.0f / D) + EPS);
#pragma unroll
        for (int j = 0; j < 4; ++j) { const f32x4 o = v[j] * rstd * A[j] + B[j]; u32x2 p; p.x = pk2(o[0], o[1]); p.y = pk2(o[2], o[3]);
            *(u32x2*)(XN + (size_t)m * D + 4 * lane + 256 * j) = p;
            const f32x4 o2 = w[j] * rstd2 * A[j] + B[j]; u32x2 p2; p2.x = pk2(o2[0], o2[1]); p2.y = pk2(o2[2], o2[3]);
            *(u32x2*)(XN + (size_t)m2 * D + 4 * lane + 256 * j) = p2; }
    }
}
__device__ __forceinline__ void final_norm_phase(float* X, const float* g, int wave, int lane) {
    const int gw = blockIdx.x * NWAVES + wave, NGW = gridDim.x * NWAVES;
    f32x4 A[4];
#pragma unroll
    for (int j = 0; j < 4; ++j) A[j] = *(const f32x4*)(g + 4 * lane + 256 * j);
    for (int m = gw; m < M; m += NGW) {
        f32x4 v[4]; float ss = 0.f;
#pragma unroll
        for (int j = 0; j < 4; ++j) { v[j] = *(const f32x4*)(X + (size_t)m * D + 4 * lane + 256 * j); ss += (v[j][0] * v[j][0] + v[j][1] * v[j][1]) + (v[j][2] * v[j][2] + v[j][3] * v[j][3]); }
        const float rstd = rsqrtf(wave_sum(ss) * (1.0f / D) + EPS);
#pragma unroll
        for (int j = 0; j < 4; ++j) *(f32x4*)(X + (size_t)m * D + 4 * lane + 256 * j) = v[j] * rstd * A[j];
    }
}

typedef short v4i16_t __attribute__((ext_vector_type(4)));
__device__ __forceinline__ u32x2 tr_read(const LAS bf16_t* p) { return __builtin_bit_cast(u32x2, __builtin_amdgcn_ds_read_tr16_b64_v4i16((LAS v4i16_t*)p)); }

constexpr float ATT_C1 = 0.125f * 1.4426950408889634f;
template <bool MASK, int KT_LO, int KT_HI>
__device__ __forceinline__ void attn_chunk(const int kc, const LAS bf16_t* Ks, const LAS bf16_t* Vs, bf16x8 (&qf)[2][2], f32x4 (&o)[4][2], float (&m_run)[2], float (&l_run)[2],
                                           const float fbase, const float sl8, const int fr, const int fq, const int troff, const bool q_reload, const bf16_t* qnext) {
    f32x4 s[4][2];
    float fb = fbase; asm volatile("" : "+v"(fb));
#pragma unroll
    for (int kt = KT_LO; kt < KT_HI; ++kt) { const LAS bf16_t* kp = Ks + (kc * 64 + kt * 16 + fr) * 72 + fq * 8;
        const bf16x8 a0 = *(const LAS bf16x8*)kp, a1 = *(const LAS bf16x8*)(kp + 32);
#pragma unroll
        for (int qt = 0; qt < 2; ++qt) { const f32x4 z = {0.f, 0.f, 0.f, 0.f}; s[kt][qt] = mfma16(a1, qf[qt][1], mfma16(a0, qf[qt][0], z)); } }
    if (q_reload) {
#pragma unroll
        for (int qt = 0; qt < 2; ++qt)
#pragma unroll
            for (int kk = 0; kk < 2; ++kk) qf[qt][kk] = *(const bf16x8*)(qnext + (size_t)qt * 16 * NPROJ + kk * 32); }
    unsigned pb[2][4][2];
#pragma unroll
    for (int qt = 0; qt < 2; ++qt) {
        float cmax = -1e30f;
#pragma unroll
        for (int kt = KT_LO; kt < KT_HI; ++kt)
#pragma unroll
            for (int i = 0; i < 4; ++i) { const float rel = fb + (float)(kc * 64 + kt * 16 + i - qt * 16); const float ar = fabsf(rel);
                float lg = fmaf(-sl8, ar, s[kt][qt][i]); if (MASK) lg = (ar <= 128.0f) ? lg : -1e30f; s[kt][qt][i] = lg; cmax = fmaxf(cmax, lg); }
        cmax = quad_max(cmax);
        const float m_new = fmaxf(m_run[qt], cmax), alpha = __builtin_amdgcn_exp2f((m_run[qt] - m_new) * ATT_C1), mc = m_new * ATT_C1; m_run[qt] = m_new;
        float psum = 0.f;
#pragma unroll
        for (int kt = KT_LO; kt < KT_HI; ++kt) { float p[4];
#pragma unroll
            for (int i = 0; i < 4; ++i) { p[i] = __builtin_amdgcn_exp2f(fmaf(s[kt][qt][i], ATT_C1, -mc)); psum += p[i]; }
            pb[qt][kt][0] = pk2(p[0], p[1]); pb[qt][kt][1] = pk2(p[2], p[3]); }
        l_run[qt] = l_run[qt] * alpha + psum;
#pragma unroll
        for (int dt = 0; dt < 4; ++dt) o[dt][qt] *= alpha;
    }
#pragma unroll
    for (int ks = KT_LO / 2; ks < KT_HI / 2; ++ks)
#pragma unroll
        for (int dt = 0; dt < 4; ++dt) { const LAS bf16_t* vp = Vs + (kc * 64 + ks * 32) * 80 + troff + dt * 16;
            const u32x2 lo = tr_read(vp), hi = tr_read(vp + 16 * 80); const bf16x8 a = mk8(lo.x, lo.y, hi.x, hi.y);
#pragma unroll
            for (int qt = 0; qt < 2; ++qt) o[dt][qt] = mfma16(a, mk8(pb[qt][2 * ks][0], pb[qt][2 * ks][1], pb[qt][2 * ks + 1][0], pb[qt][2 * ks + 1][1]), o[dt][qt]); }
}

__device__ __forceinline__ void attn_phase(const Params& P, LAS unsigned char* lds, int tid, int wave, int lane, const bool do_atomic) {
    LAS bf16_t* Ks = (LAS bf16_t*)lds;
    LAS bf16_t* Vs = (LAS bf16_t*)(lds + 46080);
    const bf16_t* PROJ = (const bf16_t*)(P.ws + WS_PROJ);
    bf16_t* A2 = (bf16_t*)(P.ws + WS_A2); float* ATTSS = (float*)(P.ws + WS_ATTSS);
    const int fr = lane & 15, fq = lane >> 4, g = wave >> 1, r = wave & 1;
    const int troff = (fq * 4 + ((lane >> 2) & 3)) * 80 + (lane & 3) * 4;
    const float fbase = (float)(fq * 4 - 128 - r * 32 - fr);
    const int G = gridDim.x;
    int u = (G % 8 == 0) ? ((int)blockIdx.x % 8) * (G / 8) + (int)blockIdx.x / 8 : (int)blockIdx.x; if (u >= NB * (SEQ / 64)) return;
    u32x4 rk[5], rv[5];
#define AT_LOADS(uu, kvh_) do { const int b_ = (uu) >> 7, t0_ = ((uu) & 127) * 64, kb_ = t0_ - 128; \
        _Pragma("unroll") for (int i = 0; i < 5; ++i) { const int cidx = tid + 512 * i, key = cidx >> 3, part = cidx & 7, tok = kb_ + key; const u32x4 z = {0u, 0u, 0u, 0u}; rk[i] = z; rv[i] = z; \
            if (tok >= 0 && tok < SEQ) { const bf16_t* rowp = PROJ + (size_t)(b_ * SEQ + tok) * NPROJ; rk[i] = *(const u32x4*)(rowp + 512 + (kvh_) * 64 + part * 8); rv[i] = *(const u32x4*)(rowp + 640 + (kvh_) * 64 + part * 8); } } \
        } while (0)
    AT_LOADS(u, 0);
    bf16x8 qf[2][2];
    { const int b0 = u >> 7, t00 = (u & 127) * 64;
#pragma unroll
      for (int qt = 0; qt < 2; ++qt)
#pragma unroll
          for (int kk = 0; kk < 2; ++kk) qf[qt][kk] = *(const bf16x8*)(PROJ + (size_t)(b0 * SEQ + t00 + r * 32 + qt * 16 + fr) * NPROJ + g * 64 + kk * 32 + fq * 8); }
    for (;;) {
        const int b = u >> 7, qb = u & 127, t0 = qb * 64;
        const int kc_lo = qb == 0 ? 2 : (qb == 1 ? 1 : 0), kc_hi = qb == 127 ? 3 : (qb == 126 ? 4 : 5);
        const int un = u + G; const bool more = un < NB * (SEQ / 64);
#pragma unroll 1
        for (int kvh = 0; kvh < 2; ++kvh) {
            __syncthreads();
#pragma unroll
            for (int i = 0; i < 5; ++i) { const int cidx = tid + 512 * i, key = cidx >> 3, part = cidx & 7; *(LAS u32x4*)(Ks + key * 72 + part * 8) = rk[i]; *(LAS u32x4*)(Vs + key * 80 + part * 8) = rv[i]; }
            __syncthreads();
            const bool qnx = (kvh == 0) || more; const int un_b = un >> 7, un_t0 = (un & 127) * 64;
            const bf16_t* qnext = (kvh == 0) ? PROJ + (size_t)(b * SEQ + t0 + r * 32 + fr) * NPROJ + (4 + g) * 64 + fq * 8
                                             : PROJ + (size_t)(un_b * SEQ + un_t0 + r * 32 + fr) * NPROJ + g * 64 + fq * 8;
            if (!qnx) qnext = PROJ;
            if (kvh == 0) { AT_LOADS(u, 1); } else if (more) { AT_LOADS(un, 0); }
            const int h = kvh * 4 + g;
            const float sl8 = 8.0f * exp2f(-(float)(h + 1));
            float m_run[2], l_run[2]; f32x4 o[4][2];
#pragma unroll
            for (int qt = 0; qt < 2; ++qt) { m_run[qt] = 8.0f * P.sink[h]; l_run[qt] = (fq == 0) ? 1.0f : 0.0f;
#pragma unroll
                for (int dt = 0; dt < 4; ++dt) o[dt][qt] = (f32x4){0.f, 0.f, 0.f, 0.f}; }
            if (r == 0) {
                if (kc_lo <= 0) attn_chunk<true, 0, 4>(0, Ks, Vs, qf, o, m_run, l_run, fbase, sl8, fr, fq, troff, qnx && (kc_hi == 1), qnext);
                if (kc_lo <= 1) attn_chunk<false, 0, 4>(1, Ks, Vs, qf, o, m_run, l_run, fbase, sl8, fr, fq, troff, qnx && (kc_hi == 2), qnext);
                attn_chunk<false, 0, 4>(2, Ks, Vs, qf, o, m_run, l_run, fbase, sl8, fr, fq, troff, qnx && (kc_hi == 3), qnext);
                if (kc_hi > 3) attn_chunk<false, 0, 4>(3, Ks, Vs, qf, o, m_run, l_run, fbase, sl8, fr, fq, troff, qnx && (kc_hi == 4), qnext);
                if (kc_hi > 4) attn_chunk<true, 0, 2>(4, Ks, Vs, qf, o, m_run, l_run, fbase, sl8, fr, fq, troff, qnx && (kc_hi == 5), qnext);
            } else {
                if (kc_lo <= 0) attn_chunk<true, 2, 4>(0, Ks, Vs, qf, o, m_run, l_run, fbase, sl8, fr, fq, troff, qnx && (kc_hi == 1), qnext);
                if (kc_lo <= 1) attn_chunk<false, 0, 4>(1, Ks, Vs, qf, o, m_run, l_run, fbase, sl8, fr, fq, troff, qnx && (kc_hi == 2), qnext);
                attn_chunk<false, 0, 4>(2, Ks, Vs, qf, o, m_run, l_run, fbase, sl8, fr, fq, troff, qnx && (kc_hi == 3), qnext);
                if (kc_hi > 3) attn_chunk<false, 0, 4>(3, Ks, Vs, qf, o, m_run, l_run, fbase, sl8, fr, fq, troff, qnx && (kc_hi == 4), qnext);
                if (kc_hi > 4) attn_chunk<true, 0, 4>(4, Ks, Vs, qf, o, m_run, l_run, fbase, sl8, fr, fq, troff, qnx && (kc_hi == 5), qnext);
            }
#pragma unroll
            for (int qt = 0; qt < 2; ++qt) { const float inv = 1.0f / quad_sum(l_run[qt]); float ss = 0.f;
                const int rr = r * 32 + qt * 16 + fr; const size_t mrow = (size_t)(b * SEQ + t0 + rr);
                bf16_t* orow = A2 + mrow * D;
#pragma unroll
                for (int dt = 0; dt < 4; ++dt) { const f32x4 v = o[dt][qt] * inv; ss += (v[0] * v[0] + v[1] * v[1]) + (v[2] * v[2] + v[3] * v[3]);
                    const int col = h * 64 + dt * 16 + fq * 4; const f32x4 gv = *(const f32x4*)(P.g_attn_out + col); const f32x4 w4 = v * gv;
                    u32x2 w; w.x = pk2(w4[0], w4[1]); w.y = pk2(w4[2], w4[3]); *(u32x2*)(orow + col) = w; }
                ss = quad_sum(ss);
                if (fq == 0 && do_atomic) __hip_atomic_fetch_add(ATTSS + mrow, ss, __ATOMIC_RELAXED, __HIP_MEMORY_SCOPE_AGENT); }
        }
        if (!more) break;
        u = un;
    }
#undef AT_LOADS
}

__device__ __forceinline__ float scan_up_add(float v, int lane) {
#pragma unroll
    for (int o = 1; o < 64; o <<= 1) { const float t = __shfl_up(v, o); v += (lane >= o) ? t : 0.f; }
    return v;
}
__device__ __forceinline__ float scan_down_add(float v, int lane) {
#pragma unroll
    for (int o = 1; o < 64; o <<= 1) { const float t = __shfl_down(v, o); v += (lane + o < 64) ? t : 0.f; }
    return v;
}
__device__ __forceinline__ float scan_up_max(float v, int lane) {
#pragma unroll
    for (int o = 1; o < 64; o <<= 1) { const float t = __shfl_up(v, o); v = (lane >= o) ? fmaxf(v, t) : v; }
    return v;
}
__device__ __forceinline__ float scan_down_max(float v, int lane) {
#pragma unroll
    for (int o = 1; o < 64; o <<= 1) { const float t = __shfl_down(v, o); v = (lane + o < 64) ? fmaxf(v, t) : v; }
    return v;
}
__device__ __forceinline__ float wave_max(float v) {
#pragma unroll
    for (int o = 1; o < 64; o <<= 1) v = fmaxf(v, __shfl_xor(v, o));
    return v;
}
__device__ __forceinline__ void conv8(const u32x4& x0, const u32x4& x1, const u32x4& x2, const float* cw, const float* cb, int ch0, float (&r8)[8]) {
#pragma unroll
    for (int e2 = 0; e2 < 2; ++e2) { const f32x4 w0 = *(const f32x4*)(cw + ch0 + 4 * e2), w1 = *(const f32x4*)(cw + 1024 + ch0 + 4 * e2), w2 = *(const f32x4*)(cw + 2048 + ch0 + 4 * e2), bb = *(const f32x4*)(cb + ch0 + 4 * e2);
#pragma unroll
        for (int e = 0; e < 4; ++e) { const int ee = e2 * 4 + e; const unsigned sh = 16 * (ee & 1);
            const float a0 = bf2f((x0[ee >> 1] >> sh) & 0xffffu), a1 = bf2f((x1[ee >> 1] >> sh) & 0xffffu), a2 = bf2f((x2[ee >> 1] >> sh) & 0xffffu);
            float v = a0 * w0[e]; v += a1 * w1[e]; v += a2 * w2[e]; v += bb[e]; r8[ee] = silu_f(v); } }
}
__device__ __forceinline__ void mstate_unit(const Params& P, LAS unsigned char* lds, int unit, int tid, int wave, int lane) {
    const int b = unit >> 8, c = (unit >> 2) & 63, h = unit & 3;
    LAS bf16_t* Kwf = (LAS bf16_t*)lds; LAS bf16_t* Kwb = (LAS bf16_t*)(lds + 36864); LAS bf16_t* Vs = (LAS bf16_t*)(lds + 73728);
    LAS float* wf = (LAS float*)(lds + 110592); LAS float* wb = wf + 128;
    unsigned char* ws = P.ws;
    const bf16_t* PROJ = (const bf16_t*)(ws + WS_PROJ); const float* GATES = (const float*)(ws + WS_GATES);
    float* GV = (float*)(ws + WS_GV); float* SC = (float*)(ws + WS_SC); float* NC = (float*)(ws + WS_NC); bf16_t* KVC = (bf16_t*)P.out;
    bf16_t* QM = (bf16_t*)(ws + WS_QM); bf16_t* KM = (bf16_t*)(ws + WS_KM);
    const size_t m0 = (size_t)b * SEQ + (size_t)c * 128;
    const int fr = lane & 15, fq = lane >> 4;
    __syncthreads();
    float gi0 = 0.f, gf0 = 0.f, gi1 = 0.f, gf1 = 0.f;
    if (wave < 2) { const float* gp = GATES + (m0 + lane) * 16 + wave * 8 + h; gi0 = gp[0]; gf0 = gp[4]; gi1 = gp[64 * 16]; gf1 = gp[64 * 16 + 4]; }
    u32x4 xk[3][3], xv[3];
#define MS_LOAD(it, j) do { const int idx = tid + 512 * (it), s = idx >> 4, part = idx & 15; const int t = c * 128 + s; const bf16_t* rowm = PROJ + (m0 + s) * NPROJ; \
        const int pk = 1280 + h * 128 + part * 8; const u32x4 z = {0u, 0u, 0u, 0u}; \
        xk[j][1] = *(const u32x4*)(rowm + pk); xv[j] = *(const u32x4*)(rowm + 1792 + h * 128 + part * 8); \
        xk[j][0] = z; xk[j][2] = z; \
        if (t > 0) { xk[j][0] = *(const u32x4*)(rowm - NPROJ + pk); } \
        if (t < SEQ - 1) { xk[j][2] = *(const u32x4*)(rowm + NPROJ + pk); } } while (0)
    MS_LOAD(0, 0); MS_LOAD(1, 1);
    if (wave < 2) {
        const float l0 = logsig_f(gf0), l1 = logsig_f(gf1); float p0, p1, tot;
        if (wave == 0) { p0 = scan_up_add(l0, lane); const float t0 = __shfl(p0, 63); p1 = scan_up_add(l1, lane) + t0; tot = __shfl(p1, 63); }
        else { p1 = scan_down_add(l1, lane); const float t1 = __shfl(p1, 0); p0 = scan_down_add(l0, lane) + t1; tot = __shfl(p0, 0); }
        const float u0 = gi0 - p0, u1 = gi1 - p1; const float umax = wave_max(fmaxf(u0, u1));
        LAS float* wv = wave ? wb : wf; wv[lane] = __expf(u0 - umax); wv[64 + lane] = __expf(u1 - umax);
        float* gv = GV + (size_t)unit * 512 + wave * 128; gv[lane] = u0; gv[64 + lane] = u1; gv[256 + lane] = p0; gv[256 + 64 + lane] = p1;
        if (lane == 0) { float* sc = SC + unit * 4 + wave * 2; sc[0] = tot; sc[1] = tot + umax; }
    }
    __syncthreads();
#define MS_COMPUTE(it, j) do { const int idx = tid + 512 * (it), s = idx >> 4, part = idx & 15; const float wfs = wf[s], wbs = wb[s]; float r8[8]; \
        conv8(xk[j][0], xk[j][1], xk[j][2], P.conv_w, P.conv_b, 512 + h * 128 + part * 8, r8); \
        { u32x4 w; w.x = pk2(r8[0], r8[1]); w.y = pk2(r8[2], r8[3]); w.z = pk2(r8[4], r8[5]); w.w = pk2(r8[6], r8[7]); *(u32x4*)(KM + (m0 + s) * 512 + h * 128 + part * 8) = w; \
          u32x4 a; a.x = pk2(r8[0] * wfs, r8[1] * wfs); a.y = pk2(r8[2] * wfs, r8[3] * wfs); a.z = pk2(r8[4] * wfs, r8[5] * wfs); a.w = pk2(r8[6] * wfs, r8[7] * wfs); *(LAS u32x4*)(Kwf + s * 144 + part * 8) = a; \
          u32x4 bq; bq.x = pk2(r8[0] * wbs, r8[1] * wbs); bq.y = pk2(r8[2] * wbs, r8[3] * wbs); bq.z = pk2(r8[4] * wbs, r8[5] * wbs); bq.w = pk2(r8[6] * wbs, r8[7] * wbs); *(LAS u32x4*)(Kwb + s * 144 + part * 8) = bq; } \
        *(LAS u32x4*)(Vs + s * 144 + part * 8) = xv[j]; } while (0)
    MS_LOAD(2, 2); MS_COMPUTE(0, 0);
    MS_LOAD(3, 0); MS_COMPUTE(1, 1);
    MS_COMPUTE(2, 2); MS_COMPUTE(3, 0);
#undef MS_LOAD
#undef MS_COMPUTE
    __syncthreads();
    {
        const int dir = wave >> 2, wq = wave & 3, vt0 = wq * 2; const LAS bf16_t* Kw = dir ? Kwb : Kwf;
        const int troff = (fq * 4 + ((lane >> 2) & 3)) * 144 + (lane & 3) * 4;
        const unsigned onev = (fr == 0) ? 0x3f803f80u : 0u; const bf16x8 ones = mk8(onev, onev, onev, onev);
        f32x4 acc[2][8], nacc[2];
#pragma unroll
        for (int vi = 0; vi < 2; ++vi) { nacc[vi] = (f32x4){0.f, 0.f, 0.f, 0.f};
#pragma unroll
            for (int kt = 0; kt < 8; ++kt) acc[vi][kt] = (f32x4){0.f, 0.f, 0.f, 0.f}; }
#pragma unroll
        for (int ks = 0; ks < 4; ++ks) { const LAS bf16_t* vp = Vs + ks * 32 * 144 + troff + vt0 * 16; const LAS bf16_t* kp = Kw + ks * 32 * 144 + troff;
            const u32x2 l0 = tr_read(vp), h0 = tr_read(vp + 16 * 144), l1 = tr_read(vp + 16), h1 = tr_read(vp + 16 * 144 + 16);
            const bf16x8 a0 = mk8(l0.x, l0.y, h0.x, h0.y), a1 = mk8(l1.x, l1.y, h1.x, h1.y);
#pragma unroll
            for (int kt = 0; kt < 8; ++kt) { const u32x2 bl = tr_read(kp + kt * 16), bh = tr_read(kp + 16 * 144 + kt * 16); const bf16x8 bb = mk8(bl.x, bl.y, bh.x, bh.y);
                acc[0][kt] = mfma16(a0, bb, acc[0][kt]); acc[1][kt] = mfma16(a1, bb, acc[1][kt]);
                if ((kt >> 1) == wq) nacc[kt & 1] = mfma16(ones, bb, nacc[kt & 1]); } }
        bf16_t* outp = KVC + (size_t)(unit * 2 + dir) * 16384;
#pragma unroll
        for (int vi = 0; vi < 2; ++vi)
#pragma unroll
            for (int kt = 0; kt < 8; ++kt)
#pragma unroll
                for (int i = 0; i < 4; i += 2) { const unsigned pq = pk2(acc[vi][kt][i], acc[vi][kt][i + 1]);
                    outp[((vt0 + vi) * 16 + fq * 4 + i) * 128 + kt * 16 + fr] = (bf16_t)(pq & 0xffffu); outp[((vt0 + vi) * 16 + fq * 4 + i + 1) * 128 + kt * 16 + fr] = (bf16_t)(pq >> 16); }
        if (fq == 0) { float* np = NC + (size_t)(unit * 2 + dir) * 128 + wq * 32 + fr; np[0] = nacc[0][0]; np[16] = nacc[1][0]; }
    }
}

__device__ __forceinline__ void scan_phase(const Params& P, int tid) {
    unsigned char* ws = P.ws;
    const bf16_t* KVC = (const bf16_t*)P.out; const float* SC = (const float*)(ws + WS_SC); const float* NC = (const float*)(ws + WS_NC);
    bf16_t* CPREV = (bf16_t*)(ws + WS_XN); float* NPREV = (float*)(ws + WS_NPREV); float* MPREV = (float*)(ws + WS_MPREV);
    for (int blk = blockIdx.x; blk < 256; blk += gridDim.x) {
        const int seq = blk >> 4, e2 = (blk & 15) * NTHREADS + tid, b = seq >> 3, h = (seq >> 1) & 3, dir = seq & 1;
        const int off = (e2 >> 6) * 128 + (e2 & 63) * 2;
        const bool do_n = e2 < 128;
        float c0 = 0.f, c1 = 0.f, nst = 0.f, mst = 0.f;
        for (int jb = 0; jb < 64; jb += 16) {
            f32x2_t kv[16]; float bl[16], am[16], nn[16];
#pragma unroll
            for (int u = 0; u < 16; ++u) { const int j = jb + u, cidx = dir ? 63 - j : j, unit = (b * 64 + cidx) * 4 + h;
                { const unsigned pq = *(const unsigned*)(KVC + (size_t)(unit * 2 + dir) * 16384 + off); kv[u] = (f32x2_t){bf2f(pq & 0xffffu), bf2f(pq >> 16)}; }
                bl[u] = SC[unit * 4 + dir * 2]; am[u] = SC[unit * 4 + dir * 2 + 1]; nn[u] = do_n ? NC[(size_t)(unit * 2 + dir) * 128 + e2] : 0.f; }
#pragma unroll
            for (int u = 0; u < 16; ++u) { const int j = jb + u, cidx = dir ? 63 - j : j, unit = (b * 64 + cidx) * 4 + h;
                *(unsigned*)(CPREV + (size_t)(unit * 2 + dir) * 16384 + off) = pk2(c0, c1);
                if (do_n) NPREV[(size_t)(unit * 2 + dir) * 128 + e2] = nst;
                if (e2 == 0) MPREV[unit * 2 + dir] = mst;
                const float m_new = fmaxf(bl[u] + mst, am[u]); const float dec = __expf(bl[u] + mst - m_new), inj = __expf(am[u] - m_new);
                c0 = dec * c0 + inj * kv[u][0]; c1 = dec * c1 + inj * kv[u][1]; nst = dec * nst + inj * nn[u]; mst = m_new; }
        }
    }
}

__device__ __forceinline__ void mout_unit(const Params& P, LAS unsigned char* lds, int unit, int tid, int wave, int lane) {
    const int b = unit >> 8, c = (unit >> 2) & 63, h = unit & 3;
    LAS bf16_t* Ks = (LAS bf16_t*)lds;
    LAS bf16_t* Vs = (LAS bf16_t*)(lds + 34816);
    LAS bf16_t* Cf = (LAS bf16_t*)(lds + 71680);
    LAS bf16_t* Cb = (LAS bf16_t*)(lds + 106496);
    LAS float* fa = (LAS float*)(lds + 141312);
    LAS float* uf = fa; LAS float* ub = fa + 128; LAS float* Mf = fa + 256; LAS float* Mb = fa + 384; LAS float* inf_ = fa + 512; LAS float* inb = fa + 640;
    LAS float* emf = fa + 768; LAS float* emb = fa + 896; LAS float* npf = fa + 1024; LAS float* npb = fa + 1152;
    unsigned char* ws = P.ws;
    const bf16_t* PROJ = (const bf16_t*)(ws + WS_PROJ); const bf16_t* QM = (const bf16_t*)(ws + WS_QM); const bf16_t* KM = (const bf16_t*)(ws + WS_KM);
    const bf16_t* CPREV = (const bf16_t*)(ws + WS_XN); const float* NPREV = (const float*)(ws + WS_NPREV); const float* MPREV = (const float*)(ws + WS_MPREV);
    const float* GV = (const float*)(ws + WS_GV); bf16_t* A2 = (bf16_t*)(ws + WS_A2);
    const size_t m0 = (size_t)b * SEQ + (size_t)c * 128;
    const int fr = lane & 15, fq = lane >> 4;
    const int t = wave * 16 + fr;
    __syncthreads();
    u32x4 rk[4], rv[4], rcf[4], rcb[4];
#pragma unroll
    for (int it = 0; it < 4; ++it) { const int idx = tid + 512 * it, s = idx >> 4, part = idx & 15;
        rk[it] = *(const u32x4*)(KM + (m0 + s) * 512 + h * 128 + part * 8); rv[it] = *(const u32x4*)(PROJ + (m0 + s) * NPROJ + 1792 + h * 128 + part * 8);
        rcf[it] = *(const u32x4*)(CPREV + (size_t)(unit * 2) * 16384 + s * 128 + part * 8); rcb[it] = *(const u32x4*)(CPREV + (size_t)(unit * 2 + 1) * 16384 + s * 128 + part * 8); }
    u32x4 xq[4][3];
    { const int pos = c * 128 + t; const bf16_t* rowq = PROJ + (m0 + t) * NPROJ + 768 + h * 128 + fq * 8;
#pragma unroll
      for (int kk = 0; kk < 4; ++kk) { const u32x4 z = {0u, 0u, 0u, 0u}; xq[kk][1] = *(const u32x4*)(rowq + kk * 32); xq[kk][0] = z; xq[kk][2] = z;
          if (pos > 0) xq[kk][0] = *(const u32x4*)(rowq - NPROJ + kk * 32); if (pos < SEQ - 1) xq[kk][2] = *(const u32x4*)(rowq + NPROJ + kk * 32); } }
    if (wave < 2) {
        const float* gv = GV + (size_t)unit * 512 + wave * 128; const float u0 = gv[lane], u1 = gv[64 + lane], bc0 = gv[256 + lane], bc1 = gv[256 + 64 + lane];
        const float mp = MPREV[unit * 2 + wave]; float a0, a1;
        if (wave == 0) { a0 = fmaxf(scan_up_max(u0, lane), mp); const float cr = __shfl(a0, 63); a1 = fmaxf(scan_up_max(u1, lane), cr); }
        else { a1 = fmaxf(scan_down_max(u1, lane), mp); const float cr = __shfl(a1, 0); a0 = fmaxf(scan_down_max(u0, lane), cr); }
        LAS float* ua = wave ? ub : uf; LAS float* Ma = wave ? Mb : Mf; LAS float* ia = wave ? inb : inf_; LAS float* ea = wave ? emb : emf;
        ua[lane] = u0; ua[64 + lane] = u1; Ma[lane] = a0; Ma[64 + lane] = a1; ia[lane] = __expf(mp - a0); ia[64 + lane] = __expf(mp - a1);
        ea[lane] = __expf(-(bc0 + a0)); ea[64 + lane] = __expf(-(bc1 + a1));
    } else if (wave == 2) { npf[lane] = NPREV[(size_t)(unit * 2) * 128 + lane]; npf[64 + lane] = NPREV[(size_t)(unit * 2) * 128 + 64 + lane];
        npb[lane] = NPREV[(size_t)(unit * 2 + 1) * 128 + lane]; npb[64 + lane] = NPREV[(size_t)(unit * 2 + 1) * 128 + 64 + lane]; }
#pragma unroll
    for (int it = 0; it < 4; ++it) { const int idx = tid + 512 * it, s = idx >> 4, part = idx & 15;
        *(LAS u32x4*)(Ks + s * 136 + part * 8) = rk[it]; *(LAS u32x4*)(Vs + s * 144 + part * 8) = rv[it];
        *(LAS u32x4*)(Cf + s * 136 + part * 8) = rcf[it]; *(LAS u32x4*)(Cb + s * 136 + part * 8) = rcb[it]; }
    __syncthreads();
    bf16x8 qf[4];
#pragma unroll
    for (int kk = 0; kk < 4; ++kk) { float r8[8]; conv8(xq[kk][0], xq[kk][1], xq[kk][2], P.conv_w, P.conv_b, h * 128 + kk * 32 + fq * 8, r8);
        const float sc = 0.08838834764831845f;
        qf[kk] = mk8(pk2(r8[0] * sc, r8[1] * sc), pk2(r8[2] * sc, r8[3] * sc), pk2(r8[4] * sc, r8[5] * sc), pk2(r8[6] * sc, r8[7] * sc)); }
    float qnf = 0.f, qnb = 0.f;
#pragma unroll
    for (int kk = 0; kk < 4; ++kk) { const u32x4 qq = __builtin_bit_cast(u32x4, qf[kk]);
#pragma unroll
        for (int j = 0; j < 8; ++j) { const float qv = bf2f((qq[j >> 1] >> (16 * (j & 1))) & 0xffffu); const int d = kk * 32 + fq * 8 + j; qnf += qv * npf[d]; qnb += qv * npb[d]; } }
    qnf = quad_sum(qnf); qnb = quad_sum(qnb);
    f32x4 sT[8];
#pragma unroll
    for (int st = 0; st < 8; ++st) { f32x4 a = {0.f, 0.f, 0.f, 0.f};
#pragma unroll
        for (int kk = 0; kk < 4; ++kk) a = mfma16(*(const LAS bf16x8*)(Ks + (st * 16 + fr) * 136 + kk * 32 + fq * 8), qf[kk], a);
        sT[st] = a; }
    const int troff = (fq * 4 + ((lane >> 2) & 3)) * 144 + (lane & 3) * 4;
    f32x4 hsum[8];
#pragma unroll
    for (int vt = 0; vt < 8; ++vt) hsum[vt] = (f32x4){0.f, 0.f, 0.f, 0.f};
#pragma unroll 1
    for (int dir = 0; dir < 2; ++dir) {
        f32x4 acc[8];
        const LAS bf16_t* Cp = dir ? Cb : Cf;
#pragma unroll
        for (int vt = 0; vt < 8; ++vt) { f32x4 a = {0.f, 0.f, 0.f, 0.f};
#pragma unroll
            for (int kk = 0; kk < 4; ++kk) a = mfma16(*(const LAS bf16x8*)(Cp + (vt * 16 + fr) * 136 + kk * 32 + fq * 8), qf[kk], a);
            acc[vt] = a; }
        const float inter = dir ? inb[t] : inf_[t], Mt = dir ? Mb[t] : Mf[t];
#pragma unroll
        for (int vt = 0; vt < 8; ++vt) acc[vt] *= inter;
        float den = 0.f; unsigned pk[8][2];
#pragma unroll
        for (int st = 0; st < 8; ++st) { const f32x4 uu = *(const LAS f32x4*)((dir ? ub : uf) + st * 16 + fq * 4); float p[4];
#pragma unroll
            for (int i = 0; i < 4; ++i) { const int s = st * 16 + fq * 4 + i; const bool ok = dir ? (s >= t) : (s <= t); const float w = ok ? __expf(uu[i] - Mt) : 0.f; p[i] = sT[st][i] * w; den += p[i]; }
            pk[st][0] = pk2(p[0], p[1]); pk[st][1] = pk2(p[2], p[3]); }
        den = quad_sum(den) + inter * (dir ? qnb : qnf);
        const int ks_lo = dir ? (wave >> 1) : 0, ks_hi = dir ? 3 : (wave >> 1);
#pragma unroll
        for (int ks = 0; ks < 4; ++ks) if (ks >= ks_lo && ks <= ks_hi) { const bf16x8 bfrag = mk8(pk[2 * ks][0], pk[2 * ks][1], pk[2 * ks + 1][0], pk[2 * ks + 1][1]);
            const LAS bf16_t* vp = Vs + ks * 32 * 144 + troff;
#pragma unroll
            for (int vt = 0; vt < 8; ++vt) { const u32x2 lo = tr_read(vp + vt * 16), hi = tr_read(vp + 16 * 144 + vt * 16);
                acc[vt] = mfma16(mk8(lo.x, lo.y, hi.x, hi.y), bfrag, acc[vt]); } }
        const float rd = 1.0f / fmaxf(fabsf(den), dir ? emb[t] : emf[t]);
#pragma unroll
        for (int vt = 0; vt < 8; ++vt) hsum[vt] += acc[vt] * rd;
    }
    float ss = 0.f;
#pragma unroll
    for (int vt = 0; vt < 8; ++vt) { const f32x4 v = hsum[vt]; ss += (v[0] * v[0] + v[1] * v[1]) + (v[2] * v[2] + v[3] * v[3]); }
    const float rstd = rsqrtf(quad_sum(ss) * (1.0f / 128.0f) + EPS) * sqrtf(((const float*)(ws + WS_ATTSS))[m0 + t] * (1.0f / 512.0f) + EPS);
#pragma unroll
    for (int vt = 0; vt < 8; ++vt) { const int v0 = h * 128 + vt * 16 + fq * 4; const f32x4 gv = *(const f32x4*)(P.g_mlstm_out + v0);
        const u32x2 om = *(const u32x2*)(PROJ + (m0 + t) * NPROJ + 2304 + v0);
        const float o0 = sigmoid_f(bf2f(om.x & 0xffffu)), o1 = sigmoid_f(bf2f(om.x >> 16)), o2 = sigmoid_f(bf2f(om.y & 0xffffu)), o3 = sigmoid_f(bf2f(om.y >> 16));
        const f32x4 v = hsum[vt] * rstd * gv; u32x2 w; w.x = pk2(v[0] * o0, v[1] * o1); w.y = pk2(v[2] * o2, v[3] * o3);
        *(u32x2*)(A2 + (m0 + t) * D + 512 + v0) = w; }
}

#define XB_TMO      128
#define XB_XCNT(j)  (256  + 64 * (j))
#define XB_XSUB(j)  (1280 + 64 * (j))
#define XB_XGEN(j)  (2304 + 64 * (j))
#define XB_TOP      3328
#define XB_TOPGEN   3392
#define XCD_BAR_WORDS 3456
#define XB_SPIN_CAP (1u << 18)

__device__ __forceinline__ unsigned xb_ld(unsigned* p)              { return __hip_atomic_load(p, __ATOMIC_RELAXED, __HIP_MEMORY_SCOPE_AGENT); }
__device__ __forceinline__ unsigned xb_add(unsigned* p, unsigned v) { return __hip_atomic_fetch_add(p, v, __ATOMIC_RELAXED, __HIP_MEMORY_SCOPE_AGENT); }
__device__ __forceinline__ unsigned xb_xcc_id() { return (unsigned)__builtin_amdgcn_s_getreg((3 << 11) | 20) & 0xFu; }
#define XB_SPIN(cond, bar) do { unsigned _sp = 0; while (cond) { __builtin_amdgcn_s_sleep(1); \
    if ((++_sp & 255u) == 0u) { if (xb_ld(&(bar)[XB_TMO])) break; if (_sp > XB_SPIN_CAP) { atomicAdd(&(bar)[XB_TMO], 1u); break; } } } } while (0)

struct XcdBarrier {
    unsigned* bar; unsigned x;
    volatile LAS unsigned* st;
};

__device__ __forceinline__ XcdBarrier xcd_barrier_post(unsigned* bar, volatile LAS unsigned* st) {
    XcdBarrier b; b.bar = bar; b.x = xb_xcc_id(); b.st = st;
    if (threadIdx.x == 0) (void)xb_add(&bar[XB_XCNT(b.x)], 1u);
    return b;
}
__device__ __forceinline__ void xcd_barrier_complete(unsigned* bar, unsigned x, unsigned& nloc, unsigned& nx) {
    const unsigned G = gridDim.x * gridDim.y * gridDim.z;
    unsigned sum, cnt, mine, sp = 0u;
    for (;;) {
        sum = 0u; cnt = 0u; mine = 0u;
#pragma unroll
        for (unsigned j = 0; j < 16; ++j) { const unsigned c = xb_ld(&bar[XB_XCNT(j)]); sum += c; cnt += (c > 0u) ? 1u : 0u; mine = (j == x) ? c : mine; }
        if (sum == G) break;
        __builtin_amdgcn_s_sleep(1);
        if ((++sp & 255u) == 0u) { if (xb_ld(&bar[XB_TMO])) break; if (sp > XB_SPIN_CAP) { atomicAdd(&bar[XB_TMO], 1u); break; } }
    }
    nloc = mine > 0u ? mine : 1u; nx = cnt > 0u ? cnt : 1u;
}

__device__ __forceinline__ void xcd_barrier(const XcdBarrier& b) {
    asm volatile("s_waitcnt vmcnt(0)" ::: "memory");
    __syncthreads();
    if (threadIdx.x == 0) {
        unsigned* bar = b.bar;
        __builtin_amdgcn_s_waitcnt(0);
        unsigned nloc = b.st[0], nx = b.st[1];
        if (nloc == 0u) { xcd_barrier_complete(bar, b.x, nloc, nx); b.st[0] = nloc; b.st[1] = nx; }
        const unsigned old = xb_add(&bar[XB_XSUB(b.x)], 1u);
        const unsigned gen = old / nloc;
        if (old + 1u == (gen + 1u) * nloc) {
            __builtin_amdgcn_fence(__ATOMIC_RELEASE, "agent");
            asm volatile("s_waitcnt vmcnt(0)" ::: "memory");
            const unsigned og = xb_add(&bar[XB_TOP], 1u);
            const unsigned tg = og / nx;
            if (og + 1u == (tg + 1u) * nx) xb_add(&bar[XB_TOPGEN], 1u);
            else XB_SPIN(xb_ld(&bar[XB_TOPGEN]) == tg, bar);
            __builtin_amdgcn_fence(__ATOMIC_ACQUIRE, "agent");
            xb_add(&bar[XB_XGEN(b.x)], 1u);
            asm volatile("s_waitcnt vmcnt(0)" ::: "memory");
        } else {
            XB_SPIN(xb_ld(&bar[XB_XGEN(b.x)]) == gen, bar);
            __builtin_amdgcn_fence(__ATOMIC_ACQUIRE, "agent");
            asm volatile("s_waitcnt vmcnt(0)" ::: "memory");
        }
    }
    __syncthreads();
}

__global__ void __launch_bounds__(NTHREADS) hybrid_fwd(Params P) {
    extern __shared__ __attribute__((aligned(16))) unsigned char lds_raw[];
    LAS unsigned char* lds = (LAS unsigned char*)lds_raw;
    cg::grid_group grid = cg::this_grid();
    const int tid = threadIdx.x, lane = tid & 63, wave = __builtin_amdgcn_readfirstlane(tid >> 6);
    volatile LAS unsigned* bst = (volatile LAS unsigned*)(lds + LDS_BYTES - 64);
    if (tid < 2) bst[tid] = 0u;
    __syncthreads();
    XcdBarrier bar = xcd_barrier_post((unsigned*)(P.ws + WS_BAR), bst);
    if (P.ph_lo < 0) grid.sync();
    unsigned char* ws = P.ws;
    const int vcu = ((int)gridDim.x % 8 == 0) ? ((int)blockIdx.x % 8) * ((int)gridDim.x / 8) + (int)blockIdx.x / 8 : (int)blockIdx.x;
    const float* MOD = (const float*)(ws + WS_MOD);
    bf16_t* XN = (bf16_t*)(ws + WS_XN);
#ifndef WGM_P2
#define WGM_P2 8
#endif
#ifndef WGM_P6
#define WGM_P6 8
#endif
#ifndef WGM_P8
#define WGM_P8 2
#endif
#ifndef WGM_P9
#define WGM_P9 8
#endif
#ifndef DUP_MASK
#define DUP_MASK 0
#endif
#ifndef PH_MASK
#define PH_MASK 0x7ff
#endif
#define IN(k) (((PH_MASK >> (k)) & 1) && P.ph_lo <= (k) && (k) < P.ph_hi)
#define SEAM(k) do { if (IN(k) && IN((k) + 1)) xcd_barrier(bar); } while (0)
    if (IN(0)) { for (int rep = 0; rep < 1 + ((DUP_MASK >> 0) & 1); ++rep) { phase0(P, lds, tid, wave, lane); __syncthreads(); } } SEAM(0);
    if (IN(1)) { for (int i = blockIdx.x * NTHREADS + tid; i < M; i += gridDim.x * NTHREADS) { ((float*)(ws + WS_ATTSS))[i] = 0.f; ((float*)(ws + WS_SS2))[i] = 0.f; ((float*)(ws + WS_SS3))[i] = 0.f; }
        for (int rep = 0; rep < 1 + ((DUP_MASK >> 1) & 1); ++rep) norm_mod_phase(P.x, P.g_norm1, MOD, 0, 1024, XN, wave, lane); } SEAM(1);
    if (IN(2)) for (int rep = 0; rep < 1 + ((DUP_MASK >> 2) & 1); ++rep) {
        pg8::Gemm g{XN, (const bf16_t*)(ws + WS_WIN), M, NPROJ, D}; pg8::StaticOrder S; S.init(M, NPROJ, (int)gridDim.x, (int)blockIdx.x, WGM_P2);
        EpiProj E{(bf16_t*)(ws + WS_PROJ), (float*)(ws + WS_GATES), P.b_gates};
        pg8::gemm_phase<EpiProj, pg8::StaticOrder, true, true>(lds, g, S, E);
    } SEAM(2);
    if (IN(3)) {
        for (int rep = 0; rep < 1 + ((DUP_MASK >> 11) & 1); ++rep) attn_phase(P, lds, tid, wave, lane, rep == 0);
        for (int rep = 0; rep < 1 + ((DUP_MASK >> 12) & 1); ++rep)
        for (int u = vcu; u < 512; u += gridDim.x) mstate_unit(P, lds, u, tid, wave, lane);
    } SEAM(3);
    if (IN(4)) { for (int rep = 0; rep < 1 + ((DUP_MASK >> 4) & 1); ++rep) scan_phase(P, tid); } SEAM(4);
    if (IN(5)) { for (int rep = 0; rep < 1 + ((DUP_MASK >> 5) & 1); ++rep) for (int u = vcu; u < 512; u += gridDim.x) mout_unit(P, lds, u, tid, wave, lane); } SEAM(5);
    if (IN(6)) for (int rep = 0; rep < 1 + ((DUP_MASK >> 6) & 1); ++rep) {
        __syncthreads();
        pg8::Gemm g{(const bf16_t*)(ws + WS_A2), (const bf16_t*)(ws + WS_WOUT), M, D, D}; pg8::StaticOrder S; S.init(M, D, (int)gridDim.x, (int)blockIdx.x, WGM_P6);
        EpiResidNorm E{P.x, P.out, MOD + 2048, (const float*)(ws + WS_ATTSS), (float*)(ws + WS_SS2), (unsigned*)(ws + WS_CNT), P.g_norm2, MOD + 4096, MOD + 3072, XN, nullptr, (bf16_t*)(ws + WS_QM)};
        pg8::gemm_phase<EpiResidNorm, pg8::StaticOrder, false, true>(lds, g, S, E);
    } do { if (IN(6) && IN(8)) xcd_barrier(bar); } while (0);
    if (IN(8)) for (int rep = 0; rep < 1 + ((DUP_MASK >> 8) & 1); ++rep) {
        pg8::Gemm g{XN, (const bf16_t*)(ws + WS_WFI), M, 2 * DFF, D}; pg8::StaticOrder S; S.init(M, 2 * DFF, (int)gridDim.x, (int)blockIdx.x, WGM_P8);
        EpiSwiglu E{(bf16_t*)(ws + WS_PROJ)};
        pg8::gemm_phase<EpiSwiglu, pg8::StaticOrder, true, true>(lds, g, S, E);
    } SEAM(8);
    if (IN(9)) {
        pg8::Gemm g{(const bf16_t*)(ws + WS_PROJ), (const bf16_t*)(ws + WS_WFO), M, D, DFF}; pg8::StaticOrder S; S.init(M, D, (int)gridDim.x, (int)blockIdx.x, WGM_P9);
        EpiResidNorm E{nullptr, P.out, MOD + 5120, nullptr, (float*)(ws + WS_SS3), (unsigned*)(ws + WS_CNT) + 1024, P.g_final, nullptr, nullptr, nullptr, (const bf16_t*)(ws + WS_QM), nullptr};
        pg8::gemm_phase<EpiResidNorm, pg8::StaticOrder, false, true>(lds, g, S, E);
    }
#undef IN
#undef SEAM
}

#ifndef MK_LAUNCHES
#define MK_LAUNCHES 1
#endif
extern "C" void kernel_launch(void* const* d_in, const int* in_sizes, int n_in, void* d_out, int out_size, void* d_ws, size_t ws_size, hipStream_t stream) {
    static int ready = 0;
    if (!ready) {
        if (n_in != 17 || out_size != M * D || ws_size < WS_END) { fprintf(stderr, "kernel_launch: unexpected shapes (n_in %d out %d ws %zu)\n", n_in, out_size, ws_size); ready = -1; return; }
        if (hipFuncSetAttribute((const void*)hybrid_fwd, hipFuncAttributeMaxDynamicSharedMemorySize, LDS_BYTES) != hipSuccess) { fprintf(stderr, "kernel_launch: hipFuncSetAttribute failed\n"); ready = -1; return; }
        ready = 1;
    }
    if (ready < 0) return;
    Params p{};
    const float** pp = (const float**)&p;
    for (int i = 0; i < 17; ++i) pp[i] = (const float*)d_in[i];
    p.out = (float*)d_out; p.ws = (unsigned char*)d_ws;
    (void)hipMemsetAsync((unsigned char*)d_ws + WS_BAR, 0, 32768, stream);
#if MK_LAUNCHES == 1
    p.ph_lo = 0; p.ph_hi = NPHASES;
    void* args[] = {&p};
    hipError_t e = hipLaunchCooperativeKernel((const void*)hybrid_fwd, dim3(256), dim3(NTHREADS), args, LDS_BYTES, stream);
    if (e != hipSuccess) fprintf(stderr, "cooperative launch failed: %s\n", hipGetErrorString(e));
#else
    for (int k = 0; k < NPHASES; ++k) { p.ph_lo = k; p.ph_hi = k + 1; void* args[] = {&p};
        hipError_t e = hipLaunchCooperativeKernel((const void*)hybrid_fwd, dim3(256), dim3(NTHREADS), args, LDS_BYTES, stream);
        if (e != hipSuccess) fprintf(stderr, "launch %d failed: %s\n", k, hipGetErrorString(e)); }
#endif
}
```

```cpp
#include <hip/hip_runtime.h>
#include <hip/hip_cooperative_groups.h>
#include <cstdio>
#include <cstdint>
namespace cg = cooperative_groups;
namespace pg8 {
#define PG8_LAS __attribute__((address_space(3)))
typedef unsigned short bf16_t;
typedef short bf16x8 __attribute__((ext_vector_type(8)));
typedef float f32x4 __attribute__((ext_vector_type(4)));
typedef unsigned u32x4 __attribute__((ext_vector_type(4)));
constexpr int BM = 256, BK = 64, HALF = 128, HTB = HALF * BK * 2  , STAGE_BYTES = 8 * HTB, NXCD = 8, WGM = 8;

__host__ __device__ __forceinline__ int lds_byte(int r, int c) { const int st = (r >> 4) * 2 + (c >> 5), rr = r & 15, cc = c & 31, ob = rr * 64 + cc * 2; return st * 1024 + (ob ^ (((ob >> 9) & 1) << 5)); }
__host__ __device__ __forceinline__ void stage_rc(int b, int& R, int& C) { const int st = b / 1024, sb = b % 1024, swz = sb ^ (((sb >> 9) & 1) << 5); R = (st >> 1) * 16 + swz / 64; C = (st & 1) * 32 + (swz % 64) / 2; }
__host__ __device__ __forceinline__ int perm32(int rho) { const int n = rho >> 4, i = rho & 15; return 8 * (i >> 2) + 4 * n + (i & 3); }

struct Unit { int pm, pn; };
struct Gemm { const bf16_t* A; const bf16_t* Bt; int M, N, K; };

struct StaticOrder {
    int nM, nN, nwg, G, c, wgm;
    __host__ __device__ void init(int M, int N, int G_, int c_, int wgm_ = WGM) { nM = M / BM; nN = N / BM; nwg = nM * nN; G = G_; c = c_; wgm = wgm_; }
    __host__ __device__ bool next(int i, Unit& u) const {
        const long L = (long)i * G + c; if (L >= nwg) return false;
        int wgid = (int)L; { const int q = nwg / NXCD, r = nwg % NXCD, xcd = wgid % NXCD, off = wgid / NXCD; wgid = (xcd < r ? xcd * (q + 1) : r * (q + 1) + (xcd - r) * q) + off; }
        const int nig = wgm * nN, gid = wgid / nig, fm = gid * wgm, gsz = (nM - fm) < wgm ? (nM - fm) : wgm;
        u.pm = fm + ((wgid % nig) % gsz); u.pn = (wgid % nig) / gsz; return true;
    }
    __device__ __forceinline__ void a_ready(const Unit&) const {}
    __device__ __forceinline__ void done(const Unit&) const {}
};

__device__ __forceinline__ unsigned cvt_pk_bf16(float lo, float hi) { unsigned r; asm volatile("v_cvt_pk_bf16_f32 %0, %1, %2" : "=v"(r) : "v"(lo), "v"(hi)); return r; }
typedef float f32x2 __attribute__((ext_vector_type(2)));
template <class Epi, class Sched, bool ALIGN_EPI = false, bool SP2 = false>
__device__ __forceinline__ void gemm_phase(PG8_LAS unsigned char* lds, const Gemm g, const Sched& S, const Epi& E) {
    const int tid = threadIdx.x, wid = __builtin_amdgcn_readfirstlane(tid >> 6), lane = tid & 63, wr = wid >> 2, wc = wid & 3, fr = lane & 15, fq = lane >> 4;
    const int K = g.K, nt = K / BK;
    unsigned voffA[2], voffB[2];
#pragma unroll
    for (int i = 0; i < 2; ++i) { int R, C; stage_rc(tid * 16 + i * 8192, R, C); const int Rb = Epi::PERM ? ((R & ~31) + perm32(R & 31)) : R;
        voffA[i] = (unsigned)(R * K + C) * 2u; voffB[i] = (unsigned)(Rb * K + C) * 2u; }
    const size_t kstep = (size_t)(BK * 2);
    const size_t hstep = (size_t)HALF * K * 2;
    const size_t tstep = 2 * hstep;
    const unsigned ldsw = (unsigned)wid * 1024u;
    const int aoff = lds_byte(wr * 64 + fr, fq * 8), boff = lds_byte(wc * 32 + fr, fq * 8);
#define PG8_SA(b, h) (((b) * 2 + (h)) * HTB)
#define PG8_SB(b, h) ((4 + (b) * 2 + (h)) * HTB)
#define PG8_STAGE(bufoff, gbase, voff) do { _Pragma("unroll") for (int _i = 0; _i < 2; ++_i) \
        __builtin_amdgcn_global_load_lds((const unsigned*)((const char*)(gbase) + (voff)[_i]), (PG8_LAS unsigned*)(lds + (bufoff) + ldsw + _i * 8192), 16, 0, 0); } while (0)
#define PG8_LDA(dst, b, h) do { _Pragma("unroll") for (int m = 0; m < 4; ++m) _Pragma("unroll") for (int k = 0; k < 2; ++k) dst[m][k] = *(const PG8_LAS bf16x8*)(lds + PG8_SA(b, h) + aoff + m * 2048 + k * 1024); } while (0)
#define PG8_LDB(dst, b, h) do { _Pragma("unroll") for (int n = 0; n < 2; ++n) _Pragma("unroll") for (int k = 0; k < 2; ++k) dst[n][k] = *(const PG8_LAS bf16x8*)(lds + PG8_SB(b, h) + boff + n * 2048 + k * 1024); } while (0)
#define PG8_MMA(ai, bj, At, Bt) do { __builtin_amdgcn_s_setprio(1); _Pragma("unroll") for (int m = 0; m < 4; ++m) _Pragma("unroll") for (int n = 0; n < 2; ++n) _Pragma("unroll") for (int k = 0; k < 2; ++k) \
        acc[ai][bj][m][n] = __builtin_amdgcn_mfma_f32_16x16x32_bf16(Bt[n][k], At[m][k], acc[ai][bj][m][n], 0, 0, 0); __builtin_amdgcn_s_setprio(0); } while (0)
#define PG8_WAIT_V(n) asm volatile("s_waitcnt vmcnt(" #n ")" ::: "memory")
#define PG8_WAIT_L(n) asm volatile("s_waitcnt lgkmcnt(" #n ")" ::: "memory")
#define PG8_BAR __builtin_amdgcn_s_barrier()
#define PG8_SCHED __builtin_amdgcn_sched_barrier(0)
    Unit cur, nxt; int ui = 0;
    if (!S.next(0, cur)) return;
    f32x4 acc[2][2][4][2];
#pragma unroll
    for (int a = 0; a < 2; ++a)
#pragma unroll
        for (int b = 0; b < 2; ++b)
#pragma unroll
            for (int m = 0; m < 4; ++m)
#pragma unroll
                for (int n = 0; n < 2; ++n) acc[a][b][m][n] = (f32x4){0.f, 0.f, 0.f, 0.f};
    bf16x8 At[4][2], B0[2][2], B1[2][2];
    const char* cA = (const char*)g.A + (size_t)cur.pm * tstep; const char* cB = (const char*)g.Bt + (size_t)cur.pn * tstep;
    S.a_ready(cur);
    if constexpr (SP2) {
        PG8_STAGE(PG8_SB(0, 0), cB, voffB); PG8_STAGE(PG8_SB(0, 1), cB + hstep, voffB); PG8_STAGE(PG8_SA(0, 0), cA, voffA); PG8_STAGE(PG8_SA(0, 1), cA + hstep, voffA);
        if (wr == 1) PG8_BAR;
        PG8_WAIT_V(2); PG8_BAR;
        PG8_STAGE(PG8_SB(1, 0), cB + kstep, voffB); PG8_STAGE(PG8_SA(1, 0), cA + kstep, voffA); PG8_STAGE(PG8_SB(1, 1), cB + hstep + kstep, voffB);
        PG8_WAIT_V(6); PG8_BAR;
    } else {
        PG8_STAGE(PG8_SB(0, 0), cB, voffB); PG8_STAGE(PG8_SA(0, 0), cA, voffA); PG8_STAGE(PG8_SB(0, 1), cB + hstep, voffB); PG8_STAGE(PG8_SA(0, 1), cA + hstep, voffA);
        if (wr == 1) PG8_BAR;
        PG8_WAIT_V(4); PG8_BAR;
        PG8_STAGE(PG8_SB(1, 0), cB + kstep, voffB); PG8_STAGE(PG8_SA(1, 0), cA + kstep, voffA); PG8_STAGE(PG8_SB(1, 1), cB + hstep + kstep, voffB);
        PG8_WAIT_V(6); PG8_BAR;
    }
    for (;;) {
        const bool has_next = S.next(ui + 1, nxt);
        const char* nA = has_next ? (const char*)g.A + (size_t)nxt.pm * tstep : cA; const char* nB = has_next ? (const char*)g.Bt + (size_t)nxt.pn * tstep : cB;
        for (int t = 0; t < nt; t += 2) {
            const bool last = (t == nt - 2);
            const char* a1 = cA + (size_t)(t + 1) * kstep;
            const char* a2 = last ? nA : cA + (size_t)(t + 2) * kstep; const char* b2 = last ? nB : cB + (size_t)(t + 2) * kstep;
            const char* a3 = a2 + kstep; const char* b3 = b2 + kstep;
            if (last && has_next) S.a_ready(nxt);
            if constexpr (SP2) {
            PG8_LDB(B0, 0, 0); PG8_LDB(B1, 0, 1); PG8_SCHED; PG8_LDA(At, 0, 0); PG8_STAGE(PG8_SA(1, 1), a1 + hstep, voffA);
            PG8_WAIT_V(8); PG8_WAIT_L(0); PG8_BAR; PG8_MMA(0, 0, At, B0); PG8_MMA(0, 1, At, B1); PG8_BAR; PG8_SCHED;
            PG8_LDA(At, 0, 1); PG8_STAGE(PG8_SB(0, 0), b2, voffB); PG8_STAGE(PG8_SB(0, 1), b2 + hstep, voffB); PG8_STAGE(PG8_SA(0, 0), a2, voffA);
            PG8_WAIT_V(8); PG8_WAIT_L(0); PG8_BAR; PG8_MMA(1, 0, At, B0); PG8_MMA(1, 1, At, B1); PG8_BAR; PG8_SCHED;
            PG8_LDB(B0, 1, 0); PG8_LDB(B1, 1, 1); PG8_SCHED; PG8_LDA(At, 1, 0); PG8_STAGE(PG8_SA(0, 1), a2 + hstep, voffA);
            PG8_WAIT_V(8); PG8_WAIT_L(0); PG8_BAR; PG8_MMA(0, 0, At, B0); PG8_MMA(0, 1, At, B1); PG8_BAR; PG8_SCHED;
            PG8_LDA(At, 1, 1); PG8_STAGE(PG8_SB(1, 0), b3, voffB); PG8_STAGE(PG8_SB(1, 1), b3 + hstep, voffB); PG8_STAGE(PG8_SA(1, 0), a3, voffA);
            PG8_WAIT_V(8); PG8_WAIT_L(0); PG8_BAR; PG8_MMA(1, 0, At, B0); PG8_MMA(1, 1, At, B1); PG8_BAR; PG8_SCHED;
            } else {
            PG8_LDB(B0, 0, 0); PG8_SCHED; PG8_LDA(At, 0, 0); PG8_STAGE(PG8_SA(1, 1), a1 + hstep, voffA);
            PG8_WAIT_L(8); PG8_BAR; PG8_WAIT_L(0); PG8_MMA(0, 0, At, B0); PG8_BAR; PG8_SCHED;
            PG8_LDB(B1, 0, 1); PG8_STAGE(PG8_SB(0, 0), b2, voffB);
            PG8_BAR; PG8_WAIT_L(0); PG8_MMA(0, 1, At, B1); PG8_BAR;
            PG8_LDA(At, 0, 1); PG8_STAGE(PG8_SA(0, 0), a2, voffA);
            PG8_BAR; PG8_WAIT_L(0); PG8_MMA(1, 0, At, B0); PG8_BAR; PG8_SCHED;
            PG8_STAGE(PG8_SB(0, 1), b2 + hstep, voffB);
            PG8_WAIT_V(6); PG8_BAR; PG8_MMA(1, 1, At, B1); PG8_BAR;
            PG8_LDB(B0, 1, 0); PG8_SCHED; PG8_LDA(At, 1, 0); PG8_STAGE(PG8_SA(0, 1), a2 + hstep, voffA);
            PG8_WAIT_L(8); PG8_BAR; PG8_WAIT_L(0); PG8_MMA(0, 0, At, B0); PG8_BAR; PG8_SCHED;
            PG8_LDB(B1, 1, 1); PG8_STAGE(PG8_SB(1, 0), b3, voffB);
            PG8_BAR; PG8_WAIT_L(0); PG8_MMA(0, 1, At, B1); PG8_BAR;
            PG8_LDA(At, 1, 1); PG8_STAGE(PG8_SA(1, 0), a3, voffA);
            PG8_BAR; PG8_WAIT_L(0); PG8_MMA(1, 0, At, B0); PG8_BAR; PG8_SCHED;
            PG8_STAGE(PG8_SB(1, 1), b3 + hstep, voffB);
            PG8_WAIT_V(6); PG8_BAR; PG8_MMA(1, 1, At, B1); PG8_BAR;
            }
        }
        if constexpr (ALIGN_EPI) { if (wr == 0) PG8_BAR; }
        if constexpr (!Epi::AFTER_DRAIN) { E(acc, cur, wr, wc, fr, fq); S.done(cur); }
        if (!has_next) break;
#pragma unroll
        for (int a = 0; a < 2; ++a)
#pragma unroll
            for (int b = 0; b < 2; ++b)
#pragma unroll
                for (int m = 0; m < 4; ++m)
#pragma unroll
                    for (int n = 0; n < 2; ++n) acc[a][b][m][n] = (f32x4){0.f, 0.f, 0.f, 0.f};
        cur = nxt; cA = nA; cB = nB; ++ui;
        if constexpr (ALIGN_EPI) { if (wr == 1) PG8_BAR; }
    }
    PG8_WAIT_V(0);
    if constexpr (!ALIGN_EPI) { if (wr == 0) PG8_BAR; }
    PG8_BAR;
    if constexpr (Epi::AFTER_DRAIN) { E.fused(acc, cur, wr, wc, fr, fq, lds, wid, lane); S.done(cur); }
#undef PG8_SA
#undef PG8_SB
#undef PG8_STAGE
#undef PG8_LDA
#undef PG8_LDB
#undef PG8_MMA
#undef PG8_WAIT_V
#undef PG8_WAIT_L
#undef PG8_BAR
#undef PG8_SCHED
}
}

#define LAS __attribute__((address_space(3)))
typedef unsigned short bf16_t;
typedef short bf16x8 __attribute__((ext_vector_type(8)));
typedef float f32x4 __attribute__((ext_vector_type(4)));
typedef unsigned u32x4 __attribute__((ext_vector_type(4)));
typedef unsigned u32x2 __attribute__((ext_vector_type(2)));
typedef float f32x2_t __attribute__((ext_vector_type(2)));
typedef __bf16 bf16x2_t __attribute__((ext_vector_type(2)));

constexpr int SEQ = 8192, NB = 2, M = NB * SEQ, D = 1024, NPROJ = 3072, NIN = 2832, DFF = 2816, NMOD = 6144;
constexpr float EPS = 1e-6f;
constexpr int NTHREADS = 512, NWAVES = 8;
constexpr int LDS_BYTES = 155648;
constexpr int NPHASES = 11;

constexpr size_t MiB = 1u << 20;
constexpr size_t WS_MOD = 0;
constexpr size_t WS_SC = 256 * 1024;
constexpr size_t WS_MPREV = 320 * 1024;
constexpr size_t WS_ATTSS = 384 * 1024;
constexpr size_t WS_SS2 = 640 * 1024;
constexpr size_t WS_SS3 = 704 * 1024;
constexpr size_t WS_BAR = 512 * 1024;
constexpr size_t WS_CNT = 512 * 1024 + 16384;
constexpr size_t WS_GATES = 1 * MiB;
constexpr size_t WS_GV = 2 * MiB;
constexpr size_t WS_NC = 3 * MiB;
constexpr size_t WS_NPREV = 4 * MiB;
constexpr size_t WS_WIN = 6 * MiB;
constexpr size_t WS_WOUT = 12 * MiB;
constexpr size_t WS_WFI = 14 * MiB;
constexpr size_t WS_WFO = 25 * MiB;
constexpr size_t WS_PROJ = 32 * MiB;
constexpr size_t WS_QM = 128 * MiB;
constexpr size_t WS_KM = 144 * MiB;
constexpr size_t WS_XN = 160 * MiB;
constexpr size_t WS_A2 = 192 * MiB;
constexpr size_t WS_END = 224 * MiB;

struct Params {
    const float *x, *c, *w_mod, *b_mod, *g_norm1, *w_in, *conv_w, *conv_b, *b_gates, *sink, *g_attn_out, *g_mlstm_out, *w_out, *g_norm2, *w_ffn_in, *w_ffn_out, *g_final;
    float* out; unsigned char* ws; int ph_lo, ph_hi;
};

__device__ __forceinline__ float bf2f(unsigned h) { return __uint_as_float(h << 16); }
__device__ __forceinline__ unsigned pk2(float lo, float hi) { f32x2_t v = {lo, hi}; bf16x2_t b = __builtin_convertvector(v, bf16x2_t); return __builtin_bit_cast(unsigned, b); }
__device__ __forceinline__ float wave_sum(float v) {
#pragma unroll
    for (int o = 1; o < 64; o <<= 1) v += __shfl_xor(v, o);
    return v;
}
__device__ __forceinline__ float quad_sum(float v) { v += __shfl_xor(v, 16); v += __shfl_xor(v, 32); return v; }
__device__ __forceinline__ float quad_max(float v) { v = fmaxf(v, __shfl_xor(v, 16)); v = fmaxf(v, __shfl_xor(v, 32)); return v; }
__device__ __forceinline__ float silu_f(float v) { return v * __builtin_amdgcn_rcpf(1.0f + __expf(-v)); }
__device__ __forceinline__ float sigmoid_f(float v) { return __builtin_amdgcn_rcpf(1.0f + __expf(-v)); }
__device__ __forceinline__ float logsig_f(float f) { return fminf(f, 0.f) - log1pf(expf(-fabsf(f))); }
__device__ __forceinline__ f32x4 mfma16(bf16x8 a, bf16x8 b, f32x4 c) { return __builtin_amdgcn_mfma_f32_16x16x32_bf16(a, b, c, 0, 0, 0); }
__device__ __forceinline__ bf16x8 mk8(unsigned a, unsigned b, unsigned c, unsigned d) { u32x4 v = {a, b, c, d}; return __builtin_bit_cast(bf16x8, v); }

struct EpiProj {
    static constexpr bool PERM = true, AFTER_DRAIN = false;
    bf16_t* O; float* gates; const float* b_gates;
    __device__ __forceinline__ void operator()(const f32x4 (&acc)[2][2][4][2], const pg8::Unit& u, int wr, int wc, int fr, int fq) const {
        const int row0 = u.pm * 256 + wr * 64 + fr; const int col0 = u.pn * 256 + wc * 32 + 8 * fq;
        if (u.pn != 11)
#pragma unroll
        for (int ai = 0; ai < 2; ++ai)
#pragma unroll
            for (int m = 0; m < 4; ++m) { bf16_t* rowp = O + (size_t)(row0 + ai * 128 + m * 16) * NPROJ + col0;
#pragma unroll
                for (int bj = 0; bj < 2; ++bj) { const f32x4 v0 = acc[ai][bj][m][0], v1 = acc[ai][bj][m][1];
                    u32x4 w; w.x = pk2(v0[0], v0[1]); w.y = pk2(v0[2], v0[3]); w.z = pk2(v1[0], v1[1]); w.w = pk2(v1[2], v1[3]);
                    *(u32x4*)(rowp + bj * 128) = w; } }
        if (u.pn == 11 && wc == 0 && fq < 2) {
            const f32x4 b0 = *(const f32x4*)(b_gates + 8 * fq), b1 = *(const f32x4*)(b_gates + 8 * fq + 4);
#pragma unroll
            for (int ai = 0; ai < 2; ++ai)
#pragma unroll
                for (int m = 0; m < 4; ++m) { float* gp = gates + (size_t)(row0 + ai * 128 + m * 16) * 16 + 8 * fq;
                    *(f32x4*)gp = acc[ai][0][m][0] + b0; *(f32x4*)(gp + 4) = acc[ai][0][m][1] + b1; }
        }
    }
};
struct EpiResid {
    static constexpr bool PERM = false, AFTER_DRAIN = false;
    const float* base; float* out; const float* gate;
    const float* rowss;
    __device__ __forceinline__ void operator()(const f32x4 (&acc)[2][2][4][2], const pg8::Unit& u, int wr, int wc, int fr, int fq) const {
        const int col0 = u.pn * 256 + wc * 32 + 4 * fq; const int b = u.pm >> 5;
        float rs[2][4];
#pragma unroll
        for (int ai = 0; ai < 2; ++ai)
#pragma unroll
            for (int m = 0; m < 4; ++m) rs[ai][m] = rowss ? rsqrtf(rowss[u.pm * 256 + ai * 128 + wr * 64 + m * 16 + fr] * (1.0f / 512.0f) + EPS) : 1.0f;
#pragma unroll
        for (int bj = 0; bj < 2; ++bj)
#pragma unroll
            for (int n = 0; n < 2; ++n) { const f32x4 g = *(const f32x4*)(gate + b * NMOD + col0 + bj * 128 + n * 16);
#pragma unroll
                for (int ai = 0; ai < 2; ++ai)
#pragma unroll
                    for (int m = 0; m < 4; ++m) { const size_t off = (size_t)(u.pm * 256 + ai * 128 + wr * 64 + m * 16 + fr) * D + col0 + bj * 128 + n * 16;
                        const f32x4 bs = *(const f32x4*)(base + off); *(f32x4*)(out + off) = bs + (g * rs[ai][m]) * acc[ai][bj][m][n]; } }
    }
};
struct EpiResidNorm {
    static constexpr bool PERM = false, AFTER_DRAIN = true;
    const float* base; float* out; const float* gate; const float* rowss;
    float* SS; unsigned* CNT; const float* gcol; const float* mod_scale; const float* mod_shift; bf16_t* XN;
    const bf16_t* base_bf; bf16_t* x1_bf;
    __device__ __forceinline__ void fused(f32x4 (&acc)[2][2][4][2], const pg8::Unit& u, int wr, int wc, int fr, int fq, PG8_LAS unsigned char* lds, int wid, int lane) const {
        const int col0 = u.pn * 256 + wc * 32 + 4 * fq; const int b = u.pm >> 5; const int rowb = u.pm * 256 + wr * 64 + fr;
        f32x4 gq[2][2];
#pragma unroll
        for (int bj = 0; bj < 2; ++bj)
#pragma unroll
            for (int n = 0; n < 2; ++n) gq[bj][n] = *(const f32x4*)(gate + b * NMOD + col0 + bj * 128 + n * 16);
#pragma unroll
        for (int ai = 0; ai < 2; ++ai)
#pragma unroll
            for (int mp = 0; mp < 2; ++mp) {
                f32x4 bs[2][2][2]; float rsv[2];
#pragma unroll
                for (int mi = 0; mi < 2; ++mi) { const int row = rowb + ai * 128 + (mp * 2 + mi) * 16; rsv[mi] = rowss ? rowss[row] : 0.f;
#pragma unroll
                    for (int bj = 0; bj < 2; ++bj)
#pragma unroll
                        for (int n = 0; n < 2; ++n) { const unsigned off = (unsigned)(row * D + col0 + bj * 128 + n * 16);
                            if (base_bf) { const u32x2 q = *(const u32x2*)(base_bf + off); bs[mi][bj][n] = (f32x4){bf2f(q.x & 0xffffu), bf2f(q.x >> 16), bf2f(q.y & 0xffffu), bf2f(q.y >> 16)}; }
                            else bs[mi][bj][n] = *(const f32x4*)(base + off); } }
#pragma unroll
                for (int mi = 0; mi < 2; ++mi) { const int m = mp * 2 + mi; const int row = rowb + ai * 128 + m * 16;
                    const float rs1 = rowss ? rsqrtf(rsv[mi] * (1.0f / 512.0f) + EPS) : 1.0f; float ssp = 0.f;
#pragma unroll
                    for (int bj = 0; bj < 2; ++bj)
#pragma unroll
                        for (int n = 0; n < 2; ++n) { const f32x4 v = bs[mi][bj][n] + (gq[bj][n] * rs1) * acc[ai][bj][m][n]; acc[ai][bj][m][n] = v;
                            ssp += (v[0] * v[0] + v[1] * v[1]) + (v[2] * v[2] + v[3] * v[3]);
                            asm volatile("" : "+v"(acc[ai][bj][m][n])); }
                    const float sq = quad_sum(ssp); if (fq == 0) __hip_atomic_fetch_add(SS + row, sq, __ATOMIC_RELAXED, __HIP_MEMORY_SCOPE_AGENT); }
                asm volatile("" ::: "memory"); }
        asm volatile("s_waitcnt vmcnt(0)" ::: "memory");
        __syncthreads();
        if (threadIdx.x == 0) { unsigned* cp = CNT + u.pm * 16;
            __builtin_amdgcn_fence(__ATOMIC_RELEASE, "agent");
            __hip_atomic_fetch_add(cp, 1u, __ATOMIC_RELAXED, __HIP_MEMORY_SCOPE_AGENT);
            unsigned spins = 0;
            while (__hip_atomic_load(cp, __ATOMIC_RELAXED, __HIP_MEMORY_SCOPE_AGENT) < 4u && ++spins < (1u << 22)) __builtin_amdgcn_s_sleep(1);
            __builtin_amdgcn_fence(__ATOMIC_ACQUIRE, "agent"); }
        __syncthreads();
        int rowc = rowb; asm volatile("" : "+v"(rowc));
        float rstd[2][4];
#pragma unroll
        for (int ai = 0; ai < 2; ++ai)
#pragma unroll
            for (int m = 0; m < 4; ++m) rstd[ai][m] = rsqrtf(__hip_atomic_load(SS + rowc + ai * 128 + m * 16, __ATOMIC_RELAXED, __HIP_MEMORY_SCOPE_AGENT) * (1.0f / D) + EPS);
#pragma unroll
        for (int bj = 0; bj < 2; ++bj)
#pragma unroll
            for (int n = 0; n < 2; ++n) { const int col = col0 + bj * 128 + n * 16; f32x4 gc = *(const f32x4*)(gcol + col); f32x4 sh = {0.f, 0.f, 0.f, 0.f};
                if (XN) { gc = gc * (1.0f + *(const f32x4*)(mod_scale + b * NMOD + col)); sh = *(const f32x4*)(mod_shift + b * NMOD + col); }
#pragma unroll
                for (int ai = 0; ai < 2; ++ai)
#pragma unroll
                    for (int m = 0; m < 4; ++m) { const unsigned off = (unsigned)((rowc + ai * 128 + m * 16) * D + col); const f32x4 v = acc[ai][bj][m][n] * rstd[ai][m] * gc + sh;
                        if (XN) { { const f32x4 a = acc[ai][bj][m][n]; u32x2 q; q.x = pk2(a[0], a[1]); q.y = pk2(a[2], a[3]); *(u32x2*)(x1_bf + off) = q; } u32x2 w; w.x = pk2(v[0], v[1]); w.y = pk2(v[2], v[3]); *(u32x2*)(XN + off) = w; } else *(f32x4*)(out + off) = v; } }
    }
};
struct EpiSwiglu {
    static constexpr bool PERM = true, AFTER_DRAIN = false;
    bf16_t* O;
    __device__ __forceinline__ void operator()(const f32x4 (&acc)[2][2][4][2], const pg8::Unit& u, int wr, int wc, int fr, int fq) const {
        const int row0 = u.pm * 256 + wr * 64 + fr; const int col0 = u.pn * 128 + wc * 32 + 8 * fq;
#pragma unroll
        for (int ai = 0; ai < 2; ++ai)
#pragma unroll
            for (int m = 0; m < 4; ++m) { float r[8];
#pragma unroll
                for (int n = 0; n < 2; ++n)
#pragma unroll
                    for (int e = 0; e < 4; ++e) { const float g = acc[ai][0][m][n][e], up = acc[ai][1][m][n][e]; r[n * 4 + e] = silu_f(g) * up; }
                u32x4 w; w.x = pk2(r[0], r[1]); w.y = pk2(r[2], r[3]); w.z = pk2(r[4], r[5]); w.w = pk2(r[6], r[7]);
                *(u32x4*)(O + (size_t)(row0 + ai * 128 + m * 16) * DFF + col0) = w; }
    }
};

__device__ __forceinline__ void transpose_item(const float* W, int K, int N, bf16_t* WT, int drow0, int k0, int n0, LAS float* scr, int lane) {
    const int kr = lane >> 3, nq = (lane & 7) * 4; f32x4 v[8];
#pragma unroll
    for (int i = 0; i < 8; ++i) { const f32x4 z = {0.f, 0.f, 0.f, 0.f}; v[i] = (n0 + nq < N) ? *(const f32x4*)(W + (size_t)(k0 + kr + 8 * i) * N + n0 + nq) : z; }
#pragma unroll
    for (int i = 0; i < 8; ++i) { LAS float* d = scr + (kr + 8 * i) * 33 + nq; d[0] = v[i][0]; d[1] = v[i][1]; d[2] = v[i][2]; d[3] = v[i][3]; }
    const int c = lane & 7;
#pragma unroll
    for (int j = 0; j < 4; ++j) { const int n = (lane >> 3) + 8 * j; const LAS float* s = scr + (8 * c) * 33 + n;
        u32x4 o; o.x = pk2(s[0 * 33], s[1 * 33]); o.y = pk2(s[2 * 33], s[3 * 33]); o.z = pk2(s[4 * 33], s[5 * 33]); o.w = pk2(s[6 * 33], s[7 * 33]);
        *(u32x4*)(WT + (size_t)(drow0 + n) * K + k0 + 8 * c) = o; }
}

__device__ __forceinline__ void phase0(const Params& P, LAS unsigned char* lds, int tid, int wave, int lane) {
    unsigned char* ws = P.ws;
    float* MOD = (float*)(ws + WS_MOD);
    LAS float* red = (LAS float*)(lds + 81920);
    for (int item = blockIdx.x; item < NMOD / 32; item += gridDim.x) {
        const int col0 = item * 32 + (lane & 7) * 4; const int r = lane >> 3;
        f32x4 a0 = {0.f, 0.f, 0.f, 0.f}, a1 = {0.f, 0.f, 0.f, 0.f};
#pragma unroll 4
        for (int i = 0; i < 16; ++i) { const int k = wave * 128 + r + 8 * i; const f32x4 w = *(const f32x4*)(P.w_mod + (size_t)k * NMOD + col0);
            const float s0 = silu_f(P.c[k]), s1 = silu_f(P.c[D + k]); a0 += s0 * w; a1 += s1 * w; }
#pragma unroll
        for (int e = 0; e < 4; ++e) {
#pragma unroll
            for (int o = 8; o < 64; o <<= 1) { a0[e] += __shfl_xor(a0[e], o); a1[e] += __shfl_xor(a1[e], o); } }
        if (lane < 8) {
#pragma unroll
            for (int e = 0; e < 4; ++e) { red[(wave * 8 + lane) * 8 + e] = a0[e]; red[(wave * 8 + lane) * 8 + 4 + e] = a1[e]; } }
        __syncthreads();
        if (tid < 64) { const int q = tid >> 3, e = tid & 7; float s = 0.f;
#pragma unroll
            for (int w = 0; w < 8; ++w) s += red[(w * 8 + q) * 8 + e];
            const int b = e >> 2, col = item * 32 + q * 4 + (e & 3); MOD[b * NMOD + col] = s + P.b_mod[col]; }
        __syncthreads();
    }
    LAS float* scr = (LAS float*)(lds + wave * 8704);
    const int gw = blockIdx.x * NWAVES + wave, NGW = gridDim.x * NWAVES;
    bf16_t* WIN = (bf16_t*)(ws + WS_WIN); bf16_t* WOUT = (bf16_t*)(ws + WS_WOUT); bf16_t* WFI = (bf16_t*)(ws + WS_WFI); bf16_t* WFO = (bf16_t*)(ws + WS_WFO);
    constexpr int NB_IN = 88, I_IN = 16 * NB_IN, I_OUT = 16 * 32, I_FI = 16 * 176, I_FO = 44 * 32;
    if ((int)gridDim.x > NMOD / 32) { const int xw = ((int)blockIdx.x - NMOD / 32) * NWAVES + wave; if (xw >= 0 && xw < 16) transpose_item(P.w_in, D, NIN, WIN, 88 * 32, xw * 64, 88 * 32, scr, lane); }
    else if (gw < 16) transpose_item(P.w_in, D, NIN, WIN, 88 * 32, gw * 64, 88 * 32, scr, lane);
    for (int it = gw; it < I_IN + I_OUT + I_FI + I_FO; it += NGW) {
        int r = it;
        if (r < I_IN) { const int kb = r / NB_IN, nb = r % NB_IN; transpose_item(P.w_in, D, NIN, WIN, nb * 32, kb * 64, nb * 32, scr, lane); continue; } r -= I_IN;
        if (r < I_OUT) { const int kb = r / 32, nb = r % 32; transpose_item(P.w_out, D, D, WOUT, nb * 32, kb * 64, nb * 32, scr, lane); continue; } r -= I_OUT;
        if (r < I_FI) { const int kb = r / 176, nb = r % 176; const int n0 = nb * 32; const int np = n0 < DFF ? n0 : n0 - DFF;
            const int drow0 = (np / 128) * 256 + (n0 < DFF ? 0 : 128) + (np % 128);
            transpose_item(P.w_ffn_in, D, 2 * DFF, WFI, drow0, kb * 64, n0, scr, lane); continue; } r -= I_FI;
        { const int kb = r / 32, nb = r % 32; transpose_item(P.w_ffn_out, DFF, D, WFO, nb * 32, kb * 64, nb * 32, scr, lane); }
    }
}

__device__ __forceinline__ void norm_mod_phase(const float* X, const float* g, const float* MOD, int shift_off, int scale_off, bf16_t* XN, int wave, int lane) {
    const int gw = blockIdx.x * NWAVES + wave, NGW = gridDim.x * NWAVES;
    int curb = -1; f32x4 A[4], B[4];
    for (int m = gw; m < M; m += 2 * NGW) {
        const int b = m >> 13; const int m2 = m + NGW;
        if (b != curb) { curb = b;
#pragma unroll
            for (int j = 0; j < 4; ++j) { const int col = 4 * lane + 256 * j; const f32x4 gv = *(const f32x4*)(g + col), sc = *(const f32x4*)(MOD + b * NMOD + scale_off + col);
                A[j] = gv * (1.0f + sc); B[j] = *(const f32x4*)(MOD + b * NMOD + shift_off + col); } }
        f32x4 v[4], w[4]; float ss = 0.f, ss2 = 0.f;
#pragma unroll
        for (int j = 0; j < 4; ++j) { v[j] = *(const f32x4*)(X + (size_t)m * D + 4 * lane + 256 * j); w[j] = *(const f32x4*)(X + (size_t)m2 * D + 4 * lane + 256 * j); }
#pragma unroll
        for (int j = 0; j < 4; ++j) { ss += (v[j][0] * v[j][0] + v[j][1] * v[j][1]) + (v[j][2] * v[j][2] + v[j][3] * v[j][3]); ss2 += (w[j][0] * w[j][0] + w[j][1] * w[j][1]) + (w[j][2] * w[j][2] + w[j][3] * w[j][3]); }
        const float rstd = rsqrtf(wave_sum(ss) * (1.0f / D) + EPS), rstd2 = rsqrtf(wave_sum(ss2) * (1.0f / D) + EPS);
#pragma unroll
        for (int j = 0; j < 4; ++j) { const f32x4 o = v[j] * rstd * A[j] + B[j]; u32x2 p; p.x = pk2(o[0], o[1]); p.y = pk2(o[2], o[3]);
            *(u32x2*)(XN + (size_t)m * D + 4 * lane + 256 * j) = p;
            const f32x4 o2 = w[j] * rstd2 * A[j] + B[j]; u32x2 p2; p2.x = pk2(o2[0], o2[1]); p2.y = pk2(o2[2], o2[3]);
            *(u32x2*)(XN + (size_t)m2 * D + 4 * lane + 256 * j) = p2; }
    }
}
__device__ __forceinline__ void final_norm_phase(float* X, const float* g, int wave, int lane) {
    const int gw = blockIdx.x * NWAVES + wave, NGW = gridDim.x * NWAVES;
    f32x4 A[4];
#pragma unroll
    for (int j = 0; j < 4; ++j) A[j] = *(const f32x4*)(g + 4 * lane + 256 * j);
    for (int m = gw; m < M; m += NGW) {
        f32x4 v[4]; float ss = 0.f;
#pragma unroll
        for (int j = 0; j < 4; ++j) { v[j] = *(const f32x4*)(X + (size_t)m * D + 4 * lane + 256 * j); ss += (v[j][0] * v[j][0] + v[j][1] * v[j][1]) + (v[j][2] * v[j][2] + v[j][3] * v[j][3]); }
        const float rstd = rsqrtf(wave_sum(ss) * (1.0f / D) + EPS);
#pragma unroll
        for (int j = 0; j < 4; ++j) *(f32x4*)(X + (size_t)m * D + 4 * lane + 256 * j) = v[j] * rstd * A[j];
    }
}

typedef short v4i16_t __attribute__((ext_vector_type(4)));
__device__ __forceinline__ u32x2 tr_read(const LAS bf16_t* p) { return __builtin_bit_cast(u32x2, __builtin_amdgcn_ds_read_tr16_b64_v4i16((LAS v4i16_t*)p)); }

constexpr float ATT_C1 = 0.125f * 1.4426950408889634f;
template <bool MASK, int KT_LO, int KT_HI>
__device__ __forceinline__ void attn_chunk(const int kc, const LAS bf16_t* Ks, const LAS bf16_t* Vs, bf16x8 (&qf)[2][2], f32x4 (&o)[4][2], float (&m_run)[2], float (&l_run)[2],
                                           const float fbase, const float sl8, const int fr, const int fq, const int troff, const bool q_reload, const bf16_t* qnext) {
    f32x4 s[4][2];
    float fb = fbase; asm volatile("" : "+v"(fb));
#pragma unroll
    for (int kt = KT_LO; kt < KT_HI; ++kt) { const LAS bf16_t* kp = Ks + (kc * 64 + kt * 16 + fr) * 72 + fq * 8;
        const bf16x8 a0 = *(const LAS bf16x8*)kp, a1 = *(const LAS bf16x8*)(kp + 32);
#pragma unroll
        for (int qt = 0; qt < 2; ++qt) { const f32x4 z = {0.f, 0.f, 0.f, 0.f}; s[kt][qt] = mfma16(a1, qf[qt][1], mfma16(a0, qf[qt][0], z)); } }
    if (q_reload) {
#pragma unroll
        for (int qt = 0; qt < 2; ++qt)
#pragma unroll
            for (int kk = 0; kk < 2; ++kk) qf[qt][kk] = *(const bf16x8*)(qnext + (size_t)qt * 16 * NPROJ + kk * 32); }
    unsigned pb[2][4][2];
#pragma unroll
    for (int qt = 0; qt < 2; ++qt) {
        float cmax = -1e30f;
#pragma unroll
        for (int kt = KT_LO; kt < KT_HI; ++kt)
#pragma unroll
            for (int i = 0; i < 4; ++i) { const float rel = fb + (float)(kc * 64 + kt * 16 + i - qt * 16); const float ar = fabsf(rel);
                float lg = fmaf(-sl8, ar, s[kt][qt][i]); if (MASK) lg = (ar <= 128.0f) ? lg : -1e30f; s[kt][qt][i] = lg; cmax = fmaxf(cmax, lg); }
        cmax = quad_max(cmax);
        const float m_new = fmaxf(m_run[qt], cmax), alpha = __builtin_amdgcn_exp2f((m_run[qt] - m_new) * ATT_C1), mc = m_new * ATT_C1; m_run[qt] = m_new;
        float psum = 0.f;
#pragma unroll
        for (int kt = KT_LO; kt < KT_HI; ++kt) { float p[4];
#pragma unroll
            for (int i = 0; i < 4; ++i) { p[i] = __builtin_amdgcn_exp2f(fmaf(s[kt][qt][i], ATT_C1, -mc)); psum += p[i]; }
            pb[qt][kt][0] = pk2(p[0], p[1]); pb[qt][kt][1] = pk2(p[2], p[3]); }
        l_run[qt] = l_run[qt] * alpha + psum;
#pragma unroll
        for (int dt = 0; dt < 4; ++dt) o[dt][qt] *= alpha;
    }
#pragma unroll
    for (int ks = KT_LO / 2; ks < KT_HI / 2; ++ks)
#pragma unroll
        for (int dt = 0; dt < 4; ++dt) { const LAS bf16_t* vp = Vs + (kc * 64 + ks * 32) * 80 + troff + dt * 16;
            const u32x2 lo = tr_read(vp), hi = tr_read(vp + 16 * 80); const bf16x8 a = mk8(lo.x, lo.y, hi.x, hi.y);
#pragma unroll
            for (int qt = 0; qt < 2; ++qt) o[dt][qt] = mfma16(a, mk8(pb[qt][2 * ks][0], pb[qt][2 * ks][1], pb[qt][2 * ks + 1][0], pb[qt][2 * ks + 1][1]), o[dt][qt]); }
}

__device__ __forceinline__ void attn_phase(const Params& P, LAS unsigned char* lds, int tid, int wave, int lane, const bool do_atomic) {
    LAS bf16_t* Ks = (LAS bf16_t*)lds;
    LAS bf16_t* Vs = (LAS bf16_t*)(lds + 46080);
    const bf16_t* PROJ = (const bf16_t*)(P.ws + WS_PROJ);
    bf16_t* A2 = (bf16_t*)(P.ws + WS_A2); float* ATTSS = (float*)(P.ws + WS_ATTSS);
    const int fr = lane & 15, fq = lane >> 4, g = wave >> 1, r = wave & 1;
    const int troff = (fq * 4 + ((lane >> 2) & 3)) * 80 + (lane & 3) * 4;
    const float fbase = (float)(fq * 4 - 128 - r * 32 - fr);
    const int G = gridDim.x;
    int u = (G % 8 == 0) ? ((int)blockIdx.x % 8) * (G / 8) + (int)blockIdx.x / 8 : (int)blockIdx.x; if (u >= NB * (SEQ / 64)) return;
    u32x4 rk[5], rv[5];
#define AT_LOADS(uu, kvh_) do { const int b_ = (uu) >> 7, t0_ = ((uu) & 127) * 64, kb_ = t0_ - 128; \
        _Pragma("unroll") for (int i = 0; i < 5; ++i) { const int cidx = tid + 512 * i, key = cidx >> 3, part = cidx & 7, tok = kb_ + key; const u32x4 z = {0u, 0u, 0u, 0u}; rk[i] = z; rv[i] = z; \
            if (tok >= 0 && tok < SEQ) { const bf16_t* rowp = PROJ + (size_t)(b_ * SEQ + tok) * NPROJ; rk[i] = *(const u32x4*)(rowp + 512 + (kvh_) * 64 + part * 8); rv[i] = *(const u32x4*)(rowp + 640 + (kvh_) * 64 + part * 8); } } \
        } while (0)
    AT_LOADS(u, 0);
    bf16x8 qf[2][2];
    { const int b0 = u >> 7, t00 = (u & 127) * 64;
#pragma unroll
      for (int qt = 0; qt < 2; ++qt)
#pragma unroll
          for (int kk = 0; kk < 2; ++kk) qf[qt][kk] = *(const bf16x8*)(PROJ + (size_t)(b0 * SEQ + t00 + r * 32 + qt * 16 + fr) * NPROJ + g * 64 + kk * 32 + fq * 8); }
    for (;;) {
        const int b = u >> 7, qb = u & 127, t0 = qb * 64;
        const int kc_lo = qb == 0 ? 2 : (qb == 1 ? 1 : 0), kc_hi = qb == 127 ? 3 : (qb == 126 ? 4 : 5);
        const int un = u + G; const bool more = un < NB * (SEQ / 64);
#pragma unroll 1
        for (int kvh = 0; kvh < 2; ++kvh) {
            __syncthreads();
#pragma unroll
            for (int i = 0; i < 5; ++i) { const int cidx = tid + 512 * i, key = cidx >> 3, part = cidx & 7; *(LAS u32x4*)(Ks + key * 72 + part * 8) = rk[i]; *(LAS u32x4*)(Vs + key * 80 + part * 8) = rv[i]; }
            __syncthreads();
            const bool qnx = (kvh == 0) || more; const int un_b = un >> 7, un_t0 = (un & 127) * 64;
            const bf16_t* qnext = (kvh == 0) ? PROJ + (size_t)(b * SEQ + t0 + r * 32 + fr) * NPROJ + (4 + g) * 64 + fq * 8
                                             : PROJ + (size_t)(un_b * SEQ + un_t0 + r * 32 + fr) * NPROJ + g * 64 + fq * 8;
            if (!qnx) qnext = PROJ;
            if (kvh == 0) { AT_LOADS(u, 1); } else if (more) { AT_LOADS(un, 0); }
            const int h = kvh * 4 + g;
            const float sl8 = 8.0f * exp2f(-(float)(h + 1));
            float m_run[2], l_run[2]; f32x4 o[4][2];
#pragma unroll
            for (int qt = 0; qt < 2; ++qt) { m_run[qt] = 8.0f * P.sink[h]; l_run[qt] = (fq == 0) ? 1.0f : 0.0f;
#pragma unroll
                for (int dt = 0; dt < 4; ++dt) o[dt][qt] = (f32x4){0.f, 0.f, 0.f, 0.f}; }
            if (r == 0) {
                if (kc_lo <= 0) attn_chunk<true, 0, 4>(0, Ks, Vs, qf, o, m_run, l_run, fbase, sl8, fr, fq, troff, qnx && (kc_hi == 1), qnext);
                if (kc_lo <= 1) attn_chunk<false, 0, 4>(1, Ks, Vs, qf, o, m_run, l_run, fbase, sl8, fr, fq, troff, qnx && (kc_hi == 2), qnext);
                attn_chunk<false, 0, 4>(2, Ks, Vs, qf, o, m_run, l_run, fbase, sl8, fr, fq, troff, qnx && (kc_hi == 3), qnext);
                if (kc_hi > 3) attn_chunk<false, 0, 4>(3, Ks, Vs, qf, o, m_run, l_run, fbase, sl8, fr, fq, troff, qnx && (kc_hi == 4), qnext);
                if (kc_hi > 4) attn_chunk<true, 0, 2>(4, Ks, Vs, qf, o, m_run, l_run, fbase, sl8, fr, fq, troff, qnx && (kc_hi == 5), qnext);
            } else {
                if (kc_lo <= 0) attn_chunk<true, 2, 4>(0, Ks, Vs, qf, o, m_run, l_run, fbase, sl8, fr, fq, troff, qnx && (kc_hi == 1), qnext);
                if (kc_lo <= 1) attn_chunk<false, 0, 4>(1, Ks, Vs, qf, o, m_run, l_run, fbase, sl8, fr, fq, troff, qnx && (kc_hi == 2), qnext);
                attn_chunk<false, 0, 4>(2, Ks, Vs, qf, o, m_run, l_run, fbase, sl8, fr, fq, troff, qnx && (kc_hi == 3), qnext);
                if (kc_hi > 3) attn_chunk<false, 0, 4>(3, Ks, Vs, qf, o, m_run, l_run, fbase, sl8, fr, fq, troff, qnx && (kc_hi == 4), qnext);
                if (kc_hi > 4) attn_chunk<true, 0, 4>(4, Ks, Vs, qf, o, m_run, l_run, fbase, sl8, fr, fq, troff, qnx && (kc_hi == 5), qnext);
            }
#pragma unroll
            for (int qt = 0; qt < 2; ++qt) { const float inv = 1.0f / quad_sum(l_run[qt]); float ss = 0.f;
                const int rr = r * 32 + qt * 16 + fr; const size_t mrow = (size_t)(b * SEQ + t0 + rr);
                bf16_t* orow = A2 + mrow * D;
#pragma unroll
                for (int dt = 0; dt < 4; ++dt) { const f32x4 v = o[dt][qt] * inv; ss += (v[0] * v[0] + v[1] * v[1]) + (v[2] * v[2] + v[3] * v[3]);
                    const int col = h * 64 + dt * 16 + fq * 4; const f32x4 gv = *(const f32x4*)(P.g_attn_out + col); const f32x4 w4 = v * gv;
                    u32x2 w; w.x = pk2(w4[0], w4[1]); w.y = pk2(w4[2], w4[3]); *(u32x2*)(orow + col) = w; }
                ss = quad_sum(ss);
                if (fq == 0 && do_atomic) __hip_atomic_fetch_add(ATTSS + mrow, ss, __ATOMIC_RELAXED, __HIP_MEMORY_SCOPE_AGENT); }
        }
        if (!more) break;
        u = un;
    }
#undef AT_LOADS
}

__device__ __forceinline__ float scan_up_add(float v, int lane) {
#pragma unroll
    for (int o = 1; o < 64; o <<= 1) { const float t = __shfl_up(v, o); v += (lane >= o) ? t : 0.f; }
    return v;
}
__device__ __forceinline__ float scan_down_add(float v, int lane) {
#pragma unroll
    for (int o = 1; o < 64; o <<= 1) { const float t = __shfl_down(v, o); v += (lane + o < 64) ? t : 0.f; }
    return v;
}
__device__ __forceinline__ float scan_up_max(float v, int lane) {
#pragma unroll
    for (int o = 1; o < 64; o <<= 1) { const float t = __shfl_up(v, o); v = (lane >= o) ? fmaxf(v, t) : v; }
    return v;
}
__device__ __forceinline__ float scan_down_max(float v, int lane) {
#pragma unroll
    for (int o = 1; o < 64; o <<= 1) { const float t = __shfl_down(v, o); v = (lane + o < 64) ? fmaxf(v, t) : v; }
    return v;
}
__device__ __forceinline__ float wave_max(float v) {
#pragma unroll
    for (int o = 1; o < 64; o <<= 1) v = fmaxf(v, __shfl_xor(v, o));
    return v;
}
__device__ __forceinline__ void conv8(const u32x4& x0, const u32x4& x1, const u32x4& x2, const float* cw, const float* cb, int ch0, float (&r8)[8]) {
#pragma unroll
    for (int e2 = 0; e2 < 2; ++e2) { const f32x4 w0 = *(const f32x4*)(cw + ch0 + 4 * e2), w1 = *(const f32x4*)(cw + 1024 + ch0 + 4 * e2), w2 = *(const f32x4*)(cw + 2048 + ch0 + 4 * e2), bb = *(const f32x4*)(cb + ch0 + 4 * e2);
#pragma unroll
        for (int e = 0; e < 4; ++e) { const int ee = e2 * 4 + e; const unsigned sh = 16 * (ee & 1);
            const float a0 = bf2f((x0[ee >> 1] >> sh) & 0xffffu), a1 = bf2f((x1[ee >> 1] >> sh) & 0xffffu), a2 = bf2f((x2[ee >> 1] >> sh) & 0xffffu);
            float v = a0 * w0[e]; v += a1 * w1[e]; v += a2 * w2[e]; v += bb[e]; r8[ee] = silu_f(v); } }
}
__device__ __forceinline__ void mstate_unit(const Params& P, LAS unsigned char* lds, int unit, int tid, int wave, int lane) {
    const int b = unit >> 8, c = (unit >> 2) & 63, h = unit & 3;
    LAS bf16_t* Kwf = (LAS bf16_t*)lds; LAS bf16_t* Kwb = (LAS bf16_t*)(lds + 36864); LAS bf16_t* Vs = (LAS bf16_t*)(lds + 73728);
    LAS float* wf = (LAS float*)(lds + 110592); LAS float* wb = wf + 128;
    unsigned char* ws = P.ws;
    const bf16_t* PROJ = (const bf16_t*)(ws + WS_PROJ); const float* GATES = (const float*)(ws + WS_GATES);
    float* GV = (float*)(ws + WS_GV); float* SC = (float*)(ws + WS_SC); float* NC = (float*)(ws + WS_NC); bf16_t* KVC = (bf16_t*)P.out;
    bf16_t* QM = (bf16_t*)(ws + WS_QM); bf16_t* KM = (bf16_t*)(ws + WS_KM);
    const size_t m0 = (size_t)b * SEQ + (size_t)c * 128;
    const int fr = lane & 15, fq = lane >> 4;
    __syncthreads();
    float gi0 = 0.f, gf0 = 0.f, gi1 = 0.f, gf1 = 0.f;
    if (wave < 2) { const float* gp = GATES + (m0 + lane) * 16 + wave * 8 + h; gi0 = gp[0]; gf0 = gp[4]; gi1 = gp[64 * 16]; gf1 = gp[64 * 16 + 4]; }
    u32x4 xk[3][3], xv[3];
#define MS_LOAD(it, j) do { const int idx = tid + 512 * (it), s = idx >> 4, part = idx & 15; const int t = c * 128 + s; const bf16_t* rowm = PROJ + (m0 + s) * NPROJ; \
        const int pk = 1280 + h * 128 + part * 8; const u32x4 z = {0u, 0u, 0u, 0u}; \
        xk[j][1] = *(const u32x4*)(rowm + pk); xv[j] = *(const u32x4*)(rowm + 1792 + h * 128 + part * 8); \
        xk[j][0] = z; xk[j][2] = z; \
        if (t > 0) { xk[j][0] = *(const u32x4*)(rowm - NPROJ + pk); } \
        if (t < SEQ - 1) { xk[j][2] = *(const u32x4*)(rowm + NPROJ + pk); } } while (0)
    MS_LOAD(0, 0); MS_LOAD(1, 1);
    if (wave < 2) {
        const float l0 = logsig_f(gf0), l1 = logsig_f(gf1); float p0, p1, tot;
        if (wave == 0) { p0 = scan_up_add(l0, lane); const float t0 = __shfl(p0, 63); p1 = scan_up_add(l1, lane) + t0; tot = __shfl(p1, 63); }
        else { p1 = scan_down_add(l1, lane); const float t1 = __shfl(p1, 0); p0 = scan_down_add(l0, lane) + t1; tot = __shfl(p0, 0); }
        const float u0 = gi0 - p0, u1 = gi1 - p1; const float umax = wave_max(fmaxf(u0, u1));
        LAS float* wv = wave ? wb : wf; wv[lane] = __expf(u0 - umax); wv[64 + lane] = __expf(u1 - umax);
        float* gv = GV + (size_t)unit * 512 + wave * 128; gv[lane] = u0; gv[64 + lane] = u1; gv[256 + lane] = p0; gv[256 + 64 + lane] = p1;
        if (lane == 0) { float* sc = SC + unit * 4 + wave * 2; sc[0] = tot; sc[1] = tot + umax; }
    }
    __syncthreads();
#define MS_COMPUTE(it, j) do { const int idx = tid + 512 * (it), s = idx >> 4, part = idx & 15; const float wfs = wf[s], wbs = wb[s]; float r8[8]; \
        conv8(xk[j][0], xk[j][1], xk[j][2], P.conv_w, P.conv_b, 512 + h * 128 + part * 8, r8); \
        { u32x4 w; w.x = pk2(r8[0], r8[1]); w.y = pk2(r8[2], r8[3]); w.z = pk2(r8[4], r8[5]); w.w = pk2(r8[6], r8[7]); *(u32x4*)(KM + (m0 + s) * 512 + h * 128 + part * 8) = w; \
          u32x4 a; a.x = pk2(r8[0] * wfs, r8[1] * wfs); a.y = pk2(r8[2] * wfs, r8[3] * wfs); a.z = pk2(r8[4] * wfs, r8[5] * wfs); a.w = pk2(r8[6] * wfs, r8[7] * wfs); *(LAS u32x4*)(Kwf + s * 144 + part * 8) = a; \
          u32x4 bq; bq.x = pk2(r8[0] * wbs, r8[1] * wbs); bq.y = pk2(r8[2] * wbs, r8[3] * wbs); bq.z = pk2(r8[4] * wbs, r8[5] * wbs); bq.w = pk2(r8[6] * wbs, r8[7] * wbs); *(LAS u32x4*)(Kwb + s * 144 + part * 8) = bq; } \
        *(LAS u32x4*)(Vs + s * 144 + part * 8) = xv[j]; } while (0)
    MS_LOAD(2, 2); MS_COMPUTE(0, 0);
    MS_LOAD(3, 0); MS_COMPUTE(1, 1);
    MS_COMPUTE(2, 2); MS_COMPUTE(3, 0);
#undef MS_LOAD
#undef MS_COMPUTE
    __syncthreads();
    {
        const int dir = wave >> 2, wq = wave & 3, vt0 = wq * 2; const LAS bf16_t* Kw = dir ? Kwb : Kwf;
        const int troff = (fq * 4 + ((lane >> 2) & 3)) * 144 + (lane & 3) * 4;
        const unsigned onev = (fr == 0) ? 0x3f803f80u : 0u; const bf16x8 ones = mk8(onev, onev, onev, onev);
        f32x4 acc[2][8], nacc[2];
#pragma unroll
        for (int vi = 0; vi < 2; ++vi) { nacc[vi] = (f32x4){0.f, 0.f, 0.f, 0.f};
#pragma unroll
            for (int kt = 0; kt < 8; ++kt) acc[vi][kt] = (f32x4){0.f, 0.f, 0.f, 0.f}; }
#pragma unroll
        for (int ks = 0; ks < 4; ++ks) { const LAS bf16_t* vp = Vs + ks * 32 * 144 + troff + vt0 * 16; const LAS bf16_t* kp = Kw + ks * 32 * 144 + troff;
            const u32x2 l0 = tr_read(vp), h0 = tr_read(vp + 16 * 144), l1 = tr_read(vp + 16), h1 = tr_read(vp + 16 * 144 + 16);
            const bf16x8 a0 = mk8(l0.x, l0.y, h0.x, h0.y), a1 = mk8(l1.x, l1.y, h1.x, h1.y);
#pragma unroll
            for (int kt = 0; kt < 8; ++kt) { const u32x2 bl = tr_read(kp + kt * 16), bh = tr_read(kp + 16 * 144 + kt * 16); const bf16x8 bb = mk8(bl.x, bl.y, bh.x, bh.y);
                acc[0][kt] = mfma16(a0, bb, acc[0][kt]); acc[1][kt] = mfma16(a1, bb, acc[1][kt]);
                if ((kt >> 1) == wq) nacc[kt & 1] = mfma16(ones, bb, nacc[kt & 1]); } }
        bf16_t* outp = KVC + (size_t)(unit * 2 + dir) * 16384;
#pragma unroll
        for (int vi = 0; vi < 2; ++vi)
#pragma unroll
            for (int kt = 0; kt < 8; ++kt)
#pragma unroll
                for (int i = 0; i < 4; i += 2) { const unsigned pq = pk2(acc[vi][kt][i], acc[vi][kt][i + 1]);
                    outp[((vt0 + vi) * 16 + fq * 4 + i) * 128 + kt * 16 + fr] = (bf16_t)(pq & 0xffffu); outp[((vt0 + vi) * 16 + fq * 4 + i + 1) * 128 + kt * 16 + fr] = (bf16_t)(pq >> 16); }
        if (fq == 0) { float* np = NC + (size_t)(unit * 2 + dir) * 128 + wq * 32 + fr; np[0] = nacc[0][0]; np[16] = nacc[1][0]; }
    }
}

__device__ __forceinline__ void mstate_pair(const Params& P, LAS unsigned char* lds, int uA, int uB, int tid, int wave, int lane) {
    const int grp = wave >> 2, wv = wave & 3, tg = tid & 255;
    const int unit = grp ? uB : uA;
    const int b = unit >> 8, c = (unit >> 2) & 63, h = unit & 3;
    LAS unsigned char* gl = lds + grp * 75776;
    LAS bf16_t* Kr = (LAS bf16_t*)gl; LAS bf16_t* Vs = (LAS bf16_t*)(gl + 36864);
    LAS float* wf = (LAS float*)(gl + 73728); LAS float* wb = wf + 128;
    unsigned char* ws = P.ws;
    const bf16_t* PROJ = (const bf16_t*)(ws + WS_PROJ); const float* GATES = (const float*)(ws + WS_GATES);
    float* GV = (float*)(ws + WS_GV); float* SC = (float*)(ws + WS_SC); float* NC = (float*)(ws + WS_NC); bf16_t* KVC = (bf16_t*)P.out;
    bf16_t* KM = (bf16_t*)(ws + WS_KM);
    const size_t m0 = (size_t)b * SEQ + (size_t)c * 128;
    const int fr = lane & 15, fq = lane >> 4;
    __syncthreads();
    float gi0 = 0.f, gf0 = 0.f, gi1 = 0.f, gf1 = 0.f;
    if (wv < 2) { const float* gp = GATES + (m0 + lane) * 16 + wv * 8 + h; gi0 = gp[0]; gf0 = gp[4]; gi1 = gp[64 * 16]; gf1 = gp[64 * 16 + 4]; }
    u32x4 xk[3][3], xv[3];
#define MP_LOAD(it, j) do { const int idx = tg + 256 * (it), s = idx >> 4, part = idx & 15; const int t = c * 128 + s; const bf16_t* rowm = PROJ + (m0 + s) * NPROJ; \
        const int pk = 1280 + h * 128 + part * 8; const u32x4 z = {0u, 0u, 0u, 0u}; \
        xk[j][1] = *(const u32x4*)(rowm + pk); xv[j] = *(const u32x4*)(rowm + 1792 + h * 128 + part * 8); \
        xk[j][0] = z; xk[j][2] = z; \
        if (t > 0) { xk[j][0] = *(const u32x4*)(rowm - NPROJ + pk); } \
        if (t < SEQ - 1) { xk[j][2] = *(const u32x4*)(rowm + NPROJ + pk); } } while (0)
#define MP_COMPUTE(it, j) do { const int idx = tg + 256 * (it), s = idx >> 4, part = idx & 15; float r8[8]; \
        conv8(xk[j][0], xk[j][1], xk[j][2], P.conv_w, P.conv_b, 512 + h * 128 + part * 8, r8); \
        { u32x4 w; w.x = pk2(r8[0], r8[1]); w.y = pk2(r8[2], r8[3]); w.z = pk2(r8[4], r8[5]); w.w = pk2(r8[6], r8[7]); *(u32x4*)(KM + (m0 + s) * 512 + h * 128 + part * 8) = w; \
          *(LAS u32x4*)(Kr + s * 144 + part * 8) = w; } \
        *(LAS u32x4*)(Vs + s * 144 + part * 8) = xv[j]; } while (0)
    MP_LOAD(0, 0); MP_LOAD(1, 1);
    if (wv < 2) {
        const float l0 = logsig_f(gf0), l1 = logsig_f(gf1); float p0, p1, tot;
        if (wv == 0) { p0 = scan_up_add(l0, lane); const float t0 = __shfl(p0, 63); p1 = scan_up_add(l1, lane) + t0; tot = __shfl(p1, 63); }
        else { p1 = scan_down_add(l1, lane); const float t1 = __shfl(p1, 0); p0 = scan_down_add(l0, lane) + t1; tot = __shfl(p0, 0); }
        const float u0 = gi0 - p0, u1 = gi1 - p1; const float umax = wave_max(fmaxf(u0, u1));
        LAS float* wvp = wv ? wb : wf; wvp[lane] = __expf(u0 - umax); wvp[64 + lane] = __expf(u1 - umax);
        float* gv = GV + (size_t)unit * 512 + wv * 128; gv[lane] = u0; gv[64 + lane] = u1; gv[256 + lane] = p0; gv[256 + 64 + lane] = p1;
        if (lane == 0) { float* sc = SC + unit * 4 + wv * 2; sc[0] = tot; sc[1] = tot + umax; }
    }
    MP_LOAD(2, 2); MP_COMPUTE(0, 0);
    MP_LOAD(3, 0); MP_COMPUTE(1, 1);
    MP_LOAD(4, 1); MP_COMPUTE(2, 2);
    MP_LOAD(5, 2); MP_COMPUTE(3, 0);
    MP_LOAD(6, 0); MP_COMPUTE(4, 1);
    MP_LOAD(7, 1); MP_COMPUTE(5, 2);
    MP_COMPUTE(6, 0); MP_COMPUTE(7, 1);
#undef MP_LOAD
#undef MP_COMPUTE
    __syncthreads();
    const int vt0 = wv * 2;
    const int troff = (fq * 4 + ((lane >> 2) & 3)) * 144 + (lane & 3) * 4;
#pragma unroll 1
    for (int dir = 0; dir < 2; ++dir) {
        const LAS float* wd = dir ? wb : wf;
        f32x4 acc[2][8], nacc[2];
#pragma unroll
        for (int vi = 0; vi < 2; ++vi) { nacc[vi] = (f32x4){0.f, 0.f, 0.f, 0.f};
#pragma unroll
            for (int kt = 0; kt < 8; ++kt) acc[vi][kt] = (f32x4){0.f, 0.f, 0.f, 0.f}; }
#pragma unroll
        for (int ks = 0; ks < 4; ++ks) { const LAS bf16_t* vp = Vs + ks * 32 * 144 + troff + vt0 * 16; const LAS bf16_t* kp = Kr + ks * 32 * 144 + troff;
            const f32x4 wlo = *(const LAS f32x4*)(wd + ks * 32 + fq * 4), whi = *(const LAS f32x4*)(wd + ks * 32 + 16 + fq * 4);
            bf16x8 a[2];
#pragma unroll
            for (int vi = 0; vi < 2; ++vi) { const u32x2 lo = tr_read(vp + vi * 16), hi = tr_read(vp + 16 * 144 + vi * 16);
                a[vi] = mk8(pk2(bf2f(lo.x & 0xffffu) * wlo[0], bf2f(lo.x >> 16) * wlo[1]), pk2(bf2f(lo.y & 0xffffu) * wlo[2], bf2f(lo.y >> 16) * wlo[3]),
                            pk2(bf2f(hi.x & 0xffffu) * whi[0], bf2f(hi.x >> 16) * whi[1]), pk2(bf2f(hi.y & 0xffffu) * whi[2], bf2f(hi.y >> 16) * whi[3])); }
            const bf16x8 onesw = (fr == 0) ? mk8(pk2(wlo[0], wlo[1]), pk2(wlo[2], wlo[3]), pk2(whi[0], whi[1]), pk2(whi[2], whi[3])) : mk8(0u, 0u, 0u, 0u);
#pragma unroll
            for (int kt = 0; kt < 8; ++kt) { const u32x2 bl = tr_read(kp + kt * 16), bh = tr_read(kp + 16 * 144 + kt * 16); const bf16x8 bb = mk8(bl.x, bl.y, bh.x, bh.y);
                acc[0][kt] = mfma16(a[0], bb, acc[0][kt]); acc[1][kt] = mfma16(a[1], bb, acc[1][kt]);
                if ((kt >> 1) == wv) nacc[kt & 1] = mfma16(onesw, bb, nacc[kt & 1]); } }
        bf16_t* outp = KVC + (size_t)(unit * 2 + dir) * 16384;
#pragma unroll
        for (int vi = 0; vi < 2; ++vi)
#pragma unroll
            for (int kt = 0; kt < 8; ++kt)
#pragma unroll
                for (int i = 0; i < 4; i += 2) { const unsigned pq = pk2(acc[vi][kt][i], acc[vi][kt][i + 1]);
                    outp[((vt0 + vi) * 16 + fq * 4 + i) * 128 + kt * 16 + fr] = (bf16_t)(pq & 0xffffu); outp[((vt0 + vi) * 16 + fq * 4 + i + 1) * 128 + kt * 16 + fr] = (bf16_t)(pq >> 16); }
        if (fq == 0) { float* np = NC + (size_t)(unit * 2 + dir) * 128 + wv * 32 + fr; np[0] = nacc[0][0]; np[16] = nacc[1][0]; }
    }
}

__device__ __forceinline__ void scan_phase(const Params& P, int tid) {
    unsigned char* ws = P.ws;
    const bf16_t* KVC = (const bf16_t*)P.out; const float* SC = (const float*)(ws + WS_SC); const float* NC = (const float*)(ws + WS_NC);
    bf16_t* CPREV = (bf16_t*)(ws + WS_XN); float* NPREV = (float*)(ws + WS_NPREV); float* MPREV = (float*)(ws + WS_MPREV);
    for (int blk = blockIdx.x; blk < 256; blk += gridDim.x) {
        const int seq = blk >> 4, e2 = (blk & 15) * NTHREADS + tid, b = seq >> 3, h = (seq >> 1) & 3, dir = seq & 1;
        const int off = (e2 >> 6) * 128 + (e2 & 63) * 2;
        const bool do_n = e2 < 128;
        float c0 = 0.f, c1 = 0.f, nst = 0.f, mst = 0.f;
        for (int jb = 0; jb < 64; jb += 16) {
            f32x2_t kv[16]; float bl[16], am[16], nn[16];
#pragma unroll
            for (int u = 0; u < 16; ++u) { const int j = jb + u, cidx = dir ? 63 - j : j, unit = (b * 64 + cidx) * 4 + h;
                { const unsigned pq = *(const unsigned*)(KVC + (size_t)(unit * 2 + dir) * 16384 + off); kv[u] = (f32x2_t){bf2f(pq & 0xffffu), bf2f(pq >> 16)}; }
                bl[u] = SC[unit * 4 + dir * 2]; am[u] = SC[unit * 4 + dir * 2 + 1]; nn[u] = do_n ? NC[(size_t)(unit * 2 + dir) * 128 + e2] : 0.f; }
#pragma unroll
            for (int u = 0; u < 16; ++u) { const int j = jb + u, cidx = dir ? 63 - j : j, unit = (b * 64 + cidx) * 4 + h;
                *(unsigned*)(CPREV + (size_t)(unit * 2 + dir) * 16384 + off) = pk2(c0, c1);
                if (do_n) NPREV[(size_t)(unit * 2 + dir) * 128 + e2] = nst;
                if (e2 == 0) MPREV[unit * 2 + dir] = mst;
                const float m_new = fmaxf(bl[u] + mst, am[u]); const float dec = __expf(bl[u] + mst - m_new), inj = __expf(am[u] - m_new);
                c0 = dec * c0 + inj * kv[u][0]; c1 = dec * c1 + inj * kv[u][1]; nst = dec * nst + inj * nn[u]; mst = m_new; }
        }
    }
}

__device__ __forceinline__ void mout_unit(const Params& P, LAS unsigned char* lds, int unit, int tid, int wave, int lane) {
    const int b = unit >> 8, c = (unit >> 2) & 63, h = unit & 3;
    LAS bf16_t* Ks = (LAS bf16_t*)lds;
    LAS bf16_t* Vs = (LAS bf16_t*)(lds + 34816);
    LAS bf16_t* Cf = (LAS bf16_t*)(lds + 71680);
    LAS bf16_t* Cb = (LAS bf16_t*)(lds + 106496);
    LAS float* fa = (LAS float*)(lds + 141312);
    LAS float* uf = fa; LAS float* ub = fa + 128; LAS float* Mf = fa + 256; LAS float* Mb = fa + 384; LAS float* inf_ = fa + 512; LAS float* inb = fa + 640;
    LAS float* emf = fa + 768; LAS float* emb = fa + 896; LAS float* npf = fa + 1024; LAS float* npb = fa + 1152;
    unsigned char* ws = P.ws;
    const bf16_t* PROJ = (const bf16_t*)(ws + WS_PROJ); const bf16_t* QM = (const bf16_t*)(ws + WS_QM); const bf16_t* KM = (const bf16_t*)(ws + WS_KM);
    const bf16_t* CPREV = (const bf16_t*)(ws + WS_XN); const float* NPREV = (const float*)(ws + WS_NPREV); const float* MPREV = (const float*)(ws + WS_MPREV);
    const float* GV = (const float*)(ws + WS_GV); bf16_t* A2 = (bf16_t*)(ws + WS_A2);
    const size_t m0 = (size_t)b * SEQ + (size_t)c * 128;
    const int fr = lane & 15, fq = lane >> 4;
    const int t = wave * 16 + fr;
    __syncthreads();
    u32x4 rk[4], rv[4], rcf[4], rcb[4];
#pragma unroll
    for (int it = 0; it < 4; ++it) { const int idx = tid + 512 * it, s = idx >> 4, part = idx & 15;
        rk[it] = *(const u32x4*)(KM + (m0 + s) * 512 + h * 128 + part * 8); rv[it] = *(const u32x4*)(PROJ + (m0 + s) * NPROJ + 1792 + h * 128 + part * 8);
        rcf[it] = *(const u32x4*)(CPREV + (size_t)(unit * 2) * 16384 + s * 128 + part * 8); rcb[it] = *(const u32x4*)(CPREV + (size_t)(unit * 2 + 1) * 16384 + s * 128 + part * 8); }
    u32x4 xq[4][3];
    { const int pos = c * 128 + t; const bf16_t* rowq = PROJ + (m0 + t) * NPROJ + 768 + h * 128 + fq * 8;
#pragma unroll
      for (int kk = 0; kk < 4; ++kk) { const u32x4 z = {0u, 0u, 0u, 0u}; xq[kk][1] = *(const u32x4*)(rowq + kk * 32); xq[kk][0] = z; xq[kk][2] = z;
          if (pos > 0) xq[kk][0] = *(const u32x4*)(rowq - NPROJ + kk * 32); if (pos < SEQ - 1) xq[kk][2] = *(const u32x4*)(rowq + NPROJ + kk * 32); } }
    if (wave < 2) {
        const float* gv = GV + (size_t)unit * 512 + wave * 128; const float u0 = gv[lane], u1 = gv[64 + lane], bc0 = gv[256 + lane], bc1 = gv[256 + 64 + lane];
        const float mp = MPREV[unit * 2 + wave]; float a0, a1;
        if (wave == 0) { a0 = fmaxf(scan_up_max(u0, lane), mp); const float cr = __shfl(a0, 63); a1 = fmaxf(scan_up_max(u1, lane), cr); }
        else { a1 = fmaxf(scan_down_max(u1, lane), mp); const float cr = __shfl(a1, 0); a0 = fmaxf(scan_down_max(u0, lane), cr); }
        LAS float* ua = wave ? ub : uf; LAS float* Ma = wave ? Mb : Mf; LAS float* ia = wave ? inb : inf_; LAS float* ea = wave ? emb : emf;
        ua[lane] = u0; ua[64 + lane] = u1; Ma[lane] = a0; Ma[64 + lane] = a1; ia[lane] = __expf(mp - a0); ia[64 + lane] = __expf(mp - a1);
        ea[lane] = __expf(-(bc0 + a0)); ea[64 + lane] = __expf(-(bc1 + a1));
    } else if (wave == 2) { npf[lane] = NPREV[(size_t)(unit * 2) * 128 + lane]; npf[64 + lane] = NPREV[(size_t)(unit * 2) * 128 + 64 + lane];
        npb[lane] = NPREV[(size_t)(unit * 2 + 1) * 128 + lane]; npb[64 + lane] = NPREV[(size_t)(unit * 2 + 1) * 128 + 64 + lane]; }
#pragma unroll
    for (int it = 0; it < 4; ++it) { const int idx = tid + 512 * it, s = idx >> 4, part = idx & 15;
        *(LAS u32x4*)(Ks + s * 136 + part * 8) = rk[it]; *(LAS u32x4*)(Vs + s * 144 + part * 8) = rv[it];
        *(LAS u32x4*)(Cf + s * 136 + part * 8) = rcf[it]; *(LAS u32x4*)(Cb + s * 136 + part * 8) = rcb[it]; }
    __syncthreads();
    bf16x8 qf[4];
#pragma unroll
    for (int kk = 0; kk < 4; ++kk) { float r8[8]; conv8(xq[kk][0], xq[kk][1], xq[kk][2], P.conv_w, P.conv_b, h * 128 + kk * 32 + fq * 8, r8);
        const float sc = 0.08838834764831845f;
        qf[kk] = mk8(pk2(r8[0] * sc, r8[1] * sc), pk2(r8[2] * sc, r8[3] * sc), pk2(r8[4] * sc, r8[5] * sc), pk2(r8[6] * sc, r8[7] * sc)); }
    float qnf = 0.f, qnb = 0.f;
#pragma unroll
    for (int kk = 0; kk < 4; ++kk) { const u32x4 qq = __builtin_bit_cast(u32x4, qf[kk]);
#pragma unroll
        for (int j = 0; j < 8; ++j) { const float qv = bf2f((qq[j >> 1] >> (16 * (j & 1))) & 0xffffu); const int d = kk * 32 + fq * 8 + j; qnf += qv * npf[d]; qnb += qv * npb[d]; } }
    qnf = quad_sum(qnf); qnb = quad_sum(qnb);
    f32x4 sT[8];
#pragma unroll
    for (int st = 0; st < 8; ++st) { f32x4 a = {0.f, 0.f, 0.f, 0.f};
#pragma unroll
        for (int kk = 0; kk < 4; ++kk) a = mfma16(*(const LAS bf16x8*)(Ks + (st * 16 + fr) * 136 + kk * 32 + fq * 8), qf[kk], a);
        sT[st] = a; }
    const int troff = (fq * 4 + ((lane >> 2) & 3)) * 144 + (lane & 3) * 4;
    f32x4 hsum[8];
#pragma unroll
    for (int vt = 0; vt < 8; ++vt) hsum[vt] = (f32x4){0.f, 0.f, 0.f, 0.f};
#pragma unroll 1
    for (int dir = 0; dir < 2; ++dir) {
        f32x4 acc[8];
        const LAS bf16_t* Cp = dir ? Cb : Cf;
#pragma unroll
        for (int vt = 0; vt < 8; ++vt) { f32x4 a = {0.f, 0.f, 0.f, 0.f};
#pragma unroll
            for (int kk = 0; kk < 4; ++kk) a = mfma16(*(const LAS bf16x8*)(Cp + (vt * 16 + fr) * 136 + kk * 32 + fq * 8), qf[kk], a);
            acc[vt] = a; }
        const float inter = dir ? inb[t] : inf_[t], Mt = dir ? Mb[t] : Mf[t];
#pragma unroll
        for (int vt = 0; vt < 8; ++vt) acc[vt] *= inter;
        float den = 0.f; unsigned pk[8][2];
#pragma unroll
        for (int st = 0; st < 8; ++st) { const f32x4 uu = *(const LAS f32x4*)((dir ? ub : uf) + st * 16 + fq * 4); float p[4];
#pragma unroll
            for (int i = 0; i < 4; ++i) { const int s = st * 16 + fq * 4 + i; const bool ok = dir ? (s >= t) : (s <= t); const float w = ok ? __expf(uu[i] - Mt) : 0.f; p[i] = sT[st][i] * w; den += p[i]; }
            pk[st][0] = pk2(p[0], p[1]); pk[st][1] = pk2(p[2], p[3]); }
        den = quad_sum(den) + inter * (dir ? qnb : qnf);
        const int ks_lo = dir ? (wave >> 1) : 0, ks_hi = dir ? 3 : (wave >> 1);
#pragma unroll
        for (int ks = 0; ks < 4; ++ks) if (ks >= ks_lo && ks <= ks_hi) { const bf16x8 bfrag = mk8(pk[2 * ks][0], pk[2 * ks][1], pk[2 * ks + 1][0], pk[2 * ks + 1][1]);
            const LAS bf16_t* vp = Vs + ks * 32 * 144 + troff;
#pragma unroll
            for (int vt = 0; vt < 8; ++vt) { const u32x2 lo = tr_read(vp + vt * 16), hi = tr_read(vp + 16 * 144 + vt * 16);
                acc[vt] = mfma16(mk8(lo.x, lo.y, hi.x, hi.y), bfrag, acc[vt]); } }
        const float rd = 1.0f / fmaxf(fabsf(den), dir ? emb[t] : emf[t]);
#pragma unroll
        for (int vt = 0; vt < 8; ++vt) hsum[vt] += acc[vt] * rd;
    }
    float ss = 0.f;
#pragma unroll
    for (int vt = 0; vt < 8; ++vt) { const f32x4 v = hsum[vt]; ss += (v[0] * v[0] + v[1] * v[1]) + (v[2] * v[2] + v[3] * v[3]); }
    const float rstd = rsqrtf(quad_sum(ss) * (1.0f / 128.0f) + EPS) * sqrtf(((const float*)(ws + WS_ATTSS))[m0 + t] * (1.0f / 512.0f) + EPS);
#pragma unroll
    for (int vt = 0; vt < 8; ++vt) { const int v0 = h * 128 + vt * 16 + fq * 4; const f32x4 gv = *(const f32x4*)(P.g_mlstm_out + v0);
        const u32x2 om = *(const u32x2*)(PROJ + (m0 + t) * NPROJ + 2304 + v0);
        const float o0 = sigmoid_f(bf2f(om.x & 0xffffu)), o1 = sigmoid_f(bf2f(om.x >> 16)), o2 = sigmoid_f(bf2f(om.y & 0xffffu)), o3 = sigmoid_f(bf2f(om.y >> 16));
        const f32x4 v = hsum[vt] * rstd * gv; u32x2 w; w.x = pk2(v[0] * o0, v[1] * o1); w.y = pk2(v[2] * o2, v[3] * o3);
        *(u32x2*)(A2 + (m0 + t) * D + 512 + v0) = w; }
}

#define XB_TMO      128
#define XB_XCNT(j)  (256  + 64 * (j))
#define XB_XSUB(j)  (1280 + 64 * (j))
#define XB_XGEN(j)  (2304 + 64 * (j))
#define XB_TOP      3328
#define XB_TOPGEN   3392
#define XCD_BAR_WORDS 3456
#define XB_SPIN_CAP (1u << 18)

__device__ __forceinline__ unsigned xb_ld(unsigned* p)              { return __hip_atomic_load(p, __ATOMIC_RELAXED, __HIP_MEMORY_SCOPE_AGENT); }
__device__ __forceinline__ unsigned xb_add(unsigned* p, unsigned v) { return __hip_atomic_fetch_add(p, v, __ATOMIC_RELAXED, __HIP_MEMORY_SCOPE_AGENT); }
__device__ __forceinline__ unsigned xb_xcc_id() { return (unsigned)__builtin_amdgcn_s_getreg((3 << 11) | 20) & 0xFu; }
#define XB_SPIN(cond, bar) do { unsigned _sp = 0; while (cond) { __builtin_amdgcn_s_sleep(1); \
    if ((++_sp & 255u) == 0u) { if (xb_ld(&(bar)[XB_TMO])) break; if (_sp > XB_SPIN_CAP) { atomicAdd(&(bar)[XB_TMO], 1u); break; } } } } while (0)

struct XcdBarrier {
    unsigned* bar; unsigned x;
    volatile LAS unsigned* st;
};

__device__ __forceinline__ XcdBarrier xcd_barrier_post(unsigned* bar, volatile LAS unsigned* st) {
    XcdBarrier b; b.bar = bar; b.x = xb_xcc_id(); b.st = st;
    if (threadIdx.x == 0) (void)xb_add(&bar[XB_XCNT(b.x)], 1u);
    return b;
}
__device__ __forceinline__ void xcd_barrier_complete(unsigned* bar, unsigned x, unsigned& nloc, unsigned& nx) {
    const unsigned G = gridDim.x * gridDim.y * gridDim.z;
    unsigned sum, cnt, mine, sp = 0u;
    for (;;) {
        sum = 0u; cnt = 0u; mine = 0u;
#pragma unroll
        for (unsigned j = 0; j < 16; ++j) { const unsigned c = xb_ld(&bar[XB_XCNT(j)]); sum += c; cnt += (c > 0u) ? 1u : 0u; mine = (j == x) ? c : mine; }
        if (sum == G) break;
        __builtin_amdgcn_s_sleep(1);
        if ((++sp & 255u) == 0u) { if (xb_ld(&bar[XB_TMO])) break; if (sp > XB_SPIN_CAP) { atomicAdd(&bar[XB_TMO], 1u); break; } }
    }
    nloc = mine > 0u ? mine : 1u; nx = cnt > 0u ? cnt : 1u;
}

__device__ __forceinline__ void xcd_barrier(const XcdBarrier& b) {
    asm volatile("s_waitcnt vmcnt(0)" ::: "memory");
    __syncthreads();
    if (threadIdx.x == 0) {
        unsigned* bar = b.bar;
        __builtin_amdgcn_s_waitcnt(0);
        unsigned nloc = b.st[0], nx = b.st[1];
        if (nloc == 0u) { xcd_barrier_complete(bar, b.x, nloc, nx); b.st[0] = nloc; b.st[1] = nx; }
        const unsigned old = xb_add(&bar[XB_XSUB(b.x)], 1u);
        const unsigned gen = old / nloc;
        if (old + 1u == (gen + 1u) * nloc) {
            __builtin_amdgcn_fence(__ATOMIC_RELEASE, "agent");
            asm volatile("s_waitcnt vmcnt(0)" ::: "memory");
            const unsigned og = xb_add(&bar[XB_TOP], 1u);
            const unsigned tg = og / nx;
            if (og + 1u == (tg + 1u) * nx) xb_add(&bar[XB_TOPGEN], 1u);
            else XB_SPIN(xb_ld(&bar[XB_TOPGEN]) == tg, bar);
            __builtin_amdgcn_fence(__ATOMIC_ACQUIRE, "agent");
            xb_add(&bar[XB_XGEN(b.x)], 1u);
            asm volatile("s_waitcnt vmcnt(0)" ::: "memory");
        } else {
            XB_SPIN(xb_ld(&bar[XB_XGEN(b.x)]) == gen, bar);
            __builtin_amdgcn_fence(__ATOMIC_ACQUIRE, "agent");
            asm volatile("s_waitcnt vmcnt(0)" ::: "memory");
        }
    }
    __syncthreads();
}

__global__ void __launch_bounds__(NTHREADS) hybrid_fwd(Params P) {
    extern __shared__ __attribute__((aligned(16))) unsigned char lds_raw[];
    LAS unsigned char* lds = (LAS unsigned char*)lds_raw;
    cg::grid_group grid = cg::this_grid();
    const int tid = threadIdx.x, lane = tid & 63, wave = __builtin_amdgcn_readfirstlane(tid >> 6);
    volatile LAS unsigned* bst = (volatile LAS unsigned*)(lds + LDS_BYTES - 64);
    if (tid < 2) bst[tid] = 0u;
    __syncthreads();
    XcdBarrier bar = xcd_barrier_post((unsigned*)(P.ws + WS_BAR), bst);
    if (P.ph_lo < 0) grid.sync();
    unsigned char* ws = P.ws;
    const int vcu = ((int)gridDim.x % 8 == 0) ? ((int)blockIdx.x % 8) * ((int)gridDim.x / 8) + (int)blockIdx.x / 8 : (int)blockIdx.x;
    const float* MOD = (const float*)(ws + WS_MOD);
    bf16_t* XN = (bf16_t*)(ws + WS_XN);
#ifndef WGM_P2
#define WGM_P2 8
#endif
#ifndef WGM_P6
#define WGM_P6 8
#endif
#ifndef WGM_P8
#define WGM_P8 2
#endif
#ifndef WGM_P9
#define WGM_P9 8
#endif
#ifndef DUP_MASK
#define DUP_MASK 0
#endif
#ifndef PH_MASK
#define PH_MASK 0x7ff
#endif
#define IN(k) (((PH_MASK >> (k)) & 1) && P.ph_lo <= (k) && (k) < P.ph_hi)
#define SEAM(k) do { if (IN(k) && IN((k) + 1)) xcd_barrier(bar); } while (0)
    if (IN(0)) { for (int rep = 0; rep < 1 + ((DUP_MASK >> 0) & 1); ++rep) { phase0(P, lds, tid, wave, lane); __syncthreads(); } } SEAM(0);
    if (IN(1)) { for (int i = blockIdx.x * NTHREADS + tid; i < M; i += gridDim.x * NTHREADS) { ((float*)(ws + WS_ATTSS))[i] = 0.f; ((float*)(ws + WS_SS2))[i] = 0.f; ((float*)(ws + WS_SS3))[i] = 0.f; }
        for (int rep = 0; rep < 1 + ((DUP_MASK >> 1) & 1); ++rep) norm_mod_phase(P.x, P.g_norm1, MOD, 0, 1024, XN, wave, lane); } SEAM(1);
    if (IN(2)) for (int rep = 0; rep < 1 + ((DUP_MASK >> 2) & 1); ++rep) {
        pg8::Gemm g{XN, (const bf16_t*)(ws + WS_WIN), M, NPROJ, D}; pg8::StaticOrder S; S.init(M, NPROJ, (int)gridDim.x, (int)blockIdx.x, WGM_P2);
        EpiProj E{(bf16_t*)(ws + WS_PROJ), (float*)(ws + WS_GATES), P.b_gates};
        pg8::gemm_phase<EpiProj, pg8::StaticOrder, true, true>(lds, g, S, E);
    } SEAM(2);
    if (IN(3)) {
        for (int rep = 0; rep < 1 + ((DUP_MASK >> 11) & 1); ++rep) attn_phase(P, lds, tid, wave, lane, rep == 0);
        for (int rep = 0; rep < 1 + ((DUP_MASK >> 12) & 1); ++rep)
        for (int u = vcu; u < 256; u += gridDim.x) mstate_pair(P, lds, u, u + 256, tid, wave, lane);
    } SEAM(3);
    if (IN(4)) { for (int rep = 0; rep < 1 + ((DUP_MASK >> 4) & 1); ++rep) scan_phase(P, tid); } SEAM(4);
    if (IN(5)) { for (int rep = 0; rep < 1 + ((DUP_MASK >> 5) & 1); ++rep) for (int u = vcu; u < 512; u += gridDim.x) mout_unit(P, lds, u, tid, wave, lane); } SEAM(5);
    if (IN(6)) for (int rep = 0; rep < 1 + ((DUP_MASK >> 6) & 1); ++rep) {
        __syncthreads();
        pg8::Gemm g{(const bf16_t*)(ws + WS_A2), (const bf16_t*)(ws + WS_WOUT), M, D, D}; pg8::StaticOrder S; S.init(M, D, (int)gridDim.x, (int)blockIdx.x, WGM_P6);
        EpiResidNorm E{P.x, P.out, MOD + 2048, (const float*)(ws + WS_ATTSS), (float*)(ws + WS_SS2), (unsigned*)(ws + WS_CNT), P.g_norm2, MOD + 4096, MOD + 3072, XN, nullptr, (bf16_t*)(ws + WS_QM)};
        pg8::gemm_phase<EpiResidNorm, pg8::StaticOrder, false, true>(lds, g, S, E);
    } do { if (IN(6) && IN(8)) xcd_barrier(bar); } while (0);
    if (IN(8)) for (int rep = 0; rep < 1 + ((DUP_MASK >> 8) & 1); ++rep) {
        pg8::Gemm g{XN, (const bf16_t*)(ws + WS_WFI), M, 2 * DFF, D}; pg8::StaticOrder S; S.init(M, 2 * DFF, (int)gridDim.x, (int)blockIdx.x, WGM_P8);
        EpiSwiglu E{(bf16_t*)(ws + WS_PROJ)};
        pg8::gemm_phase<EpiSwiglu, pg8::StaticOrder, true, true>(lds, g, S, E);
    } SEAM(8);
    if (IN(9)) {
        pg8::Gemm g{(const bf16_t*)(ws + WS_PROJ), (const bf16_t*)(ws + WS_WFO), M, D, DFF}; pg8::StaticOrder S; S.init(M, D, (int)gridDim.x, (int)blockIdx.x, WGM_P9);
        EpiResidNorm E{nullptr, P.out, MOD + 5120, nullptr, (float*)(ws + WS_SS3), (unsigned*)(ws + WS_CNT) + 1024, P.g_final, nullptr, nullptr, nullptr, (const bf16_t*)(ws + WS_QM), nullptr};
        pg8::gemm_phase<EpiResidNorm, pg8::StaticOrder, false, true>(lds, g, S, E);
    }
#undef IN
#undef SEAM
}

#ifndef MK_LAUNCHES
#define MK_LAUNCHES 1
#endif
extern "C" void kernel_launch(void* const* d_in, const int* in_sizes, int n_in, void* d_out, int out_size, void* d_ws, size_t ws_size, hipStream_t stream) {
    static int ready = 0;
    if (!ready) {
        if (n_in != 17 || out_size != M * D || ws_size < WS_END) { fprintf(stderr, "kernel_launch: unexpected shapes (n_in %d out %d ws %zu)\n", n_in, out_size, ws_size); ready = -1; return; }
        if (hipFuncSetAttribute((const void*)hybrid_fwd, hipFuncAttributeMaxDynamicSharedMemorySize, LDS_BYTES) != hipSuccess) { fprintf(stderr, "kernel_launch: hipFuncSetAttribute failed\n"); ready = -1; return; }
        ready = 1;
    }
    if (ready < 0) return;
    Params p{};
    const float** pp = (const float**)&p;
    for (int i = 0; i < 17; ++i) pp[i] = (const float*)d_in[i];
    p.out = (float*)d_out; p.ws = (unsigned char*)d_ws;
    (void)hipMemsetAsync((unsigned char*)d_ws + WS_BAR, 0, 32768, stream);
#if MK_LAUNCHES == 1
    p.ph_lo = 0; p.ph_hi = NPHASES;
    void* args[] = {&p};
    hipError_t e = hipLaunchCooperativeKernel((const void*)hybrid_fwd, dim3(256), dim3(NTHREADS), args, LDS_BYTES, stream);
    if (e != hipSuccess) fprintf(stderr, "cooperative launch failed: %s\n", hipGetErrorString(e));
#else
    for (int k = 0; k < NPHASES; ++k) { p.ph_lo = k; p.ph_hi = k + 1; void* args[] = {&p};
        hipError_t e = hipLaunchCooperativeKernel((const void*)hybrid_fwd, dim3(256), dim3(NTHREADS), args, LDS_BYTES, stream);
        if (e != hipSuccess) fprintf(stderr, "launch %d failed: %s\n", k, hipGetErrorString(e)); }
#endif
}
```

```cpp
#include <hip/hip_runtime.h>
#include <hip/hip_cooperative_groups.h>
#include <cstdio>
#include <cstdint>
namespace cg = cooperative_groups;
namespace pg8 {
#define PG8_LAS __attribute__((address_space(3)))
typedef unsigned short bf16_t;
typedef short bf16x8 __attribute__((ext_vector_type(8)));
typedef float f32x4 __attribute__((ext_vector_type(4)));
typedef unsigned u32x4 __attribute__((ext_vector_type(4)));
constexpr int BM = 256, BK = 64, HALF = 128, HTB = HALF * BK * 2  , STAGE_BYTES = 8 * HTB, NXCD = 8, WGM = 8;

__host__ __device__ __forceinline__ int lds_byte(int r, int c) { const int st = (r >> 4) * 2 + (c >> 5), rr = r & 15, cc = c & 31, ob = rr * 64 + cc * 2; return st * 1024 + (ob ^ (((ob >> 9) & 1) << 5)); }
__host__ __device__ __forceinline__ void stage_rc(int b, int& R, int& C) { const int st = b / 1024, sb = b % 1024, swz = sb ^ (((sb >> 9) & 1) << 5); R = (st >> 1) * 16 + swz / 64; C = (st & 1) * 32 + (swz % 64) / 2; }
__host__ __device__ __forceinline__ int perm32(int rho) { const int n = rho >> 4, i = rho & 15; return 8 * (i >> 2) + 4 * n + (i & 3); }

struct Unit { int pm, pn; };
struct Gemm { const bf16_t* A; const bf16_t* Bt; int M, N, K; };

struct StaticOrder {
    int nM, nN, nwg, G, c, wgm;
    __host__ __device__ void init(int M, int N, int G_, int c_, int wgm_ = WGM) { nM = M / BM; nN = N / BM; nwg = nM * nN; G = G_; c = c_; wgm = wgm_; }
    __host__ __device__ bool next(int i, Unit& u) const {
        const long L = (long)i * G + c; if (L >= nwg) return false;
        int wgid = (int)L; { const int q = nwg / NXCD, r = nwg % NXCD, xcd = wgid % NXCD, off = wgid / NXCD; wgid = (xcd < r ? xcd * (q + 1) : r * (q + 1) + (xcd - r) * q) + off; }
        const int nig = wgm * nN, gid = wgid / nig, fm = gid * wgm, gsz = (nM - fm) < wgm ? (nM - fm) : wgm;
        u.pm = fm + ((wgid % nig) % gsz); u.pn = (wgid % nig) / gsz; return true;
    }
    __device__ __forceinline__ void a_ready(const Unit&) const {}
    __device__ __forceinline__ void done(const Unit&) const {}
};

__device__ __forceinline__ unsigned cvt_pk_bf16(float lo, float hi) { unsigned r; asm volatile("v_cvt_pk_bf16_f32 %0, %1, %2" : "=v"(r) : "v"(lo), "v"(hi)); return r; }
typedef float f32x2 __attribute__((ext_vector_type(2)));
template <class Epi, class Sched, bool ALIGN_EPI = false, bool SP2 = false>
__device__ __forceinline__ void gemm_phase(PG8_LAS unsigned char* lds, const Gemm g, const Sched& S, const Epi& E) {
    const int tid = threadIdx.x, wid = __builtin_amdgcn_readfirstlane(tid >> 6), lane = tid & 63, wr = wid >> 2, wc = wid & 3, fr = lane & 15, fq = lane >> 4;
    const int K = g.K, nt = K / BK;
    unsigned voffA[2], voffB[2];
#pragma unroll
    for (int i = 0; i < 2; ++i) { int R, C; stage_rc(tid * 16 + i * 8192, R, C); const int Rb = Epi::PERM ? ((R & ~31) + perm32(R & 31)) : R;
        voffA[i] = (unsigned)(R * K + C) * 2u; voffB[i] = (unsigned)(Rb * K + C) * 2u; }
    const size_t kstep = (size_t)(BK * 2);
    const size_t hstep = (size_t)HALF * K * 2;
    const size_t tstep = 2 * hstep;
    const unsigned ldsw = (unsigned)wid * 1024u;
    const int aoff = lds_byte(wr * 64 + fr, fq * 8), boff = lds_byte(wc * 32 + fr, fq * 8);
#define PG8_SA(b, h) (((b) * 2 + (h)) * HTB)
#define PG8_SB(b, h) ((4 + (b) * 2 + (h)) * HTB)
#define PG8_STAGE(bufoff, gbase, voff) do { _Pragma("unroll") for (int _i = 0; _i < 2; ++_i) \
        __builtin_amdgcn_global_load_lds((const unsigned*)((const char*)(gbase) + (voff)[_i]), (PG8_LAS unsigned*)(lds + (bufoff) + ldsw + _i * 8192), 16, 0, 0); } while (0)
#define PG8_LDA(dst, b, h) do { _Pragma("unroll") for (int m = 0; m < 4; ++m) _Pragma("unroll") for (int k = 0; k < 2; ++k) dst[m][k] = *(const PG8_LAS bf16x8*)(lds + PG8_SA(b, h) + aoff + m * 2048 + k * 1024); } while (0)
#define PG8_LDB(dst, b, h) do { _Pragma("unroll") for (int n = 0; n < 2; ++n) _Pragma("unroll") for (int k = 0; k < 2; ++k) dst[n][k] = *(const PG8_LAS bf16x8*)(lds + PG8_SB(b, h) + boff + n * 2048 + k * 1024); } while (0)
#define PG8_MMA(ai, bj, At, Bt) do { __builtin_amdgcn_s_setprio(1); _Pragma("unroll") for (int m = 0; m < 4; ++m) _Pragma("unroll") for (int n = 0; n < 2; ++n) _Pragma("unroll") for (int k = 0; k < 2; ++k) \
        acc[ai][bj][m][n] = __builtin_amdgcn_mfma_f32_16x16x32_bf16(Bt[n][k], At[m][k], acc[ai][bj][m][n], 0, 0, 0); __builtin_amdgcn_s_setprio(0); } while (0)
#define PG8_WAIT_V(n) asm volatile("s_waitcnt vmcnt(" #n ")" ::: "memory")
#define PG8_WAIT_L(n) asm volatile("s_waitcnt lgkmcnt(" #n ")" ::: "memory")
#define PG8_BAR __builtin_amdgcn_s_barrier()
#define PG8_SCHED __builtin_amdgcn_sched_barrier(0)
    Unit cur, nxt; int ui = 0;
    if (!S.next(0, cur)) return;
    f32x4 acc[2][2][4][2];
#pragma unroll
    for (int a = 0; a < 2; ++a)
#pragma unroll
        for (int b = 0; b < 2; ++b)
#pragma unroll
            for (int m = 0; m < 4; ++m)
#pragma unroll
                for (int n = 0; n < 2; ++n) acc[a][b][m][n] = (f32x4){0.f, 0.f, 0.f, 0.f};
    bf16x8 At[4][2], B0[2][2], B1[2][2];
    const char* cA = (const char*)g.A + (size_t)cur.pm * tstep; const char* cB = (const char*)g.Bt + (size_t)cur.pn * tstep;
    S.a_ready(cur);
    if constexpr (SP2) {
        PG8_STAGE(PG8_SB(0, 0), cB, voffB); PG8_STAGE(PG8_SB(0, 1), cB + hstep, voffB); PG8_STAGE(PG8_SA(0, 0), cA, voffA); PG8_STAGE(PG8_SA(0, 1), cA + hstep, voffA);
        if (wr == 1) PG8_BAR;
        PG8_WAIT_V(2); PG8_BAR;
        PG8_STAGE(PG8_SB(1, 0), cB + kstep, voffB); PG8_STAGE(PG8_SA(1, 0), cA + kstep, voffA); PG8_STAGE(PG8_SB(1, 1), cB + hstep + kstep, voffB);
        PG8_WAIT_V(6); PG8_BAR;
    } else {
        PG8_STAGE(PG8_SB(0, 0), cB, voffB); PG8_STAGE(PG8_SA(0, 0), cA, voffA); PG8_STAGE(PG8_SB(0, 1), cB + hstep, voffB); PG8_STAGE(PG8_SA(0, 1), cA + hstep, voffA);
        if (wr == 1) PG8_BAR;
        PG8_WAIT_V(4); PG8_BAR;
        PG8_STAGE(PG8_SB(1, 0), cB + kstep, voffB); PG8_STAGE(PG8_SA(1, 0), cA + kstep, voffA); PG8_STAGE(PG8_SB(1, 1), cB + hstep + kstep, voffB);
        PG8_WAIT_V(6); PG8_BAR;
    }
    for (;;) {
        const bool has_next = S.next(ui + 1, nxt);
        const char* nA = has_next ? (const char*)g.A + (size_t)nxt.pm * tstep : cA; const char* nB = has_next ? (const char*)g.Bt + (size_t)nxt.pn * tstep : cB;
        for (int t = 0; t < nt; t += 2) {
            const bool last = (t == nt - 2);
            const char* a1 = cA + (size_t)(t + 1) * kstep;
            const char* a2 = last ? nA : cA + (size_t)(t + 2) * kstep; const char* b2 = last ? nB : cB + (size_t)(t + 2) * kstep;
            const char* a3 = a2 + kstep; const char* b3 = b2 + kstep;
            if (last && has_next) S.a_ready(nxt);
            if constexpr (SP2) {
            PG8_LDB(B0, 0, 0); PG8_LDB(B1, 0, 1); PG8_SCHED; PG8_LDA(At, 0, 0); PG8_STAGE(PG8_SA(1, 1), a1 + hstep, voffA);
            PG8_WAIT_V(8); PG8_WAIT_L(0); PG8_BAR; PG8_MMA(0, 0, At, B0); PG8_MMA(0, 1, At, B1); PG8_BAR; PG8_SCHED;
            PG8_LDA(At, 0, 1); PG8_STAGE(PG8_SB(0, 0), b2, voffB); PG8_STAGE(PG8_SB(0, 1), b2 + hstep, voffB); PG8_STAGE(PG8_SA(0, 0), a2, voffA);
            PG8_WAIT_V(8); PG8_WAIT_L(0); PG8_BAR; PG8_MMA(1, 0, At, B0); PG8_MMA(1, 1, At, B1); PG8_BAR; PG8_SCHED;
            PG8_LDB(B0, 1, 0); PG8_LDB(B1, 1, 1); PG8_SCHED; PG8_LDA(At, 1, 0); PG8_STAGE(PG8_SA(0, 1), a2 + hstep, voffA);
            PG8_WAIT_V(8); PG8_WAIT_L(0); PG8_BAR; PG8_MMA(0, 0, At, B0); PG8_MMA(0, 1, At, B1); PG8_BAR; PG8_SCHED;
            PG8_LDA(At, 1, 1); PG8_STAGE(PG8_SB(1, 0), b3, voffB); PG8_STAGE(PG8_SB(1, 1), b3 + hstep, voffB); PG8_STAGE(PG8_SA(1, 0), a3, voffA);
            PG8_WAIT_V(8); PG8_WAIT_L(0); PG8_BAR; PG8_MMA(1, 0, At, B0); PG8_MMA(1, 1, At, B1); PG8_BAR; PG8_SCHED;
            } else {
            PG8_LDB(B0, 0, 0); PG8_SCHED; PG8_LDA(At, 0, 0); PG8_STAGE(PG8_SA(1, 1), a1 + hstep, voffA);
            PG8_WAIT_L(8); PG8_BAR; PG8_WAIT_L(0); PG8_MMA(0, 0, At, B0); PG8_BAR; PG8_SCHED;
            PG8_LDB(B1, 0, 1); PG8_STAGE(PG8_SB(0, 0), b2, voffB);
            PG8_BAR; PG8_WAIT_L(0); PG8_MMA(0, 1, At, B1); PG8_BAR;
            PG8_LDA(At, 0, 1); PG8_STAGE(PG8_SA(0, 0), a2, voffA);
            PG8_BAR; PG8_WAIT_L(0); PG8_MMA(1, 0, At, B0); PG8_BAR; PG8_SCHED;
            PG8_STAGE(PG8_SB(0, 1), b2 + hstep, voffB);
            PG8_WAIT_V(6); PG8_BAR; PG8_MMA(1, 1, At, B1); PG8_BAR;
            PG8_LDB(B0, 1, 0); PG8_SCHED; PG8_LDA(At, 1, 0); PG8_STAGE(PG8_SA(0, 1), a2 + hstep, voffA);
            PG8_WAIT_L(8); PG8_BAR; PG8_WAIT_L(0); PG8_MMA(0, 0, At, B0); PG8_BAR; PG8_SCHED;
            PG8_LDB(B1, 1, 1); PG8_STAGE(PG8_SB(1, 0), b3, voffB);
            PG8_BAR; PG8_WAIT_L(0); PG8_MMA(0, 1, At, B1); PG8_BAR;
            PG8_LDA(At, 1, 1); PG8_STAGE(PG8_SA(1, 0), a3, voffA);
            PG8_BAR; PG8_WAIT_L(0); PG8_MMA(1, 0, At, B0); PG8_BAR; PG8_SCHED;
            PG8_STAGE(PG8_SB(1, 1), b3 + hstep, voffB);
            PG8_WAIT_V(6); PG8_BAR; PG8_MMA(1, 1, At, B1); PG8_BAR;
            }
        }
        if constexpr (ALIGN_EPI) { if (wr == 0) PG8_BAR; }
        if constexpr (!Epi::AFTER_DRAIN) { E(acc, cur, wr, wc, fr, fq); S.done(cur); }
        if (!has_next) break;
#pragma unroll
        for (int a = 0; a < 2; ++a)
#pragma unroll
            for (int b = 0; b < 2; ++b)
#pragma unroll
                for (int m = 0; m < 4; ++m)
#pragma unroll
                    for (int n = 0; n < 2; ++n) acc[a][b][m][n] = (f32x4){0.f, 0.f, 0.f, 0.f};
        cur = nxt; cA = nA; cB = nB; ++ui;
        if constexpr (ALIGN_EPI) { if (wr == 1) PG8_BAR; }
    }
    PG8_WAIT_V(0);
    if constexpr (!ALIGN_EPI) { if (wr == 0) PG8_BAR; }
    PG8_BAR;
    if constexpr (Epi::AFTER_DRAIN) { E.fused(acc, cur, wr, wc, fr, fq, lds, wid, lane); S.done(cur); }
#undef PG8_SA
#undef PG8_SB
#undef PG8_STAGE
#undef PG8_LDA
#undef PG8_LDB
#undef PG8_MMA
#undef PG8_WAIT_V
#undef PG8_WAIT_L
#undef PG8_BAR
#undef PG8_SCHED
}
}

#define LAS __attribute__((address_space(3)))
typedef unsigned short bf16_t;
typedef short bf16x8 __attribute__((ext_vector_type(8)));
typedef float f32x4 __attribute__((ext_vector_type(4)));
typedef unsigned u32x4 __attribute__((ext_vector_type(4)));
typedef unsigned u32x2 __attribute__((ext_vector_type(2)));
typedef float f32x2_t __attribute__((ext_vector_type(2)));
typedef __bf16 bf16x2_t __attribute__((ext_vector_type(2)));

constexpr int SEQ = 8192, NB = 2, M = NB * SEQ, D = 1024, NPROJ = 3072, NIN = 2832, DFF = 2816, NMOD = 6144;
constexpr float EPS = 1e-6f;
constexpr int NTHREADS = 512, NWAVES = 8;
constexpr int LDS_BYTES = 155648;
constexpr int NPHASES = 11;

constexpr size_t MiB = 1u << 20;
constexpr size_t WS_MOD = 0;
constexpr size_t WS_SC = 256 * 1024;
constexpr size_t WS_MPREV = 320 * 1024;
constexpr size_t WS_ATTSS = 384 * 1024;
constexpr size_t WS_SS2 = 640 * 1024;
constexpr size_t WS_SS3 = 704 * 1024;
constexpr size_t WS_BAR = 512 * 1024;
constexpr size_t WS_CNT = 512 * 1024 + 16384;
constexpr size_t WS_GATES = 1 * MiB;
constexpr size_t WS_GV = 2 * MiB;
constexpr size_t WS_NC = 3 * MiB;
constexpr size_t WS_NPREV = 4 * MiB;
constexpr size_t WS_WIN = 6 * MiB;
constexpr size_t WS_WOUT = 12 * MiB;
constexpr size_t WS_WFI = 14 * MiB;
constexpr size_t WS_WFO = 25 * MiB;
constexpr size_t WS_PROJ = 32 * MiB;
constexpr size_t WS_QM = 128 * MiB;
constexpr size_t WS_KM = 144 * MiB;
constexpr size_t WS_XN = 160 * MiB;
constexpr size_t WS_A2 = 192 * MiB;
constexpr size_t WS_END = 224 * MiB;

struct Params {
    const float *x, *c, *w_mod, *b_mod, *g_norm1, *w_in, *conv_w, *conv_b, *b_gates, *sink, *g_attn_out, *g_mlstm_out, *w_out, *g_norm2, *w_ffn_in, *w_ffn_out, *g_final;
    float* out; unsigned char* ws; int ph_lo, ph_hi;
};

__device__ __forceinline__ float bf2f(unsigned h) { return __uint_as_float(h << 16); }
__device__ __forceinline__ unsigned pk2(float lo, float hi) { f32x2_t v = {lo, hi}; bf16x2_t b = __builtin_convertvector(v, bf16x2_t); return __builtin_bit_cast(unsigned, b); }
__device__ __forceinline__ float wave_sum(float v) {
#pragma unroll
    for (int o = 1; o < 64; o <<= 1) v += __shfl_xor(v, o);
    return v;
}
__device__ __forceinline__ float quad_sum(float v) { v += __shfl_xor(v, 16); v += __shfl_xor(v, 32); return v; }
__device__ __forceinline__ float quad_max(float v) { v = fmaxf(v, __shfl_xor(v, 16)); v = fmaxf(v, __shfl_xor(v, 32)); return v; }
__device__ __forceinline__ float silu_f(float v) { return v * __builtin_amdgcn_rcpf(1.0f + __expf(-v)); }
__device__ __forceinline__ float sigmoid_f(float v) { return __builtin_amdgcn_rcpf(1.0f + __expf(-v)); }
__device__ __forceinline__ float logsig_f(float f) { return fminf(f, 0.f) - log1pf(expf(-fabsf(f))); }
__device__ __forceinline__ f32x4 mfma16(bf16x8 a, bf16x8 b, f32x4 c) { return __builtin_amdgcn_mfma_f32_16x16x32_bf16(a, b, c, 0, 0, 0); }
__device__ __forceinline__ bf16x8 mk8(unsigned a, unsigned b, unsigned c, unsigned d) { u32x4 v = {a, b, c, d}; return __builtin_bit_cast(bf16x8, v); }

struct EpiProj {
    static constexpr bool PERM = true, AFTER_DRAIN = false;
    bf16_t* O; float* gates; const float* b_gates;
    __device__ __forceinline__ void operator()(const f32x4 (&acc)[2][2][4][2], const pg8::Unit& u, int wr, int wc, int fr, int fq) const {
        const int row0 = u.pm * 256 + wr * 64 + fr; const int col0 = u.pn * 256 + wc * 32 + 8 * fq;
        if (u.pn != 11)
#pragma unroll
        for (int ai = 0; ai < 2; ++ai)
#pragma unroll
            for (int m = 0; m < 4; ++m) { bf16_t* rowp = O + (size_t)(row0 + ai * 128 + m * 16) * NPROJ + col0;
#pragma unroll
                for (int bj = 0; bj < 2; ++bj) { const f32x4 v0 = acc[ai][bj][m][0], v1 = acc[ai][bj][m][1];
                    u32x4 w; w.x = pk2(v0[0], v0[1]); w.y = pk2(v0[2], v0[3]); w.z = pk2(v1[0], v1[1]); w.w = pk2(v1[2], v1[3]);
                    *(u32x4*)(rowp + bj * 128) = w; } }
        if (u.pn == 11 && wc == 0 && fq < 2) {
            const f32x4 b0 = *(const f32x4*)(b_gates + 8 * fq), b1 = *(const f32x4*)(b_gates + 8 * fq + 4);
#pragma unroll
            for (int ai = 0; ai < 2; ++ai)
#pragma unroll
                for (int m = 0; m < 4; ++m) { float* gp = gates + (size_t)(row0 + ai * 128 + m * 16) * 16 + 8 * fq;
                    *(f32x4*)gp = acc[ai][0][m][0] + b0; *(f32x4*)(gp + 4) = acc[ai][0][m][1] + b1; }
        }
    }
};
struct EpiResid {
    static constexpr bool PERM = false, AFTER_DRAIN = false;
    const float* base; float* out; const float* gate;
    const float* rowss;
    __device__ __forceinline__ void operator()(const f32x4 (&acc)[2][2][4][2], const pg8::Unit& u, int wr, int wc, int fr, int fq) const {
        const int col0 = u.pn * 256 + wc * 32 + 4 * fq; const int b = u.pm >> 5;
        float rs[2][4];
#pragma unroll
        for (int ai = 0; ai < 2; ++ai)
#pragma unroll
            for (int m = 0; m < 4; ++m) rs[ai][m] = rowss ? rsqrtf(rowss[u.pm * 256 + ai * 128 + wr * 64 + m * 16 + fr] * (1.0f / 512.0f) + EPS) : 1.0f;
#pragma unroll
        for (int bj = 0; bj < 2; ++bj)
#pragma unroll
            for (int n = 0; n < 2; ++n) { const f32x4 g = *(const f32x4*)(gate + b * NMOD + col0 + bj * 128 + n * 16);
#pragma unroll
                for (int ai = 0; ai < 2; ++ai)
#pragma unroll
                    for (int m = 0; m < 4; ++m) { const size_t off = (size_t)(u.pm * 256 + ai * 128 + wr * 64 + m * 16 + fr) * D + col0 + bj * 128 + n * 16;
                        const f32x4 bs = *(const f32x4*)(base + off); *(f32x4*)(out + off) = bs + (g * rs[ai][m]) * acc[ai][bj][m][n]; } }
    }
};
struct EpiResidNorm {
    static constexpr bool PERM = false, AFTER_DRAIN = true;
    const float* base; float* out; const float* gate; const float* rowss;
    float* SS; unsigned* CNT; const float* gcol; const float* mod_scale; const float* mod_shift; bf16_t* XN;
    const bf16_t* base_bf; bf16_t* x1_bf;
    __device__ __forceinline__ void fused(f32x4 (&acc)[2][2][4][2], const pg8::Unit& u, int wr, int wc, int fr, int fq, PG8_LAS unsigned char* lds, int wid, int lane) const {
        const int col0 = u.pn * 256 + wc * 32 + 4 * fq; const int b = u.pm >> 5; const int rowb = u.pm * 256 + wr * 64 + fr;
        f32x4 gq[2][2];
#pragma unroll
        for (int bj = 0; bj < 2; ++bj)
#pragma unroll
            for (int n = 0; n < 2; ++n) gq[bj][n] = *(const f32x4*)(gate + b * NMOD + col0 + bj * 128 + n * 16);
#pragma unroll
        for (int ai = 0; ai < 2; ++ai)
#pragma unroll
            for (int mp = 0; mp < 2; ++mp) {
                f32x4 bs[2][2][2]; float rsv[2];
#pragma unroll
                for (int mi = 0; mi < 2; ++mi) { const int row = rowb + ai * 128 + (mp * 2 + mi) * 16; rsv[mi] = rowss ? rowss[row] : 0.f;
#pragma unroll
                    for (int bj = 0; bj < 2; ++bj)
#pragma unroll
                        for (int n = 0; n < 2; ++n) { const unsigned off = (unsigned)(row * D + col0 + bj * 128 + n * 16);
                            if (base_bf) { const u32x2 q = *(const u32x2*)(base_bf + off); bs[mi][bj][n] = (f32x4){bf2f(q.x & 0xffffu), bf2f(q.x >> 16), bf2f(q.y & 0xffffu), bf2f(q.y >> 16)}; }
                            else bs[mi][bj][n] = *(const f32x4*)(base + off); } }
#pragma unroll
                for (int mi = 0; mi < 2; ++mi) { const int m = mp * 2 + mi; const int row = rowb + ai * 128 + m * 16;
                    const float rs1 = rowss ? rsqrtf(rsv[mi] * (1.0f / 512.0f) + EPS) : 1.0f; float ssp = 0.f;
#pragma unroll
                    for (int bj = 0; bj < 2; ++bj)
#pragma unroll
                        for (int n = 0; n < 2; ++n) { const f32x4 v = bs[mi][bj][n] + (gq[bj][n] * rs1) * acc[ai][bj][m][n]; acc[ai][bj][m][n] = v;
                            ssp += (v[0] * v[0] + v[1] * v[1]) + (v[2] * v[2] + v[3] * v[3]);
                            asm volatile("" : "+v"(acc[ai][bj][m][n])); }
                    const float sq = quad_sum(ssp); if (fq == 0) __hip_atomic_fetch_add(SS + row, sq, __ATOMIC_RELAXED, __HIP_MEMORY_SCOPE_AGENT); }
                asm volatile("" ::: "memory"); }
        asm volatile("s_waitcnt vmcnt(0)" ::: "memory");
        __syncthreads();
        if (threadIdx.x == 0) { unsigned* cp = CNT + u.pm * 16;
            __builtin_amdgcn_fence(__ATOMIC_RELEASE, "agent");
            __hip_atomic_fetch_add(cp, 1u, __ATOMIC_RELAXED, __HIP_MEMORY_SCOPE_AGENT);
            unsigned spins = 0;
            while (__hip_atomic_load(cp, __ATOMIC_RELAXED, __HIP_MEMORY_SCOPE_AGENT) < 4u && ++spins < (1u << 22)) __builtin_amdgcn_s_sleep(1);
            __builtin_amdgcn_fence(__ATOMIC_ACQUIRE, "agent"); }
        __syncthreads();
        int rowc = rowb; asm volatile("" : "+v"(rowc));
        float rstd[2][4];
#pragma unroll
        for (int ai = 0; ai < 2; ++ai)
#pragma unroll
            for (int m = 0; m < 4; ++m) rstd[ai][m] = rsqrtf(__hip_atomic_load(SS + rowc + ai * 128 + m * 16, __ATOMIC_RELAXED, __HIP_MEMORY_SCOPE_AGENT) * (1.0f / D) + EPS);
#pragma unroll
        for (int bj = 0; bj < 2; ++bj)
#pragma unroll
            for (int n = 0; n < 2; ++n) { const int col = col0 + bj * 128 + n * 16; f32x4 gc = *(const f32x4*)(gcol + col); f32x4 sh = {0.f, 0.f, 0.f, 0.f};
                if (XN) { gc = gc * (1.0f + *(const f32x4*)(mod_scale + b * NMOD + col)); sh = *(const f32x4*)(mod_shift + b * NMOD + col); }
#pragma unroll
                for (int ai = 0; ai < 2; ++ai)
#pragma unroll
                    for (int m = 0; m < 4; ++m) { const unsigned off = (unsigned)((rowc + ai * 128 + m * 16) * D + col); const f32x4 v = acc[ai][bj][m][n] * rstd[ai][m] * gc + sh;
                        if (XN) { { const f32x4 a = acc[ai][bj][m][n]; u32x2 q; q.x = pk2(a[0], a[1]); q.y = pk2(a[2], a[3]); *(u32x2*)(x1_bf + off) = q; } u32x2 w; w.x = pk2(v[0], v[1]); w.y = pk2(v[2], v[3]); *(u32x2*)(XN + off) = w; } else *(f32x4*)(out + off) = v; } }
    }
};
struct EpiSwiglu {
    static constexpr bool PERM = true, AFTER_DRAIN = false;
    bf16_t* O;
    __device__ __forceinline__ void operator()(const f32x4 (&acc)[2][2][4][2], const pg8::Unit& u, int wr, int wc, int fr, int fq) const {
        const int row0 = u.pm * 256 + wr * 64 + fr; const int col0 = u.pn * 128 + wc * 32 + 8 * fq;
#pragma unroll
        for (int ai = 0; ai < 2; ++ai)
#pragma unroll
            for (int m = 0; m < 4; ++m) { float r[8];
#pragma unroll
                for (int n = 0; n < 2; ++n)
#pragma unroll
                    for (int e = 0; e < 4; ++e) { const float g = acc[ai][0][m][n][e], up = acc[ai][1][m][n][e]; r[n * 4 + e] = silu_f(g) * up; }
                u32x4 w; w.x = pk2(r[0], r[1]); w.y = pk2(r[2], r[3]); w.z = pk2(r[4], r[5]); w.w = pk2(r[6], r[7]);
                *(u32x4*)(O + (size_t)(row0 + ai * 128 + m * 16) * DFF + col0) = w; }
    }
};

__device__ __forceinline__ void transpose_item(const float* W, int K, int N, bf16_t* WT, int drow0, int k0, int n0, LAS float* scr, int lane) {
    const int kr = lane >> 3, nq = (lane & 7) * 4; f32x4 v[8];
#pragma unroll
    for (int i = 0; i < 8; ++i) { const f32x4 z = {0.f, 0.f, 0.f, 0.f}; v[i] = (n0 + nq < N) ? __builtin_nontemporal_load((const f32x4*)(W + (size_t)(k0 + kr + 8 * i) * N + n0 + nq)) : z; }
#pragma unroll
    for (int i = 0; i < 8; ++i) { LAS float* d = scr + (kr + 8 * i) * 33 + nq; d[0] = v[i][0]; d[1] = v[i][1]; d[2] = v[i][2]; d[3] = v[i][3]; }
    const int c = lane & 7;
#pragma unroll
    for (int j = 0; j < 4; ++j) { const int n = (lane >> 3) + 8 * j; const LAS float* s = scr + (8 * c) * 33 + n;
        u32x4 o; o.x = pk2(s[0 * 33], s[1 * 33]); o.y = pk2(s[2 * 33], s[3 * 33]); o.z = pk2(s[4 * 33], s[5 * 33]); o.w = pk2(s[6 * 33], s[7 * 33]);
        *(u32x4*)(WT + (size_t)(drow0 + n) * K + k0 + 8 * c) = o; }
}

__device__ __forceinline__ void phase0(const Params& P, LAS unsigned char* lds, int tid, int wave, int lane) {
    unsigned char* ws = P.ws;
    float* MOD = (float*)(ws + WS_MOD);
    LAS float* red = (LAS float*)(lds + 81920);
    for (int item = blockIdx.x; item < NMOD / 32; item += gridDim.x) {
        const int col0 = item * 32 + (lane & 7) * 4; const int r = lane >> 3;
        f32x4 a0 = {0.f, 0.f, 0.f, 0.f}, a1 = {0.f, 0.f, 0.f, 0.f};
#pragma unroll 4
        for (int i = 0; i < 16; ++i) { const int k = wave * 128 + r + 8 * i; const f32x4 w = __builtin_nontemporal_load((const f32x4*)(P.w_mod + (size_t)k * NMOD + col0));
            const float s0 = silu_f(P.c[k]), s1 = silu_f(P.c[D + k]); a0 += s0 * w; a1 += s1 * w; }
#pragma unroll
        for (int e = 0; e < 4; ++e) {
#pragma unroll
            for (int o = 8; o < 64; o <<= 1) { a0[e] += __shfl_xor(a0[e], o); a1[e] += __shfl_xor(a1[e], o); } }
        if (lane < 8) {
#pragma unroll
            for (int e = 0; e < 4; ++e) { red[(wave * 8 + lane) * 8 + e] = a0[e]; red[(wave * 8 + lane) * 8 + 4 + e] = a1[e]; } }
        __syncthreads();
        if (tid < 64) { const int q = tid >> 3, e = tid & 7; float s = 0.f;
#pragma unroll
            for (int w = 0; w < 8; ++w) s += red[(w * 8 + q) * 8 + e];
            const int b = e >> 2, col = item * 32 + q * 4 + (e & 3); MOD[b * NMOD + col] = s + P.b_mod[col]; }
        __syncthreads();
    }
    LAS float* scr = (LAS float*)(lds + wave * 8704);
    const int gw = blockIdx.x * NWAVES + wave, NGW = gridDim.x * NWAVES;
    bf16_t* WIN = (bf16_t*)(ws + WS_WIN); bf16_t* WOUT = (bf16_t*)(ws + WS_WOUT); bf16_t* WFI = (bf16_t*)(ws + WS_WFI); bf16_t* WFO = (bf16_t*)(ws + WS_WFO);
    constexpr int NB_IN = 88, I_IN = 16 * NB_IN, I_OUT = 16 * 32, I_FI = 16 * 176, I_FO = 44 * 32;
    if ((int)gridDim.x > NMOD / 32) { const int xw = ((int)blockIdx.x - NMOD / 32) * NWAVES + wave; if (xw >= 0 && xw < 16) transpose_item(P.w_in, D, NIN, WIN, 88 * 32, xw * 64, 88 * 32, scr, lane); }
    else if (gw < 16) transpose_item(P.w_in, D, NIN, WIN, 88 * 32, gw * 64, 88 * 32, scr, lane);
    for (int it = gw; it < I_IN + I_OUT + I_FI + I_FO; it += NGW) {
        int r = it;
        if (r < I_IN) { const int kb = r / NB_IN, nb = r % NB_IN; transpose_item(P.w_in, D, NIN, WIN, nb * 32, kb * 64, nb * 32, scr, lane); continue; } r -= I_IN;
        if (r < I_OUT) { const int kb = r / 32, nb = r % 32; transpose_item(P.w_out, D, D, WOUT, nb * 32, kb * 64, nb * 32, scr, lane); continue; } r -= I_OUT;
        if (r < I_FI) { const int kb = r / 176, nb = r % 176; const int n0 = nb * 32; const int np = n0 < DFF ? n0 : n0 - DFF;
            const int drow0 = (np / 128) * 256 + (n0 < DFF ? 0 : 128) + (np % 128);
            transpose_item(P.w_ffn_in, D, 2 * DFF, WFI, drow0, kb * 64, n0, scr, lane); continue; } r -= I_FI;
        { const int kb = r / 32, nb = r % 32; transpose_item(P.w_ffn_out, DFF, D, WFO, nb * 32, kb * 64, nb * 32, scr, lane); }
    }
}

__device__ __forceinline__ void norm_mod_phase(const float* X, const float* g, const float* MOD, int shift_off, int scale_off, bf16_t* XN, int wave, int lane) {
    const int gw = blockIdx.x * NWAVES + wave, NGW = gridDim.x * NWAVES;
    int curb = -1; f32x4 A[4], B[4];
    for (int m = gw; m < M; m += 2 * NGW) {
        const int b = m >> 13; const int m2 = m + NGW;
        if (b != curb) { curb = b;
#pragma unroll
            for (int j = 0; j < 4; ++j) { const int col = 4 * lane + 256 * j; const f32x4 gv = *(const f32x4*)(g + col), sc = *(const f32x4*)(MOD + b * NMOD + scale_off + col);
                A[j] = gv * (1.0f + sc); B[j] = *(const f32x4*)(MOD + b * NMOD + shift_off + col); } }
        f32x4 v[4], w[4]; float ss = 0.f, ss2 = 0.f;
#pragma unroll
        for (int j = 0; j < 4; ++j) { v[j] = *(const f32x4*)(X + (size_t)m * D + 4 * lane + 256 * j); w[j] = *(const f32x4*)(X + (size_t)m2 * D + 4 * lane + 256 * j); }
#pragma unroll
        for (int j = 0; j < 4; ++j) { ss += (v[j][0] * v[j][0] + v[j][1] * v[j][1]) + (v[j][2] * v[j][2] + v[j][3] * v[j][3]); ss2 += (w[j][0] * w[j][0] + w[j][1] * w[j][1]) + (w[j][2] * w[j][2] + w[j][3] * w[j][3]); }
        const float rstd = rsqrtf(wave_sum(ss) * (1.0f / D) + EPS), rstd2 = rsqrtf(wave_sum(ss2) * (1.0f / D) + EPS);
#pragma unroll
        for (int j = 0; j < 4; ++j) { const f32x4 o = v[j] * rstd * A[j] + B[j]; u32x2 p; p.x = pk2(o[0], o[1]); p.y = pk2(o[2], o[3]);
            *(u32x2*)(XN + (size_t)m * D + 4 * lane + 256 * j) = p;
            const f32x4 o2 = w[j] * rstd2 * A[j] + B[j]; u32x2 p2; p2.x = pk2(o2[0], o2[1]); p2.y = pk2(o2[2], o2[3]);
            *(u32x2*)(XN + (size_t)m2 * D + 4 * lane + 256 * j) = p2; }
    }
}
__device__ __forceinline__ void final_norm_phase(float* X, const float* g, int wave, int lane) {
    const int gw = blockIdx.x * NWAVES + wave, NGW = gridDim.x * NWAVES;
    f32x4 A[4];
#pragma unroll
    for (int j = 0; j < 4; ++j) A[j] = *(const f32x4*)(g + 4 * lane + 256 * j);
    for (int m = gw; m < M; m += NGW) {
        f32x4 v[4]; float ss = 0.f;
#pragma unroll
        for (int j = 0; j < 4; ++j) { v[j] = *(const f32x4*)(X + (size_t)m * D + 4 * lane + 256 * j); ss += (v[j][0] * v[j][0] + v[j][1] * v[j][1]) + (v[j][2] * v[j][2] + v[j][3] * v[j][3]); }
        const float rstd = rsqrtf(wave_sum(ss) * (1.0f / D) + EPS);
#pragma unroll
        for (int j = 0; j < 4; ++j) *(f32x4*)(X + (size_t)m * D + 4 * lane + 256 * j) = v[j] * rstd * A[j];
    }
}

typedef short v4i16_t __attribute__((ext_vector_type(4)));
__device__ __forceinline__ u32x2 tr_read(const LAS bf16_t* p) { return __builtin_bit_cast(u32x2, __builtin_amdgcn_ds_read_tr16_b64_v4i16((LAS v4i16_t*)p)); }

constexpr float ATT_C1 = 0.125f * 1.4426950408889634f;
template <bool MASK, int KT_LO, int KT_HI>
__device__ __forceinline__ void attn_chunk(const int kc, const LAS bf16_t* Ks, const LAS bf16_t* Vs, bf16x8 (&qf)[2][2], f32x4 (&o)[4][2], float (&m_run)[2], float (&l_run)[2],
                                           const float fbase, const float sl8, const int fr, const int fq, const int troff, const bool q_reload, const bf16_t* qnext) {
    f32x4 s[4][2];
    float fb = fbase; asm volatile("" : "+v"(fb));
#pragma unroll
    for (int kt = KT_LO; kt < KT_HI; ++kt) { const LAS bf16_t* kp = Ks + (kc * 64 + kt * 16 + fr) * 72 + fq * 8;
        const bf16x8 a0 = *(const LAS bf16x8*)kp, a1 = *(const LAS bf16x8*)(kp + 32);
#pragma unroll
        for (int qt = 0; qt < 2; ++qt) { const f32x4 z = {0.f, 0.f, 0.f, 0.f}; s[kt][qt] = mfma16(a1, qf[qt][1], mfma16(a0, qf[qt][0], z)); } }
    if (q_reload) {
#pragma unroll
        for (int qt = 0; qt < 2; ++qt)
#pragma unroll
            for (int kk = 0; kk < 2; ++kk) qf[qt][kk] = *(const bf16x8*)(qnext + (size_t)qt * 16 * NPROJ + kk * 32); }
    unsigned pb[2][4][2];
#pragma unroll
    for (int qt = 0; qt < 2; ++qt) {
        float cmax = -1e30f;
#pragma unroll
        for (int kt = KT_LO; kt < KT_HI; ++kt)
#pragma unroll
            for (int i = 0; i < 4; ++i) { const float rel = fb + (float)(kc * 64 + kt * 16 + i - qt * 16); const float ar = fabsf(rel);
                float lg = fmaf(-sl8, ar, s[kt][qt][i]); if (MASK) lg = (ar <= 128.0f) ? lg : -1e30f; s[kt][qt][i] = lg; cmax = fmaxf(cmax, lg); }
        cmax = quad_max(cmax);
        const float m_new = fmaxf(m_run[qt], cmax), alpha = __builtin_amdgcn_exp2f((m_run[qt] - m_new) * ATT_C1), mc = m_new * ATT_C1; m_run[qt] = m_new;
        float psum = 0.f;
#pragma unroll
        for (int kt = KT_LO; kt < KT_HI; ++kt) { float p[4];
#pragma unroll
            for (int i = 0; i < 4; ++i) { p[i] = __builtin_amdgcn_exp2f(fmaf(s[kt][qt][i], ATT_C1, -mc)); psum += p[i]; }
            pb[qt][kt][0] = pk2(p[0], p[1]); pb[qt][kt][1] = pk2(p[2], p[3]); }
        l_run[qt] = l_run[qt] * alpha + psum;
#pragma unroll
        for (int dt = 0; dt < 4; ++dt) o[dt][qt] *= alpha;
    }
#pragma unroll
    for (int ks = KT_LO / 2; ks < KT_HI / 2; ++ks)
#pragma unroll
        for (int dt = 0; dt < 4; ++dt) { const LAS bf16_t* vp = Vs + (kc * 64 + ks * 32) * 80 + troff + dt * 16;
            const u32x2 lo = tr_read(vp), hi = tr_read(vp + 16 * 80); const bf16x8 a = mk8(lo.x, lo.y, hi.x, hi.y);
#pragma unroll
            for (int qt = 0; qt < 2; ++qt) o[dt][qt] = mfma16(a, mk8(pb[qt][2 * ks][0], pb[qt][2 * ks][1], pb[qt][2 * ks + 1][0], pb[qt][2 * ks + 1][1]), o[dt][qt]); }
}

__device__ __forceinline__ void attn_phase(const Params& P, LAS unsigned char* lds, int tid, int wave, int lane, const bool do_atomic) {
    LAS bf16_t* Ks = (LAS bf16_t*)lds;
    LAS bf16_t* Vs = (LAS bf16_t*)(lds + 46080);
    const bf16_t* PROJ = (const bf16_t*)(P.ws + WS_PROJ);
    bf16_t* A2 = (bf16_t*)(P.ws + WS_A2); float* ATTSS = (float*)(P.ws + WS_ATTSS);
    const int fr = lane & 15, fq = lane >> 4, g = wave >> 1, r = wave & 1;
    const int troff = (fq * 4 + ((lane >> 2) & 3)) * 80 + (lane & 3) * 4;
    const float fbase = (float)(fq * 4 - 128 - r * 32 - fr);
    const int G = gridDim.x;
    int u = (G % 8 == 0) ? ((int)blockIdx.x % 8) * (G / 8) + (int)blockIdx.x / 8 : (int)blockIdx.x; if (u >= NB * (SEQ / 64)) return;
    u32x4 rk[5], rv[5];
#define AT_LOADS(uu, kvh_) do { const int b_ = (uu) >> 7, t0_ = ((uu) & 127) * 64, kb_ = t0_ - 128; \
        _Pragma("unroll") for (int i = 0; i < 5; ++i) { const int cidx = tid + 512 * i, key = cidx >> 3, part = cidx & 7, tok = kb_ + key; const u32x4 z = {0u, 0u, 0u, 0u}; rk[i] = z; rv[i] = z; \
            if (tok >= 0 && tok < SEQ) { const bf16_t* rowp = PROJ + (size_t)(b_ * SEQ + tok) * NPROJ; rk[i] = *(const u32x4*)(rowp + 512 + (kvh_) * 64 + part * 8); rv[i] = *(const u32x4*)(rowp + 640 + (kvh_) * 64 + part * 8); } } \
        } while (0)
    AT_LOADS(u, 0);
    bf16x8 qf[2][2];
    { const int b0 = u >> 7, t00 = (u & 127) * 64;
#pragma unroll
      for (int qt = 0; qt < 2; ++qt)
#pragma unroll
          for (int kk = 0; kk < 2; ++kk) qf[qt][kk] = *(const bf16x8*)(PROJ + (size_t)(b0 * SEQ + t00 + r * 32 + qt * 16 + fr) * NPROJ + g * 64 + kk * 32 + fq * 8); }
    for (;;) {
        const int b = u >> 7, qb = u & 127, t0 = qb * 64;
        const int kc_lo = qb == 0 ? 2 : (qb == 1 ? 1 : 0), kc_hi = qb == 127 ? 3 : (qb == 126 ? 4 : 5);
        const int un = u + G; const bool more = un < NB * (SEQ / 64);
#pragma unroll 1
        for (int kvh = 0; kvh < 2; ++kvh) {
            __syncthreads();
#pragma unroll
            for (int i = 0; i < 5; ++i) { const int cidx = tid + 512 * i, key = cidx >> 3, part = cidx & 7; *(LAS u32x4*)(Ks + key * 72 + part * 8) = rk[i]; *(LAS u32x4*)(Vs + key * 80 + part * 8) = rv[i]; }
            __syncthreads();
            const bool qnx = (kvh == 0) || more; const int un_b = un >> 7, un_t0 = (un & 127) * 64;
            const bf16_t* qnext = (kvh == 0) ? PROJ + (size_t)(b * SEQ + t0 + r * 32 + fr) * NPROJ + (4 + g) * 64 + fq * 8
                                             : PROJ + (size_t)(un_b * SEQ + un_t0 + r * 32 + fr) * NPROJ + g * 64 + fq * 8;
            if (!qnx) qnext = PROJ;
            if (kvh == 0) { AT_LOADS(u, 1); } else if (more) { AT_LOADS(un, 0); }
            const int h = kvh * 4 + g;
            const float sl8 = 8.0f * exp2f(-(float)(h + 1));
            float m_run[2], l_run[2]; f32x4 o[4][2];
#pragma unroll
            for (int qt = 0; qt < 2; ++qt) { m_run[qt] = 8.0f * P.sink[h]; l_run[qt] = (fq == 0) ? 1.0f : 0.0f;
#pragma unroll
                for (int dt = 0; dt < 4; ++dt) o[dt][qt] = (f32x4){0.f, 0.f, 0.f, 0.f}; }
            if (r == 0) {
                if (kc_lo <= 0) attn_chunk<true, 0, 4>(0, Ks, Vs, qf, o, m_run, l_run, fbase, sl8, fr, fq, troff, qnx && (kc_hi == 1), qnext);
                if (kc_lo <= 1) attn_chunk<false, 0, 4>(1, Ks, Vs, qf, o, m_run, l_run, fbase, sl8, fr, fq, troff, qnx && (kc_hi == 2), qnext);
                attn_chunk<false, 0, 4>(2, Ks, Vs, qf, o, m_run, l_run, fbase, sl8, fr, fq, troff, qnx && (kc_hi == 3), qnext);
                if (kc_hi > 3) attn_chunk<false, 0, 4>(3, Ks, Vs, qf, o, m_run, l_run, fbase, sl8, fr, fq, troff, qnx && (kc_hi == 4), qnext);
                if (kc_hi > 4) attn_chunk<true, 0, 2>(4, Ks, Vs, qf, o, m_run, l_run, fbase, sl8, fr, fq, troff, qnx && (kc_hi == 5), qnext);
            } else {
                if (kc_lo <= 0) attn_chunk<true, 2, 4>(0, Ks, Vs, qf, o, m_run, l_run, fbase, sl8, fr, fq, troff, qnx && (kc_hi == 1), qnext);
                if (kc_lo <= 1) attn_chunk<false, 0, 4>(1, Ks, Vs, qf, o, m_run, l_run, fbase, sl8, fr, fq, troff, qnx && (kc_hi == 2), qnext);
                attn_chunk<false, 0, 4>(2, Ks, Vs, qf, o, m_run, l_run, fbase, sl8, fr, fq, troff, qnx && (kc_hi == 3), qnext);
                if (kc_hi > 3) attn_chunk<false, 0, 4>(3, Ks, Vs, qf, o, m_run, l_run, fbase, sl8, fr, fq, troff, qnx && (kc_hi == 4), qnext);
                if (kc_hi > 4) attn_chunk<true, 0, 4>(4, Ks, Vs, qf, o, m_run, l_run, fbase, sl8, fr, fq, troff, qnx && (kc_hi == 5), qnext);
            }
#pragma unroll
            for (int qt = 0; qt < 2; ++qt) { const float inv = 1.0f / quad_sum(l_run[qt]); float ss = 0.f;
                const int rr = r * 32 + qt * 16 + fr; const size_t mrow = (size_t)(b * SEQ + t0 + rr);
                bf16_t* orow = A2 + mrow * D;
#pragma unroll
                for (int dt = 0; dt < 4; ++dt) { const f32x4 v = o[dt][qt] * inv; ss += (v[0] * v[0] + v[1] * v[1]) + (v[2] * v[2] + v[3] * v[3]);
                    const int col = h * 64 + dt * 16 + fq * 4; const f32x4 gv = *(const f32x4*)(P.g_attn_out + col); const f32x4 w4 = v * gv;
                    u32x2 w; w.x = pk2(w4[0], w4[1]); w.y = pk2(w4[2], w4[3]); *(u32x2*)(orow + col) = w; }
                ss = quad_sum(ss);
                if (fq == 0 && do_atomic) __hip_atomic_fetch_add(ATTSS + mrow, ss, __ATOMIC_RELAXED, __HIP_MEMORY_SCOPE_AGENT); }
        }
        if (!more) break;
        u = un;
    }
#undef AT_LOADS
}

__device__ __forceinline__ float scan_up_add(float v, int lane) {
#pragma unroll
    for (int o = 1; o < 64; o <<= 1) { const float t = __shfl_up(v, o); v += (lane >= o) ? t : 0.f; }
    return v;
}
__device__ __forceinline__ float scan_down_add(float v, int lane) {
#pragma unroll
    for (int o = 1; o < 64; o <<= 1) { const float t = __shfl_down(v, o); v += (lane + o < 64) ? t : 0.f; }
    return v;
}
__device__ __forceinline__ float scan_up_max(float v, int lane) {
#pragma unroll
    for (int o = 1; o < 64; o <<= 1) { const float t = __shfl_up(v, o); v = (lane >= o) ? fmaxf(v, t) : v; }
    return v;
}
__device__ __forceinline__ float scan_down_max(float v, int lane) {
#pragma unroll
    for (int o = 1; o < 64; o <<= 1) { const float t = __shfl_down(v, o); v = (lane + o < 64) ? fmaxf(v, t) : v; }
    return v;
}
__device__ __forceinline__ float wave_max(float v) {
#pragma unroll
    for (int o = 1; o < 64; o <<= 1) v = fmaxf(v, __shfl_xor(v, o));
    return v;
}
__device__ __forceinline__ void conv8(const u32x4& x0, const u32x4& x1, const u32x4& x2, const float* cw, const float* cb, int ch0, float (&r8)[8]) {
#pragma unroll
    for (int e2 = 0; e2 < 2; ++e2) { const f32x4 w0 = *(const f32x4*)(cw + ch0 + 4 * e2), w1 = *(const f32x4*)(cw + 1024 + ch0 + 4 * e2), w2 = *(const f32x4*)(cw + 2048 + ch0 + 4 * e2), bb = *(const f32x4*)(cb + ch0 + 4 * e2);
#pragma unroll
        for (int e = 0; e < 4; ++e) { const int ee = e2 * 4 + e; const unsigned sh = 16 * (ee & 1);
            const float a0 = bf2f((x0[ee >> 1] >> sh) & 0xffffu), a1 = bf2f((x1[ee >> 1] >> sh) & 0xffffu), a2 = bf2f((x2[ee >> 1] >> sh) & 0xffffu);
            float v = a0 * w0[e]; v += a1 * w1[e]; v += a2 * w2[e]; v += bb[e]; r8[ee] = silu_f(v); } }
}
__device__ __forceinline__ void mstate_unit(const Params& P, LAS unsigned char* lds, int unit, int tid, int wave, int lane) {
    const int b = unit >> 8, c = (unit >> 2) & 63, h = unit & 3;
    LAS bf16_t* Kwf = (LAS bf16_t*)lds; LAS bf16_t* Kwb = (LAS bf16_t*)(lds + 36864); LAS bf16_t* Vs = (LAS bf16_t*)(lds + 73728);
    LAS float* wf = (LAS float*)(lds + 110592); LAS float* wb = wf + 128;
    unsigned char* ws = P.ws;
    const bf16_t* PROJ = (const bf16_t*)(ws + WS_PROJ); const float* GATES = (const float*)(ws + WS_GATES);
    float* GV = (float*)(ws + WS_GV); float* SC = (float*)(ws + WS_SC); float* NC = (float*)(ws + WS_NC); bf16_t* KVC = (bf16_t*)P.out;
    bf16_t* QM = (bf16_t*)(ws + WS_QM); bf16_t* KM = (bf16_t*)(ws + WS_KM);
    const size_t m0 = (size_t)b * SEQ + (size_t)c * 128;
    const int fr = lane & 15, fq = lane >> 4;
    __syncthreads();
    float gi0 = 0.f, gf0 = 0.f, gi1 = 0.f, gf1 = 0.f;
    if (wave < 2) { const float* gp = GATES + (m0 + lane) * 16 + wave * 8 + h; gi0 = gp[0]; gf0 = gp[4]; gi1 = gp[64 * 16]; gf1 = gp[64 * 16 + 4]; }
    u32x4 xk[3][3], xv[3];
#define MS_LOAD(it, j) do { const int idx = tid + 512 * (it), s = idx >> 4, part = idx & 15; const int t = c * 128 + s; const bf16_t* rowm = PROJ + (m0 + s) * NPROJ; \
        const int pk = 1280 + h * 128 + part * 8; const u32x4 z = {0u, 0u, 0u, 0u}; \
        xk[j][1] = *(const u32x4*)(rowm + pk); xv[j] = *(const u32x4*)(rowm + 1792 + h * 128 + part * 8); \
        xk[j][0] = z; xk[j][2] = z; \
        if (t > 0) { xk[j][0] = *(const u32x4*)(rowm - NPROJ + pk); } \
        if (t < SEQ - 1) { xk[j][2] = *(const u32x4*)(rowm + NPROJ + pk); } } while (0)
    MS_LOAD(0, 0); MS_LOAD(1, 1);
    if (wave < 2) {
        const float l0 = logsig_f(gf0), l1 = logsig_f(gf1); float p0, p1, tot;
        if (wave == 0) { p0 = scan_up_add(l0, lane); const float t0 = __shfl(p0, 63); p1 = scan_up_add(l1, lane) + t0; tot = __shfl(p1, 63); }
        else { p1 = scan_down_add(l1, lane); const float t1 = __shfl(p1, 0); p0 = scan_down_add(l0, lane) + t1; tot = __shfl(p0, 0); }
        const float u0 = gi0 - p0, u1 = gi1 - p1; const float umax = wave_max(fmaxf(u0, u1));
        LAS float* wv = wave ? wb : wf; wv[lane] = __expf(u0 - umax); wv[64 + lane] = __expf(u1 - umax);
        float* gv = GV + (size_t)unit * 512 + wave * 128; gv[lane] = u0; gv[64 + lane] = u1; gv[256 + lane] = p0; gv[256 + 64 + lane] = p1;
        if (lane == 0) { float* sc = SC + unit * 4 + wave * 2; sc[0] = tot; sc[1] = tot + umax; }
    }
    __syncthreads();
#define MS_COMPUTE(it, j) do { const int idx = tid + 512 * (it), s = idx >> 4, part = idx & 15; const float wfs = wf[s], wbs = wb[s]; float r8[8]; \
        conv8(xk[j][0], xk[j][1], xk[j][2], P.conv_w, P.conv_b, 512 + h * 128 + part * 8, r8); \
        { u32x4 w; w.x = pk2(r8[0], r8[1]); w.y = pk2(r8[2], r8[3]); w.z = pk2(r8[4], r8[5]); w.w = pk2(r8[6], r8[7]); *(u32x4*)(KM + (m0 + s) * 512 + h * 128 + part * 8) = w; \
          u32x4 a; a.x = pk2(r8[0] * wfs, r8[1] * wfs); a.y = pk2(r8[2] * wfs, r8[3] * wfs); a.z = pk2(r8[4] * wfs, r8[5] * wfs); a.w = pk2(r8[6] * wfs, r8[7] * wfs); *(LAS u32x4*)(Kwf + s * 144 + part * 8) = a; \
          u32x4 bq; bq.x = pk2(r8[0] * wbs, r8[1] * wbs); bq.y = pk2(r8[2] * wbs, r8[3] * wbs); bq.z = pk2(r8[4] * wbs, r8[5] * wbs); bq.w = pk2(r8[6] * wbs, r8[7] * wbs); *(LAS u32x4*)(Kwb + s * 144 + part * 8) = bq; } \
        *(LAS u32x4*)(Vs + s * 144 + part * 8) = xv[j]; } while (0)
    MS_LOAD(2, 2); MS_COMPUTE(0, 0);
    MS_LOAD(3, 0); MS_COMPUTE(1, 1);
    MS_COMPUTE(2, 2); MS_COMPUTE(3, 0);
#undef MS_LOAD
#undef MS_COMPUTE
    __syncthreads();
    {
        const int dir = wave >> 2, wq = wave & 3, vt0 = wq * 2; const LAS bf16_t* Kw = dir ? Kwb : Kwf;
        const int troff = (fq * 4 + ((lane >> 2) & 3)) * 144 + (lane & 3) * 4;
        const unsigned onev = (fr == 0) ? 0x3f803f80u : 0u; const bf16x8 ones = mk8(onev, onev, onev, onev);
        f32x4 acc[2][8], nacc[2];
#pragma unroll
        for (int vi = 0; vi < 2; ++vi) { nacc[vi] = (f32x4){0.f, 0.f, 0.f, 0.f};
#pragma unroll
            for (int kt = 0; kt < 8; ++kt) acc[vi][kt] = (f32x4){0.f, 0.f, 0.f, 0.f}; }
#pragma unroll
        for (int ks = 0; ks < 4; ++ks) { const LAS bf16_t* vp = Vs + ks * 32 * 144 + troff + vt0 * 16; const LAS bf16_t* kp = Kw + ks * 32 * 144 + troff;
            const u32x2 l0 = tr_read(vp), h0 = tr_read(vp + 16 * 144), l1 = tr_read(vp + 16), h1 = tr_read(vp + 16 * 144 + 16);
            const bf16x8 a0 = mk8(l0.x, l0.y, h0.x, h0.y), a1 = mk8(l1.x, l1.y, h1.x, h1.y);
#pragma unroll
            for (int kt = 0; kt < 8; ++kt) { const u32x2 bl = tr_read(kp + kt * 16), bh = tr_read(kp + 16 * 144 + kt * 16); const bf16x8 bb = mk8(bl.x, bl.y, bh.x, bh.y);
                acc[0][kt] = mfma16(a0, bb, acc[0][kt]); acc[1][kt] = mfma16(a1, bb, acc[1][kt]);
                if ((kt >> 1) == wq) nacc[kt & 1] = mfma16(ones, bb, nacc[kt & 1]); } }
        bf16_t* outp = KVC + (size_t)(unit * 2 + dir) * 16384;
#pragma unroll
        for (int vi = 0; vi < 2; ++vi)
#pragma unroll
            for (int kt = 0; kt < 8; ++kt)
#pragma unroll
                for (int i = 0; i < 4; i += 2) { const unsigned pq = pk2(acc[vi][kt][i], acc[vi][kt][i + 1]);
                    outp[((vt0 + vi) * 16 + fq * 4 + i) * 128 + kt * 16 + fr] = (bf16_t)(pq & 0xffffu); outp[((vt0 + vi) * 16 + fq * 4 + i + 1) * 128 + kt * 16 + fr] = (bf16_t)(pq >> 16); }
        if (fq == 0) { float* np = NC + (size_t)(unit * 2 + dir) * 128 + wq * 32 + fr; np[0] = nacc[0][0]; np[16] = nacc[1][0]; }
    }
}

__device__ __forceinline__ void mstate_pair(const Params& P, LAS unsigned char* lds, int uA, int uB, int tid, int wave, int lane) {
    const int grp = wave >> 2, wv = wave & 3, tg = tid & 255;
    const int unit = grp ? uB : uA;
    const int b = unit >> 8, c = (unit >> 2) & 63, h = unit & 3;
    LAS unsigned char* gl = lds + grp * 75776;
    LAS bf16_t* Kr = (LAS bf16_t*)gl; LAS bf16_t* Vs = (LAS bf16_t*)(gl + 36864);
    LAS float* wf = (LAS float*)(gl + 73728); LAS float* wb = wf + 128;
    unsigned char* ws = P.ws;
    const bf16_t* PROJ = (const bf16_t*)(ws + WS_PROJ); const float* GATES = (const float*)(ws + WS_GATES);
    float* GV = (float*)(ws + WS_GV); float* SC = (float*)(ws + WS_SC); float* NC = (float*)(ws + WS_NC); bf16_t* KVC = (bf16_t*)P.out;
    bf16_t* KM = (bf16_t*)(ws + WS_KM);
    const size_t m0 = (size_t)b * SEQ + (size_t)c * 128;
    const int fr = lane & 15, fq = lane >> 4;
    __syncthreads();
    float gi0 = 0.f, gf0 = 0.f, gi1 = 0.f, gf1 = 0.f;
    if (wv < 2) { const float* gp = GATES + (m0 + lane) * 16 + wv * 8 + h; gi0 = gp[0]; gf0 = gp[4]; gi1 = gp[64 * 16]; gf1 = gp[64 * 16 + 4]; }
    u32x4 xk[3][3], xv[3];
#define MP_LOAD(it, j) do { const int idx = tg + 256 * (it), s = idx >> 4, part = idx & 15; const int t = c * 128 + s; const bf16_t* rowm = PROJ + (m0 + s) * NPROJ; \
        const int pk = 1280 + h * 128 + part * 8; const u32x4 z = {0u, 0u, 0u, 0u}; \
        xk[j][1] = *(const u32x4*)(rowm + pk); xv[j] = *(const u32x4*)(rowm + 1792 + h * 128 + part * 8); \
        xk[j][0] = z; xk[j][2] = z; \
        if (t > 0) { xk[j][0] = *(const u32x4*)(rowm - NPROJ + pk); } \
        if (t < SEQ - 1) { xk[j][2] = *(const u32x4*)(rowm + NPROJ + pk); } } while (0)
#define MP_COMPUTE(it, j) do { const int idx = tg + 256 * (it), s = idx >> 4, part = idx & 15; float r8[8]; \
        conv8(xk[j][0], xk[j][1], xk[j][2], P.conv_w, P.conv_b, 512 + h * 128 + part * 8, r8); \
        { u32x4 w; w.x = pk2(r8[0], r8[1]); w.y = pk2(r8[2], r8[3]); w.z = pk2(r8[4], r8[5]); w.w = pk2(r8[6], r8[7]); *(u32x4*)(KM + (m0 + s) * 512 + h * 128 + part * 8) = w; \
          *(LAS u32x4*)(Kr + s * 144 + part * 8) = w; } \
        *(LAS u32x4*)(Vs + s * 144 + part * 8) = xv[j]; } while (0)
    MP_LOAD(0, 0); MP_LOAD(1, 1);
    if (wv < 2) {
        const float l0 = logsig_f(gf0), l1 = logsig_f(gf1); float p0, p1, tot;
        if (wv == 0) { p0 = scan_up_add(l0, lane); const float t0 = __shfl(p0, 63); p1 = scan_up_add(l1, lane) + t0; tot = __shfl(p1, 63); }
        else { p1 = scan_down_add(l1, lane); const float t1 = __shfl(p1, 0); p0 = scan_down_add(l0, lane) + t1; tot = __shfl(p0, 0); }
        const float u0 = gi0 - p0, u1 = gi1 - p1; const float umax = wave_max(fmaxf(u0, u1));
        LAS float* wvp = wv ? wb : wf; wvp[lane] = __expf(u0 - umax); wvp[64 + lane] = __expf(u1 - umax);
        float* gv = GV + (size_t)unit * 512 + wv * 128; gv[lane] = u0; gv[64 + lane] = u1; gv[256 + lane] = p0; gv[256 + 64 + lane] = p1;
        if (lane == 0) { float* sc = SC + unit * 4 + wv * 2; sc[0] = tot; sc[1] = tot + umax; }
    }
    MP_LOAD(2, 2); MP_COMPUTE(0, 0);
    MP_LOAD(3, 0); MP_COMPUTE(1, 1);
    MP_LOAD(4, 1); MP_COMPUTE(2, 2);
    MP_LOAD(5, 2); MP_COMPUTE(3, 0);
    MP_LOAD(6, 0); MP_COMPUTE(4, 1);
    MP_LOAD(7, 1); MP_COMPUTE(5, 2);
    MP_COMPUTE(6, 0); MP_COMPUTE(7, 1);
#undef MP_LOAD
#undef MP_COMPUTE
    __syncthreads();
    const int vt0 = wv * 2;
    const int troff = (fq * 4 + ((lane >> 2) & 3)) * 144 + (lane & 3) * 4;
#pragma unroll 1
    for (int dir = 0; dir < 2; ++dir) {
        const LAS float* wd = dir ? wb : wf;
        f32x4 acc[2][8], nacc[2];
#pragma unroll
        for (int vi = 0; vi < 2; ++vi) { nacc[vi] = (f32x4){0.f, 0.f, 0.f, 0.f};
#pragma unroll
            for (int kt = 0; kt < 8; ++kt) acc[vi][kt] = (f32x4){0.f, 0.f, 0.f, 0.f}; }
#pragma unroll
        for (int ks = 0; ks < 4; ++ks) { const LAS bf16_t* vp = Vs + ks * 32 * 144 + troff + vt0 * 16; const LAS bf16_t* kp = Kr + ks * 32 * 144 + troff;
            const f32x4 wlo = *(const LAS f32x4*)(wd + ks * 32 + fq * 4), whi = *(const LAS f32x4*)(wd + ks * 32 + 16 + fq * 4);
            bf16x8 a[2];
#pragma unroll
            for (int vi = 0; vi < 2; ++vi) { const u32x2 lo = tr_read(vp + vi * 16), hi = tr_read(vp + 16 * 144 + vi * 16);
                a[vi] = mk8(pk2(bf2f(lo.x & 0xffffu) * wlo[0], bf2f(lo.x >> 16) * wlo[1]), pk2(bf2f(lo.y & 0xffffu) * wlo[2], bf2f(lo.y >> 16) * wlo[3]),
                            pk2(bf2f(hi.x & 0xffffu) * whi[0], bf2f(hi.x >> 16) * whi[1]), pk2(bf2f(hi.y & 0xffffu) * whi[2], bf2f(hi.y >> 16) * whi[3])); }
            const bf16x8 onesw = (fr == 0) ? mk8(pk2(wlo[0], wlo[1]), pk2(wlo[2], wlo[3]), pk2(whi[0], whi[1]), pk2(whi[2], whi[3])) : mk8(0u, 0u, 0u, 0u);
#pragma unroll
            for (int kt = 0; kt < 8; ++kt) { const u32x2 bl = tr_read(kp + kt * 16), bh = tr_read(kp + 16 * 144 + kt * 16); const bf16x8 bb = mk8(bl.x, bl.y, bh.x, bh.y);
                acc[0][kt] = mfma16(a[0], bb, acc[0][kt]); acc[1][kt] = mfma16(a[1], bb, acc[1][kt]);
                if ((kt >> 1) == wv) nacc[kt & 1] = mfma16(onesw, bb, nacc[kt & 1]); } }
        bf16_t* outp = KVC + (size_t)(unit * 2 + dir) * 16384;
#pragma unroll
        for (int vi = 0; vi < 2; ++vi)
#pragma unroll
            for (int kt = 0; kt < 8; ++kt)
#pragma unroll
                for (int i = 0; i < 4; i += 2) { const unsigned pq = pk2(acc[vi][kt][i], acc[vi][kt][i + 1]);
                    outp[((vt0 + vi) * 16 + fq * 4 + i) * 128 + kt * 16 + fr] = (bf16_t)(pq & 0xffffu); outp[((vt0 + vi) * 16 + fq * 4 + i + 1) * 128 + kt * 16 + fr] = (bf16_t)(pq >> 16); }
        if (fq == 0) { float* np = NC + (size_t)(unit * 2 + dir) * 128 + wv * 32 + fr; np[0] = nacc[0][0]; np[16] = nacc[1][0]; }
    }
}

__device__ __forceinline__ void scan_phase(const Params& P, int tid) {
    unsigned char* ws = P.ws;
    const bf16_t* KVC = (const bf16_t*)P.out; const float* SC = (const float*)(ws + WS_SC); const float* NC = (const float*)(ws + WS_NC);
    bf16_t* CPREV = (bf16_t*)(ws + WS_XN); float* NPREV = (float*)(ws + WS_NPREV); float* MPREV = (float*)(ws + WS_MPREV);
    for (int blk = blockIdx.x; blk < 256; blk += gridDim.x) {
        const int seq = blk >> 4, e2 = (blk & 15) * NTHREADS + tid, b = seq >> 3, h = (seq >> 1) & 3, dir = seq & 1;
        const int off = (e2 >> 6) * 128 + (e2 & 63) * 2;
        const bool do_n = e2 < 128;
        float c0 = 0.f, c1 = 0.f, nst = 0.f, mst = 0.f;
        for (int jb = 0; jb < 64; jb += 16) {
            f32x2_t kv[16]; float bl[16], am[16], nn[16];
#pragma unroll
            for (int u = 0; u < 16; ++u) { const int j = jb + u, cidx = dir ? 63 - j : j, unit = (b * 64 + cidx) * 4 + h;
                { const unsigned pq = *(const unsigned*)(KVC + (size_t)(unit * 2 + dir) * 16384 + off); kv[u] = (f32x2_t){bf2f(pq & 0xffffu), bf2f(pq >> 16)}; }
                bl[u] = SC[unit * 4 + dir * 2]; am[u] = SC[unit * 4 + dir * 2 + 1]; nn[u] = do_n ? NC[(size_t)(unit * 2 + dir) * 128 + e2] : 0.f; }
#pragma unroll
            for (int u = 0; u < 16; ++u) { const int j = jb + u, cidx = dir ? 63 - j : j, unit = (b * 64 + cidx) * 4 + h;
                *(unsigned*)(CPREV + (size_t)(unit * 2 + dir) * 16384 + off) = pk2(c0, c1);
                if (do_n) NPREV[(size_t)(unit * 2 + dir) * 128 + e2] = nst;
                if (e2 == 0) MPREV[unit * 2 + dir] = mst;
                const float m_new = fmaxf(bl[u] + mst, am[u]); const float dec = __expf(bl[u] + mst - m_new), inj = __expf(am[u] - m_new);
                c0 = dec * c0 + inj * kv[u][0]; c1 = dec * c1 + inj * kv[u][1]; nst = dec * nst + inj * nn[u]; mst = m_new; }
        }
    }
}

__device__ __forceinline__ void mout_unit(const Params& P, LAS unsigned char* lds, int unit, int tid, int wave, int lane) {
    const int b = unit >> 8, c = (unit >> 2) & 63, h = unit & 3;
    LAS bf16_t* Ks = (LAS bf16_t*)lds;
    LAS bf16_t* Vs = (LAS bf16_t*)(lds + 34816);
    LAS bf16_t* Cf = (LAS bf16_t*)(lds + 71680);
    LAS bf16_t* Cb = (LAS bf16_t*)(lds + 106496);
    LAS float* fa = (LAS float*)(lds + 141312);
    LAS float* uf = fa; LAS float* ub = fa + 128; LAS float* Mf = fa + 256; LAS float* Mb = fa + 384; LAS float* inf_ = fa + 512; LAS float* inb = fa + 640;
    LAS float* emf = fa + 768; LAS float* emb = fa + 896; LAS float* npf = fa + 1024; LAS float* npb = fa + 1152;
    unsigned char* ws = P.ws;
    const bf16_t* PROJ = (const bf16_t*)(ws + WS_PROJ); const bf16_t* QM = (const bf16_t*)(ws + WS_QM); const bf16_t* KM = (const bf16_t*)(ws + WS_KM);
    const bf16_t* CPREV = (const bf16_t*)(ws + WS_XN); const float* NPREV = (const float*)(ws + WS_NPREV); const float* MPREV = (const float*)(ws + WS_MPREV);
    const float* GV = (const float*)(ws + WS_GV); bf16_t* A2 = (bf16_t*)(ws + WS_A2);
    const size_t m0 = (size_t)b * SEQ + (size_t)c * 128;
    const int fr = lane & 15, fq = lane >> 4;
    const int t = wave * 16 + fr;
    __syncthreads();
    u32x4 rk[4], rv[4], rcf[4], rcb[4];
#pragma unroll
    for (int it = 0; it < 4; ++it) { const int idx = tid + 512 * it, s = idx >> 4, part = idx & 15;
        rk[it] = *(const u32x4*)(KM + (m0 + s) * 512 + h * 128 + part * 8); rv[it] = *(const u32x4*)(PROJ + (m0 + s) * NPROJ + 1792 + h * 128 + part * 8);
        rcf[it] = *(const u32x4*)(CPREV + (size_t)(unit * 2) * 16384 + s * 128 + part * 8); rcb[it] = *(const u32x4*)(CPREV + (size_t)(unit * 2 + 1) * 16384 + s * 128 + part * 8); }
    u32x4 xq[4][3];
    { const int pos = c * 128 + t; const bf16_t* rowq = PROJ + (m0 + t) * NPROJ + 768 + h * 128 + fq * 8;
#pragma unroll
      for (int kk = 0; kk < 4; ++kk) { const u32x4 z = {0u, 0u, 0u, 0u}; xq[kk][1] = *(const u32x4*)(rowq + kk * 32); xq[kk][0] = z; xq[kk][2] = z;
          if (pos > 0) xq[kk][0] = *(const u32x4*)(rowq - NPROJ + kk * 32); if (pos < SEQ - 1) xq[kk][2] = *(const u32x4*)(rowq + NPROJ + kk * 32); } }
    if (wave < 2) {
        const float* gv = GV + (size_t)unit * 512 + wave * 128; const float u0 = gv[lane], u1 = gv[64 + lane], bc0 = gv[256 + lane], bc1 = gv[256 + 64 + lane];
        const float mp = MPREV[unit * 2 + wave]; float a0, a1;
        if (wave == 0) { a0 = fmaxf(scan_up_max(u0, lane), mp); const float cr = __shfl(a0, 63); a1 = fmaxf(scan_up_max(u1, lane), cr); }
        else { a1 = fmaxf(scan_down_max(u1, lane), mp); const float cr = __shfl(a1, 0); a0 = fmaxf(scan_down_max(u0, lane), cr); }
        LAS float* ua = wave ? ub : uf; LAS float* Ma = wave ? Mb : Mf; LAS float* ia = wave ? inb : inf_; LAS float* ea = wave ? emb : emf;
        ua[lane] = u0; ua[64 + lane] = u1; Ma[lane] = a0; Ma[64 + lane] = a1; ia[lane] = __expf(mp - a0); ia[64 + lane] = __expf(mp - a1);
        ea[lane] = __expf(-(bc0 + a0)); ea[64 + lane] = __expf(-(bc1 + a1));
    } else if (wave == 2) { npf[lane] = NPREV[(size_t)(unit * 2) * 128 + lane]; npf[64 + lane] = NPREV[(size_t)(unit * 2) * 128 + 64 + lane];
        npb[lane] = NPREV[(size_t)(unit * 2 + 1) * 128 + lane]; npb[64 + lane] = NPREV[(size_t)(unit * 2 + 1) * 128 + 64 + lane]; }
#pragma unroll
    for (int it = 0; it < 4; ++it) { const int idx = tid + 512 * it, s = idx >> 4, part = idx & 15;
        *(LAS u32x4*)(Ks + s * 136 + part * 8) = rk[it]; *(LAS u32x4*)(Vs + s * 144 + part * 8) = rv[it];
        *(LAS u32x4*)(Cf + s * 136 + part * 8) = rcf[it]; *(LAS u32x4*)(Cb + s * 136 + part * 8) = rcb[it]; }
    __syncthreads();
    bf16x8 qf[4];
#pragma unroll
    for (int kk = 0; kk < 4; ++kk) { float r8[8]; conv8(xq[kk][0], xq[kk][1], xq[kk][2], P.conv_w, P.conv_b, h * 128 + kk * 32 + fq * 8, r8);
        const float sc = 0.08838834764831845f;
        qf[kk] = mk8(pk2(r8[0] * sc, r8[1] * sc), pk2(r8[2] * sc, r8[3] * sc), pk2(r8[4] * sc, r8[5] * sc), pk2(r8[6] * sc, r8[7] * sc)); }
    float qnf = 0.f, qnb = 0.f;
#pragma unroll
    for (int kk = 0; kk < 4; ++kk) { const u32x4 qq = __builtin_bit_cast(u32x4, qf[kk]);
#pragma unroll
        for (int j = 0; j < 8; ++j) { const float qv = bf2f((qq[j >> 1] >> (16 * (j & 1))) & 0xffffu); const int d = kk * 32 + fq * 8 + j; qnf += qv * npf[d]; qnb += qv * npb[d]; } }
    qnf = quad_sum(qnf); qnb = quad_sum(qnb);
    f32x4 sT[8];
#pragma unroll
    for (int st = 0; st < 8; ++st) { f32x4 a = {0.f, 0.f, 0.f, 0.f};
#pragma unroll
        for (int kk = 0; kk < 4; ++kk) a = mfma16(*(const LAS bf16x8*)(Ks + (st * 16 + fr) * 136 + kk * 32 + fq * 8), qf[kk], a);
        sT[st] = a; }
    const int troff = (fq * 4 + ((lane >> 2) & 3)) * 144 + (lane & 3) * 4;
    f32x4 hsum[8];
#pragma unroll
    for (int vt = 0; vt < 8; ++vt) hsum[vt] = (f32x4){0.f, 0.f, 0.f, 0.f};
#pragma unroll 1
    for (int dir = 0; dir < 2; ++dir) {
        f32x4 acc[8];
        const LAS bf16_t* Cp = dir ? Cb : Cf;
#pragma unroll
        for (int vt = 0; vt < 8; ++vt) { f32x4 a = {0.f, 0.f, 0.f, 0.f};
#pragma unroll
            for (int kk = 0; kk < 4; ++kk) a = mfma16(*(const LAS bf16x8*)(Cp + (vt * 16 + fr) * 136 + kk * 32 + fq * 8), qf[kk], a);
            acc[vt] = a; }
        const float inter = dir ? inb[t] : inf_[t], Mt = dir ? Mb[t] : Mf[t];
#pragma unroll
        for (int vt = 0; vt < 8; ++vt) acc[vt] *= inter;
        float den = 0.f; unsigned pk[8][2];
#pragma unroll
        for (int st = 0; st < 8; ++st) { const f32x4 uu = *(const LAS f32x4*)((dir ? ub : uf) + st * 16 + fq * 4); float p[4];
#pragma unroll
            for (int i = 0; i < 4; ++i) { const int s = st * 16 + fq * 4 + i; const bool ok = dir ? (s >= t) : (s <= t); const float w = ok ? __expf(uu[i] - Mt) : 0.f; p[i] = sT[st][i] * w; den += p[i]; }
            pk[st][0] = pk2(p[0], p[1]); pk[st][1] = pk2(p[2], p[3]); }
        den = quad_sum(den) + inter * (dir ? qnb : qnf);
        const int ks_lo = dir ? (wave >> 1) : 0, ks_hi = dir ? 3 : (wave >> 1);
#pragma unroll
        for (int ks = 0; ks < 4; ++ks) if (ks >= ks_lo && ks <= ks_hi) { const bf16x8 bfrag = mk8(pk[2 * ks][0], pk[2 * ks][1], pk[2 * ks + 1][0], pk[2 * ks + 1][1]);
            const LAS bf16_t* vp = Vs + ks * 32 * 144 + troff;
#pragma unroll
            for (int vt = 0; vt < 8; ++vt) { const u32x2 lo = tr_read(vp + vt * 16), hi = tr_read(vp + 16 * 144 + vt * 16);
                acc[vt] = mfma16(mk8(lo.x, lo.y, hi.x, hi.y), bfrag, acc[vt]); } }
        const float rd = 1.0f / fmaxf(fabsf(den), dir ? emb[t] : emf[t]);
#pragma unroll
        for (int vt = 0; vt < 8; ++vt) hsum[vt] += acc[vt] * rd;
    }
    float ss = 0.f;
#pragma unroll
    for (int vt = 0; vt < 8; ++vt) { const f32x4 v = hsum[vt]; ss += (v[0] * v[0] + v[1] * v[1]) + (v[2] * v[2] + v[3] * v[3]); }
    const float rstd = rsqrtf(quad_sum(ss) * (1.0f / 128.0f) + EPS) * sqrtf(((const float*)(ws + WS_ATTSS))[m0 + t] * (1.0f / 512.0f) + EPS);
#pragma unroll
    for (int vt = 0; vt < 8; ++vt) { const int v0 = h * 128 + vt * 16 + fq * 4; const f32x4 gv = *(const f32x4*)(P.g_mlstm_out + v0);
        const u32x2 om = *(const u32x2*)(PROJ + (m0 + t) * NPROJ + 2304 + v0);
        const float o0 = sigmoid_f(bf2f(om.x & 0xffffu)), o1 = sigmoid_f(bf2f(om.x >> 16)), o2 = sigmoid_f(bf2f(om.y & 0xffffu)), o3 = sigmoid_f(bf2f(om.y >> 16));
        const f32x4 v = hsum[vt] * rstd * gv; u32x2 w; w.x = pk2(v[0] * o0, v[1] * o1); w.y = pk2(v[2] * o2, v[3] * o3);
        *(u32x2*)(A2 + (m0 + t) * D + 512 + v0) = w; }
}

#define XB_TMO      128
#define XB_XCNT(j)  (256  + 64 * (j))
#define XB_XSUB(j)  (1280 + 64 * (j))
#define XB_XGEN(j)  (2304 + 64 * (j))
#define XB_TOP      3328
#define XB_TOPGEN   3392
#define XCD_BAR_WORDS 3456
#define XB_SPIN_CAP (1u << 18)

__device__ __forceinline__ unsigned xb_ld(unsigned* p)              { return __hip_atomic_load(p, __ATOMIC_RELAXED, __HIP_MEMORY_SCOPE_AGENT); }
__device__ __forceinline__ unsigned xb_add(unsigned* p, unsigned v) { return __hip_atomic_fetch_add(p, v, __ATOMIC_RELAXED, __HIP_MEMORY_SCOPE_AGENT); }
__device__ __forceinline__ unsigned xb_xcc_id() { return (unsigned)__builtin_amdgcn_s_getreg((3 << 11) | 20) & 0xFu; }
#define XB_SPIN(cond, bar) do { unsigned _sp = 0; while (cond) { __builtin_amdgcn_s_sleep(1); \
    if ((++_sp & 255u) == 0u) { if (xb_ld(&(bar)[XB_TMO])) break; if (_sp > XB_SPIN_CAP) { atomicAdd(&(bar)[XB_TMO], 1u); break; } } } } while (0)

struct XcdBarrier {
    unsigned* bar; unsigned x;
    volatile LAS unsigned* st;
};

__device__ __forceinline__ XcdBarrier xcd_barrier_post(unsigned* bar, volatile LAS unsigned* st) {
    XcdBarrier b; b.bar = bar; b.x = xb_xcc_id(); b.st = st;
    if (threadIdx.x == 0) (void)xb_add(&bar[XB_XCNT(b.x)], 1u);
    return b;
}
__device__ __forceinline__ void xcd_barrier_complete(unsigned* bar, unsigned x, unsigned& nloc, unsigned& nx) {
    const unsigned G = gridDim.x * gridDim.y * gridDim.z;
    unsigned sum, cnt, mine, sp = 0u;
    for (;;) {
        sum = 0u; cnt = 0u; mine = 0u;
#pragma unroll
        for (unsigned j = 0; j < 16; ++j) { const unsigned c = xb_ld(&bar[XB_XCNT(j)]); sum += c; cnt += (c > 0u) ? 1u : 0u; mine = (j == x) ? c : mine; }
        if (sum == G) break;
        __builtin_amdgcn_s_sleep(1);
        if ((++sp & 255u) == 0u) { if (xb_ld(&bar[XB_TMO])) break; if (sp > XB_SPIN_CAP) { atomicAdd(&bar[XB_TMO], 1u); break; } }
    }
    nloc = mine > 0u ? mine : 1u; nx = cnt > 0u ? cnt : 1u;
}

__device__ __forceinline__ void xcd_barrier(const XcdBarrier& b) {
    asm volatile("s_waitcnt vmcnt(0)" ::: "memory");
    __syncthreads();
    if (threadIdx.x == 0) {
        unsigned* bar = b.bar;
        __builtin_amdgcn_s_waitcnt(0);
        unsigned nloc = b.st[0], nx = b.st[1];
        if (nloc == 0u) { xcd_barrier_complete(bar, b.x, nloc, nx); b.st[0] = nloc; b.st[1] = nx; }
        const unsigned old = xb_add(&bar[XB_XSUB(b.x)], 1u);
        const unsigned gen = old / nloc;
        if (old + 1u == (gen + 1u) * nloc) {
            __builtin_amdgcn_fence(__ATOMIC_RELEASE, "agent");
            asm volatile("s_waitcnt vmcnt(0)" ::: "memory");
            const unsigned og = xb_add(&bar[XB_TOP], 1u);
            const unsigned tg = og / nx;
            if (og + 1u == (tg + 1u) * nx) xb_add(&bar[XB_TOPGEN], 1u);
            else XB_SPIN(xb_ld(&bar[XB_TOPGEN]) == tg, bar);
            __builtin_amdgcn_fence(__ATOMIC_ACQUIRE, "agent");
            xb_add(&bar[XB_XGEN(b.x)], 1u);
            asm volatile("s_waitcnt vmcnt(0)" ::: "memory");
        } else {
            XB_SPIN(xb_ld(&bar[XB_XGEN(b.x)]) == gen, bar);
            __builtin_amdgcn_fence(__ATOMIC_ACQUIRE, "agent");
            asm volatile("s_waitcnt vmcnt(0)" ::: "memory");
        }
    }
    __syncthreads();
}

__global__ void __launch_bounds__(NTHREADS) hybrid_fwd(Params P) {
    extern __shared__ __attribute__((aligned(16))) unsigned char lds_raw[];
    LAS unsigned char* lds = (LAS unsigned char*)lds_raw;
    cg::grid_group grid = cg::this_grid();
    const int tid = threadIdx.x, lane = tid & 63, wave = __builtin_amdgcn_readfirstlane(tid >> 6);
    volatile LAS unsigned* bst = (volatile LAS unsigned*)(lds + LDS_BYTES - 64);
    if (tid < 2) bst[tid] = 0u;
    __syncthreads();
    XcdBarrier bar = xcd_barrier_post((unsigned*)(P.ws + WS_BAR), bst);
    if (P.ph_lo < 0) grid.sync();
    unsigned char* ws = P.ws;
    const int vcu = ((int)gridDim.x % 8 == 0) ? ((int)blockIdx.x % 8) * ((int)gridDim.x / 8) + (int)blockIdx.x / 8 : (int)blockIdx.x;
    const float* MOD = (const float*)(ws + WS_MOD);
    bf16_t* XN = (bf16_t*)(ws + WS_XN);
#ifndef WGM_P2
#define WGM_P2 8
#endif
#ifndef WGM_P6
#define WGM_P6 8
#endif
#ifndef WGM_P8
#define WGM_P8 2
#endif
#ifndef WGM_P9
#define WGM_P9 8
#endif
#ifndef DUP_MASK
#define DUP_MASK 0
#endif
#ifndef PH_MASK
#define PH_MASK 0x7ff
#endif
#define IN(k) (((PH_MASK >> (k)) & 1) && P.ph_lo <= (k) && (k) < P.ph_hi)
#define SEAM(k) do { if (IN(k) && IN((k) + 1)) xcd_barrier(bar); } while (0)
    if (IN(0)) { for (int rep = 0; rep < 1 + ((DUP_MASK >> 0) & 1); ++rep) { phase0(P, lds, tid, wave, lane); __syncthreads(); } } SEAM(0);
    if (IN(1)) { for (int i = blockIdx.x * NTHREADS + tid; i < M; i += gridDim.x * NTHREADS) { ((float*)(ws + WS_ATTSS))[i] = 0.f; ((float*)(ws + WS_SS2))[i] = 0.f; ((float*)(ws + WS_SS3))[i] = 0.f; }
        for (int rep = 0; rep < 1 + ((DUP_MASK >> 1) & 1); ++rep) norm_mod_phase(P.x, P.g_norm1, MOD, 0, 1024, XN, wave, lane); } SEAM(1);
    if (IN(2)) for (int rep = 0; rep < 1 + ((DUP_MASK >> 2) & 1); ++rep) {
        pg8::Gemm g{XN, (const bf16_t*)(ws + WS_WIN), M, NPROJ, D}; pg8::StaticOrder S; S.init(M, NPROJ, (int)gridDim.x, (int)blockIdx.x, WGM_P2);
        EpiProj E{(bf16_t*)(ws + WS_PROJ), (float*)(ws + WS_GATES), P.b_gates};
        pg8::gemm_phase<EpiProj, pg8::StaticOrder, true, true>(lds, g, S, E);
    } SEAM(2);
    if (IN(3)) {
        for (int rep = 0; rep < 1 + ((DUP_MASK >> 11) & 1); ++rep) attn_phase(P, lds, tid, wave, lane, rep == 0);
        for (int rep = 0; rep < 1 + ((DUP_MASK >> 12) & 1); ++rep)
        for (int u = vcu; u < 256; u += gridDim.x) mstate_pair(P, lds, u, u + 256, tid, wave, lane);
    } SEAM(3);
    if (IN(4)) { for (int rep = 0; rep < 1 + ((DUP_MASK >> 4) & 1); ++rep) scan_phase(P, tid); } SEAM(4);
    if (IN(5)) { for (int rep = 0; rep < 1 + ((DUP_MASK >> 5) & 1); ++rep) for (int u = vcu; u < 512; u += gridDim.x) mout_unit(P, lds, u, tid, wave, lane); } SEAM(5);
    if (IN(6)) for (int rep = 0; rep < 1 + ((DUP_MASK >> 6) & 1); ++rep) {
        __syncthreads();
        pg8::Gemm g{(const bf16_t*)(ws + WS_A2), (const bf16_t*)(ws + WS_WOUT), M, D, D}; pg8::StaticOrder S; S.init(M, D, (int)gridDim.x, (int)blockIdx.x, WGM_P6);
        EpiResidNorm E{P.x, P.out, MOD + 2048, (const float*)(ws + WS_ATTSS), (float*)(ws + WS_SS2), (unsigned*)(ws + WS_CNT), P.g_norm2, MOD + 4096, MOD + 3072, XN, nullptr, (bf16_t*)(ws + WS_QM)};
        pg8::gemm_phase<EpiResidNorm, pg8::StaticOrder, false, true>(lds, g, S, E);
    } do { if (IN(6) && IN(8)) xcd_barrier(bar); } while (0);
    if (IN(8)) for (int rep = 0; rep < 1 + ((DUP_MASK >> 8) & 1); ++rep) {
        pg8::Gemm g{XN, (const bf16_t*)(ws + WS_WFI), M, 2 * DFF, D}; pg8::StaticOrder S; S.init(M, 2 * DFF, (int)gridDim.x, (int)blockIdx.x, WGM_P8);
        EpiSwiglu E{(bf16_t*)(ws + WS_PROJ)};
        pg8::gemm_phase<EpiSwiglu, pg8::StaticOrder, true, true>(lds, g, S, E);
    } SEAM(8);
    if (IN(9)) {
        pg8::Gemm g{(const bf16_t*)(ws + WS_PROJ), (const bf16_t*)(ws + WS_WFO), M, D, DFF}; pg8::StaticOrder S; S.init(M, D, (int)gridDim.x, (int)blockIdx.x, WGM_P9);
        EpiResidNorm E{nullptr, P.out, MOD + 5120, nullptr, (float*)(ws + WS_SS3), (unsigned*)(ws + WS_CNT) + 1024, P.g_final, nullptr, nullptr, nullptr, (const bf16_t*)(ws + WS_QM), nullptr};
        pg8::gemm_phase<EpiResidNorm, pg8::StaticOrder, false, true>(lds, g, S, E);
    }
#undef IN
#undef SEAM
}

#ifndef MK_LAUNCHES
#define MK_LAUNCHES 1
#endif
extern "C" void kernel_launch(void* const* d_in, const int* in_sizes, int n_in, void* d_out, int out_size, void* d_ws, size_t ws_size, hipStream_t stream) {
    static int ready = 0;
    if (!ready) {
        if (n_in != 17 || out_size != M * D || ws_size < WS_END) { fprintf(stderr, "kernel_launch: unexpected shapes (n_in %d out %d ws %zu)\n", n_in, out_size, ws_size); ready = -1; return; }
        if (hipFuncSetAttribute((const void*)hybrid_fwd, hipFuncAttributeMaxDynamicSharedMemorySize, LDS_BYTES) != hipSuccess) { fprintf(stderr, "kernel_launch: hipFuncSetAttribute failed\n"); ready = -1; return; }
        ready = 1;
    }
    if (ready < 0) return;
    Params p{};
    const float** pp = (const float**)&p;
    for (int i = 0; i < 17; ++i) pp[i] = (const float*)d_in[i];
    p.out = (float*)d_out; p.ws = (unsigned char*)d_ws;
    (void)hipMemsetAsync((unsigned char*)d_ws + WS_BAR, 0, 32768, stream);
#if MK_LAUNCHES == 1
    p.ph_lo = 0; p.ph_hi = NPHASES;
    void* args[] = {&p};
    hipError_t e = hipLaunchCooperativeKernel((const void*)hybrid_fwd, dim3(256), dim3(NTHREADS), args, LDS_BYTES, stream);
    if (e != hipSuccess) fprintf(stderr, "cooperative launch failed: %s\n", hipGetErrorString(e));
#else
    for (int k = 0; k < NPHASES; ++k) { p.ph_lo = k; p.ph_hi = k + 1; void* args[] = {&p};
        hipError_t e = hipLaunchCooperativeKernel((const void*)hybrid_fwd, dim3(256), dim3(NTHREADS), args, LDS_BYTES, stream);
        if (e != hipSuccess) fprintf(stderr, "launch %d failed: %s\n", k, hipGetErrorString(e)); }
#endif
}
```

```cpp
#include <hip/hip_runtime.h>
#include <hip/hip_cooperative_groups.h>
#include <cstdio>
#include <cstdint>
namespace cg = cooperative_groups;
namespace pg8 {
#define PG8_LAS __attribute__((address_space(3)))
typedef unsigned short bf16_t;
typedef short bf16x8 __attribute__((ext_vector_type(8)));
typedef float f32x4 __attribute__((ext_vector_type(4)));
typedef unsigned u32x4 __attribute__((ext_vector_type(4)));
constexpr int BM = 256, BK = 64, HALF = 128, HTB = HALF * BK * 2  , STAGE_BYTES = 8 * HTB, NXCD = 8, WGM = 8;

__host__ __device__ __forceinline__ int lds_byte(int r, int c) { const int st = (r >> 4) * 2 + (c >> 5), rr = r & 15, cc = c & 31, ob = rr * 64 + cc * 2; return st * 1024 + (ob ^ (((ob >> 9) & 1) << 5)); }
__host__ __device__ __forceinline__ void stage_rc(int b, int& R, int& C) { const int st = b / 1024, sb = b % 1024, swz = sb ^ (((sb >> 9) & 1) << 5); R = (st >> 1) * 16 + swz / 64; C = (st & 1) * 32 + (swz % 64) / 2; }
__host__ __device__ __forceinline__ int perm32(int rho) { const int n = rho >> 4, i = rho & 15; return 8 * (i >> 2) + 4 * n + (i & 3); }

struct Unit { int pm, pn; };
struct Gemm { const bf16_t* A; const bf16_t* Bt; int M, N, K; };

struct StaticOrder {
    int nM, nN, nwg, G, c, wgm;
    __host__ __device__ void init(int M, int N, int G_, int c_, int wgm_ = WGM) { nM = M / BM; nN = N / BM; nwg = nM * nN; G = G_; c = c_; wgm = wgm_; }
    __host__ __device__ bool next(int i, Unit& u) const {
        const long L = (long)i * G + c; if (L >= nwg) return false;
        int wgid = (int)L; { const int q = nwg / NXCD, r = nwg % NXCD, xcd = wgid % NXCD, off = wgid / NXCD; wgid = (xcd < r ? xcd * (q + 1) : r * (q + 1) + (xcd - r) * q) + off; }
        const int nig = wgm * nN, gid = wgid / nig, fm = gid * wgm, gsz = (nM - fm) < wgm ? (nM - fm) : wgm;
        u.pm = fm + ((wgid % nig) % gsz); u.pn = (wgid % nig) / gsz; return true;
    }
    __device__ __forceinline__ void a_ready(const Unit&) const {}
    __device__ __forceinline__ void done(const Unit&) const {}
};

__device__ __forceinline__ unsigned cvt_pk_bf16(float lo, float hi) { unsigned r; asm volatile("v_cvt_pk_bf16_f32 %0, %1, %2" : "=v"(r) : "v"(lo), "v"(hi)); return r; }
typedef float f32x2 __attribute__((ext_vector_type(2)));
template <class Epi, class Sched, bool ALIGN_EPI = false, bool SP2 = false>
__device__ __forceinline__ void gemm_phase(PG8_LAS unsigned char* lds, const Gemm g, const Sched& S, const Epi& E) {
    const int tid = threadIdx.x, wid = __builtin_amdgcn_readfirstlane(tid >> 6), lane = tid & 63, wr = wid >> 2, wc = wid & 3, fr = lane & 15, fq = lane >> 4;
    const int K = g.K, nt = K / BK;
    unsigned voffA[2], voffB[2];
#pragma unroll
    for (int i = 0; i < 2; ++i) { int R, C; stage_rc(tid * 16 + i * 8192, R, C); const int Rb = Epi::PERM ? ((R & ~31) + perm32(R & 31)) : R;
        voffA[i] = (unsigned)(R * K + C) * 2u; voffB[i] = (unsigned)(Rb * K + C) * 2u; }
    const size_t kstep = (size_t)(BK * 2);
    const size_t hstep = (size_t)HALF * K * 2;
    const size_t tstep = 2 * hstep;
    const unsigned ldsw = (unsigned)wid * 1024u;
    const int aoff = lds_byte(wr * 64 + fr, fq * 8), boff = lds_byte(wc * 32 + fr, fq * 8);
#define PG8_SA(b, h) (((b) * 2 + (h)) * HTB)
#define PG8_SB(b, h) ((4 + (b) * 2 + (h)) * HTB)
#define PG8_STAGE(bufoff, gbase, voff) do { _Pragma("unroll") for (int _i = 0; _i < 2; ++_i) \
        __builtin_amdgcn_global_load_lds((const unsigned*)((const char*)(gbase) + (voff)[_i]), (PG8_LAS unsigned*)(lds + (bufoff) + ldsw + _i * 8192), 16, 0, 0); } while (0)
#define PG8_LDA(dst, b, h) do { _Pragma("unroll") for (int m = 0; m < 4; ++m) _Pragma("unroll") for (int k = 0; k < 2; ++k) dst[m][k] = *(const PG8_LAS bf16x8*)(lds + PG8_SA(b, h) + aoff + m * 2048 + k * 1024); } while (0)
#define PG8_LDB(dst, b, h) do { _Pragma("unroll") for (int n = 0; n < 2; ++n) _Pragma("unroll") for (int k = 0; k < 2; ++k) dst[n][k] = *(const PG8_LAS bf16x8*)(lds + PG8_SB(b, h) + boff + n * 2048 + k * 1024); } while (0)
#define PG8_MMA(ai, bj, At, Bt) do { __builtin_amdgcn_s_setprio(1); _Pragma("unroll") for (int m = 0; m < 4; ++m) _Pragma("unroll") for (int n = 0; n < 2; ++n) _Pragma("unroll") for (int k = 0; k < 2; ++k) \
        acc[ai][bj][m][n] = __builtin_amdgcn_mfma_f32_16x16x32_bf16(Bt[n][k], At[m][k], acc[ai][bj][m][n], 0, 0, 0); __builtin_amdgcn_s_setprio(0); } while (0)
#define PG8_WAIT_V(n) asm volatile("s_waitcnt vmcnt(" #n ")" ::: "memory")
#define PG8_WAIT_L(n) asm volatile("s_waitcnt lgkmcnt(" #n ")" ::: "memory")
#define PG8_BAR __builtin_amdgcn_s_barrier()
#define PG8_SCHED __builtin_amdgcn_sched_barrier(0)
    Unit cur, nxt; int ui = 0;
    if (!S.next(0, cur)) return;
    f32x4 acc[2][2][4][2];
#pragma unroll
    for (int a = 0; a < 2; ++a)
#pragma unroll
        for (int b = 0; b < 2; ++b)
#pragma unroll
            for (int m = 0; m < 4; ++m)
#pragma unroll
                for (int n = 0; n < 2; ++n) acc[a][b][m][n] = (f32x4){0.f, 0.f, 0.f, 0.f};
    bf16x8 At[4][2], B0[2][2], B1[2][2];
    const char* cA = (const char*)g.A + (size_t)cur.pm * tstep; const char* cB = (const char*)g.Bt + (size_t)cur.pn * tstep;
    S.a_ready(cur);
    if constexpr (SP2) {
        PG8_STAGE(PG8_SB(0, 0), cB, voffB); PG8_STAGE(PG8_SB(0, 1), cB + hstep, voffB); PG8_STAGE(PG8_SA(0, 0), cA, voffA); PG8_STAGE(PG8_SA(0, 1), cA + hstep, voffA);
        if (wr == 1) PG8_BAR;
        PG8_WAIT_V(2); PG8_BAR;
        PG8_STAGE(PG8_SB(1, 0), cB + kstep, voffB); PG8_STAGE(PG8_SA(1, 0), cA + kstep, voffA); PG8_STAGE(PG8_SB(1, 1), cB + hstep + kstep, voffB);
        PG8_WAIT_V(6); PG8_BAR;
    } else {
        PG8_STAGE(PG8_SB(0, 0), cB, voffB); PG8_STAGE(PG8_SA(0, 0), cA, voffA); PG8_STAGE(PG8_SB(0, 1), cB + hstep, voffB); PG8_STAGE(PG8_SA(0, 1), cA + hstep, voffA);
        if (wr == 1) PG8_BAR;
        PG8_WAIT_V(4); PG8_BAR;
        PG8_STAGE(PG8_SB(1, 0), cB + kstep, voffB); PG8_STAGE(PG8_SA(1, 0), cA + kstep, voffA); PG8_STAGE(PG8_SB(1, 1), cB + hstep + kstep, voffB);
        PG8_WAIT_V(6); PG8_BAR;
    }
    for (;;) {
        const bool has_next = S.next(ui + 1, nxt);
        const char* nA = has_next ? (const char*)g.A + (size_t)nxt.pm * tstep : cA; const char* nB = has_next ? (const char*)g.Bt + (size_t)nxt.pn * tstep : cB;
        for (int t = 0; t < nt; t += 2) {
            const bool last = (t == nt - 2);
            const char* a1 = cA + (size_t)(t + 1) * kstep;
            const char* a2 = last ? nA : cA + (size_t)(t + 2) * kstep; const char* b2 = last ? nB : cB + (size_t)(t + 2) * kstep;
            const char* a3 = a2 + kstep; const char* b3 = b2 + kstep;
            if (last && has_next) S.a_ready(nxt);
            if constexpr (SP2) {
            PG8_LDB(B0, 0, 0); PG8_LDB(B1, 0, 1); PG8_SCHED; PG8_LDA(At, 0, 0); PG8_STAGE(PG8_SA(1, 1), a1 + hstep, voffA);
            PG8_WAIT_V(8); PG8_WAIT_L(0); PG8_BAR; PG8_MMA(0, 0, At, B0); PG8_MMA(0, 1, At, B1); PG8_BAR; PG8_SCHED;
            PG8_LDA(At, 0, 1); PG8_STAGE(PG8_SB(0, 0), b2, voffB); PG8_STAGE(PG8_SB(0, 1), b2 + hstep, voffB); PG8_STAGE(PG8_SA(0, 0), a2, voffA);
            PG8_WAIT_V(8); PG8_WAIT_L(0); PG8_BAR; PG8_MMA(1, 0, At, B0); PG8_MMA(1, 1, At, B1); PG8_BAR; PG8_SCHED;
            PG8_LDB(B0, 1, 0); PG8_LDB(B1, 1, 1); PG8_SCHED; PG8_LDA(At, 1, 0); PG8_STAGE(PG8_SA(0, 1), a2 + hstep, voffA);
            PG8_WAIT_V(8); PG8_WAIT_L(0); PG8_BAR; PG8_MMA(0, 0, At, B0); PG8_MMA(0, 1, At, B1); PG8_BAR; PG8_SCHED;
            PG8_LDA(At, 1, 1); PG8_STAGE(PG8_SB(1, 0), b3, voffB); PG8_STAGE(PG8_SB(1, 1), b3 + hstep, voffB); PG8_STAGE(PG8_SA(1, 0), a3, voffA);
            PG8_WAIT_V(8); PG8_WAIT_L(0); PG8_BAR; PG8_MMA(1, 0, At, B0); PG8_MMA(1, 1, At, B1); PG8_BAR; PG8_SCHED;
            } else {
            PG8_LDB(B0, 0, 0); PG8_SCHED; PG8_LDA(At, 0, 0); PG8_STAGE(PG8_SA(1, 1), a1 + hstep, voffA);
            PG8_WAIT_L(8); PG8_BAR; PG8_WAIT_L(0); PG8_MMA(0, 0, At, B0); PG8_BAR; PG8_SCHED;
            PG8_LDB(B1, 0, 1); PG8_STAGE(PG8_SB(0, 0), b2, voffB);
            PG8_BAR; PG8_WAIT_L(0); PG8_MMA(0, 1, At, B1); PG8_BAR;
            PG8_LDA(At, 0, 1); PG8_STAGE(PG8_SA(0, 0), a2, voffA);
            PG8_BAR; PG8_WAIT_L(0); PG8_MMA(1, 0, At, B0); PG8_BAR; PG8_SCHED;
            PG8_STAGE(PG8_SB(0, 1), b2 + hstep, voffB);
            PG8_WAIT_V(6); PG8_BAR; PG8_MMA(1, 1, At, B1); PG8_BAR;
            PG8_LDB(B0, 1, 0); PG8_SCHED; PG8_LDA(At, 1, 0); PG8_STAGE(PG8_SA(0, 1), a2 + hstep, voffA);
            PG8_WAIT_L(8); PG8_BAR; PG8_WAIT_L(0); PG8_MMA(0, 0, At, B0); PG8_BAR; PG8_SCHED;
            PG8_LDB(B1, 1, 1); PG8_STAGE(PG8_SB(1, 0), b3, voffB);
            PG8_BAR; PG8_WAIT_L(0); PG8_MMA(0, 1, At, B1); PG8_BAR;
            PG8_LDA(At, 1, 1); PG8_STAGE(PG8_SA(1, 0), a3, voffA);
            PG8_BAR; PG8_WAIT_L(0); PG8_MMA(1, 0, At, B0); PG8_BAR; PG8_SCHED;
            PG8_STAGE(PG8_SB(1, 1), b3 + hstep, voffB);
            PG8_WAIT_V(6); PG8_BAR; PG8_MMA(1, 1, At, B1); PG8_BAR;
            }
        }
        if constexpr (ALIGN_EPI) { if (wr == 0) PG8_BAR; }
        if constexpr (!Epi::AFTER_DRAIN) { E(acc, cur, wr, wc, fr, fq); S.done(cur); }
        if (!has_next) break;
#pragma unroll
        for (int a = 0; a < 2; ++a)
#pragma unroll
            for (int b = 0; b < 2; ++b)
#pragma unroll
                for (int m = 0; m < 4; ++m)
#pragma unroll
                    for (int n = 0; n < 2; ++n) acc[a][b][m][n] = (f32x4){0.f, 0.f, 0.f, 0.f};
        cur = nxt; cA = nA; cB = nB; ++ui;
        if constexpr (ALIGN_EPI) { if (wr == 1) PG8_BAR; }
    }
    PG8_WAIT_V(0);
    if constexpr (!ALIGN_EPI) { if (wr == 0) PG8_BAR; }
    PG8_BAR;
    if constexpr (Epi::AFTER_DRAIN) { E.fused(acc, cur, wr, wc, fr, fq, lds, wid, lane); S.done(cur); }
#undef PG8_SA
#undef PG8_SB
#undef PG8_STAGE
#undef PG8_LDA
#undef PG8_LDB
#undef PG8_MMA
#undef PG8_WAIT_V
#undef PG8_WAIT_L
#undef PG8_BAR
#undef PG8_SCHED
}
}

#define LAS __attribute__((address_space(3)))
typedef unsigned short bf16_t;
typedef short bf16x8 __attribute__((ext_vector_type(8)));
typedef float f32x4 __attribute__((ext_vector_type(4)));
typedef unsigned u32x4 __attribute__((ext_vector_type(4)));
typedef unsigned u32x2 __attribute__((ext_vector_type(2)));
typedef float f32x2_t __attribute__((ext_vector_type(2)));
typedef __bf16 bf16x2_t __attribute__((ext_vector_type(2)));

constexpr int SEQ = 8192, NB = 2, M = NB * SEQ, D = 1024, NPROJ = 3072, NIN = 2832, DFF = 2816, NMOD = 6144;
constexpr float EPS = 1e-6f;
constexpr int NTHREADS = 512, NWAVES = 8;
constexpr int LDS_BYTES = 155648;
constexpr int NPHASES = 11;

constexpr size_t MiB = 1u << 20;
constexpr size_t WS_MOD = 0;
constexpr size_t WS_SC = 256 * 1024;
constexpr size_t WS_MPREV = 320 * 1024;
constexpr size_t WS_ATTSS = 384 * 1024;
constexpr size_t WS_SS2 = 640 * 1024;
constexpr size_t WS_SS3 = 704 * 1024;
constexpr size_t WS_BAR = 512 * 1024;
constexpr size_t WS_CNT = 512 * 1024 + 16384;
constexpr size_t WS_GATES = 1 * MiB;
constexpr size_t WS_GV = 2 * MiB;
constexpr size_t WS_NC = 3 * MiB;
constexpr size_t WS_NPREV = 4 * MiB;
constexpr size_t WS_WIN = 6 * MiB;
constexpr size_t WS_WOUT = 12 * MiB;
constexpr size_t WS_WFI = 14 * MiB;
constexpr size_t WS_WFO = 25 * MiB;
constexpr size_t WS_PROJ = 32 * MiB;
constexpr size_t WS_QM = 128 * MiB;
constexpr size_t WS_KM = 144 * MiB;
constexpr size_t WS_XN = 160 * MiB;
constexpr size_t WS_A2 = 192 * MiB;
constexpr size_t WS_END = 224 * MiB;

struct Params {
    const float *x, *c, *w_mod, *b_mod, *g_norm1, *w_in, *conv_w, *conv_b, *b_gates, *sink, *g_attn_out, *g_mlstm_out, *w_out, *g_norm2, *w_ffn_in, *w_ffn_out, *g_final;
    float* out; unsigned char* ws; int ph_lo, ph_hi;
};

__device__ __forceinline__ float bf2f(unsigned h) { return __uint_as_float(h << 16); }
__device__ __forceinline__ unsigned pk2(float lo, float hi) { f32x2_t v = {lo, hi}; bf16x2_t b = __builtin_convertvector(v, bf16x2_t); return __builtin_bit_cast(unsigned, b); }
__device__ __forceinline__ float wave_sum(float v) {
#pragma unroll
    for (int o = 1; o < 64; o <<= 1) v += __shfl_xor(v, o);
    return v;
}
__device__ __forceinline__ float quad_sum(float v) { v += __shfl_xor(v, 16); v += __shfl_xor(v, 32); return v; }
__device__ __forceinline__ float quad_max(float v) { v = fmaxf(v, __shfl_xor(v, 16)); v = fmaxf(v, __shfl_xor(v, 32)); return v; }
__device__ __forceinline__ float silu_f(float v) { return v * __builtin_amdgcn_rcpf(1.0f + __expf(-v)); }
__device__ __forceinline__ float sigmoid_f(float v) { return __builtin_amdgcn_rcpf(1.0f + __expf(-v)); }
__device__ __forceinline__ float logsig_f(float f) { return fminf(f, 0.f) - log1pf(expf(-fabsf(f))); }
__device__ __forceinline__ f32x4 mfma16(bf16x8 a, bf16x8 b, f32x4 c) { return __builtin_amdgcn_mfma_f32_16x16x32_bf16(a, b, c, 0, 0, 0); }
__device__ __forceinline__ bf16x8 mk8(unsigned a, unsigned b, unsigned c, unsigned d) { u32x4 v = {a, b, c, d}; return __builtin_bit_cast(bf16x8, v); }

struct EpiProj {
    static constexpr bool PERM = true, AFTER_DRAIN = false;
    bf16_t* O; float* gates; const float* b_gates;
    __device__ __forceinline__ void operator()(const f32x4 (&acc)[2][2][4][2], const pg8::Unit& u, int wr, int wc, int fr, int fq) const {
        const int row0 = u.pm * 256 + wr * 64 + fr; const int col0 = u.pn * 256 + wc * 32 + 8 * fq;
        if (u.pn != 11)
#pragma unroll
        for (int ai = 0; ai < 2; ++ai)
#pragma unroll
            for (int m = 0; m < 4; ++m) { bf16_t* rowp = O + (size_t)(row0 + ai * 128 + m * 16) * NPROJ + col0;
#pragma unroll
                for (int bj = 0; bj < 2; ++bj) { const f32x4 v0 = acc[ai][bj][m][0], v1 = acc[ai][bj][m][1];
                    u32x4 w; w.x = pk2(v0[0], v0[1]); w.y = pk2(v0[2], v0[3]); w.z = pk2(v1[0], v1[1]); w.w = pk2(v1[2], v1[3]);
                    *(u32x4*)(rowp + bj * 128) = w; } }
        if (u.pn == 11 && wc == 0 && fq < 2) {
            const f32x4 b0 = *(const f32x4*)(b_gates + 8 * fq), b1 = *(const f32x4*)(b_gates + 8 * fq + 4);
#pragma unroll
            for (int ai = 0; ai < 2; ++ai)
#pragma unroll
                for (int m = 0; m < 4; ++m) { float* gp = gates + (size_t)(row0 + ai * 128 + m * 16) * 16 + 8 * fq;
                    *(f32x4*)gp = acc[ai][0][m][0] + b0; *(f32x4*)(gp + 4) = acc[ai][0][m][1] + b1; }
        }
    }
};
struct EpiResid {
    static constexpr bool PERM = false, AFTER_DRAIN = false;
    const float* base; float* out; const float* gate;
    const float* rowss;
    __device__ __forceinline__ void operator()(const f32x4 (&acc)[2][2][4][2], const pg8::Unit& u, int wr, int wc, int fr, int fq) const {
        const int col0 = u.pn * 256 + wc * 32 + 4 * fq; const int b = u.pm >> 5;
        float rs[2][4];
#pragma unroll
        for (int ai = 0; ai < 2; ++ai)
#pragma unroll
            for (int m = 0; m < 4; ++m) rs[ai][m] = rowss ? rsqrtf(rowss[u.pm * 256 + ai * 128 + wr * 64 + m * 16 + fr] * (1.0f / 512.0f) + EPS) : 1.0f;
#pragma unroll
        for (int bj = 0; bj < 2; ++bj)
#pragma unroll
            for (int n = 0; n < 2; ++n) { const f32x4 g = *(const f32x4*)(gate + b * NMOD + col0 + bj * 128 + n * 16);
#pragma unroll
                for (int ai = 0; ai < 2; ++ai)
#pragma unroll
                    for (int m = 0; m < 4; ++m) { const size_t off = (size_t)(u.pm * 256 + ai * 128 + wr * 64 + m * 16 + fr) * D + col0 + bj * 128 + n * 16;
                        const f32x4 bs = *(const f32x4*)(base + off); *(f32x4*)(out + off) = bs + (g * rs[ai][m]) * acc[ai][bj][m][n]; } }
    }
};
struct EpiResidNorm {
    static constexpr bool PERM = false, AFTER_DRAIN = true;
    const float* base; float* out; const float* gate; const float* rowss;
    float* SS; unsigned* CNT; const float* gcol; const float* mod_scale; const float* mod_shift; bf16_t* XN;
    const bf16_t* base_bf; bf16_t* x1_bf;
    __device__ __forceinline__ void fused(f32x4 (&acc)[2][2][4][2], const pg8::Unit& u, int wr, int wc, int fr, int fq, PG8_LAS unsigned char* lds, int wid, int lane) const {
        const int col0 = u.pn * 256 + wc * 32 + 4 * fq; const int b = u.pm >> 5; const int rowb = u.pm * 256 + wr * 64 + fr;
        f32x4 gq[2][2];
#pragma unroll
        for (int bj = 0; bj < 2; ++bj)
#pragma unroll
            for (int n = 0; n < 2; ++n) gq[bj][n] = *(const f32x4*)(gate + b * NMOD + col0 + bj * 128 + n * 16);
#pragma unroll
        for (int ai = 0; ai < 2; ++ai)
#pragma unroll
            for (int mp = 0; mp < 2; ++mp) {
                f32x4 bs[2][2][2]; float rsv[2];
#pragma unroll
                for (int mi = 0; mi < 2; ++mi) { const int row = rowb + ai * 128 + (mp * 2 + mi) * 16; rsv[mi] = rowss ? rowss[row] : 0.f;
#pragma unroll
                    for (int bj = 0; bj < 2; ++bj)
#pragma unroll
                        for (int n = 0; n < 2; ++n) { const unsigned off = (unsigned)(row * D + col0 + bj * 128 + n * 16);
                            if (base_bf) { const u32x2 q = __builtin_nontemporal_load((const u32x2*)(base_bf + off)); bs[mi][bj][n] = (f32x4){bf2f(q.x & 0xffffu), bf2f(q.x >> 16), bf2f(q.y & 0xffffu), bf2f(q.y >> 16)}; }
                            else bs[mi][bj][n] = __builtin_nontemporal_load((const f32x4*)(base + off)); } }
#pragma unroll
                for (int mi = 0; mi < 2; ++mi) { const int m = mp * 2 + mi; const int row = rowb + ai * 128 + m * 16;
                    const float rs1 = rowss ? rsqrtf(rsv[mi] * (1.0f / 512.0f) + EPS) : 1.0f; float ssp = 0.f;
#pragma unroll
                    for (int bj = 0; bj < 2; ++bj)
#pragma unroll
                        for (int n = 0; n < 2; ++n) { const f32x4 v = bs[mi][bj][n] + (gq[bj][n] * rs1) * acc[ai][bj][m][n]; acc[ai][bj][m][n] = v;
                            ssp += (v[0] * v[0] + v[1] * v[1]) + (v[2] * v[2] + v[3] * v[3]);
                            asm volatile("" : "+v"(acc[ai][bj][m][n])); }
                    const float sq = quad_sum(ssp); if (fq == 0) __hip_atomic_fetch_add(SS + row, sq, __ATOMIC_RELAXED, __HIP_MEMORY_SCOPE_AGENT); }
                asm volatile("" ::: "memory"); }
        asm volatile("s_waitcnt vmcnt(0)" ::: "memory");
        __syncthreads();
        if (threadIdx.x == 0) { unsigned* cp = CNT + u.pm * 16;
            __builtin_amdgcn_fence(__ATOMIC_RELEASE, "agent");
            __hip_atomic_fetch_add(cp, 1u, __ATOMIC_RELAXED, __HIP_MEMORY_SCOPE_AGENT);
            unsigned spins = 0;
            while (__hip_atomic_load(cp, __ATOMIC_RELAXED, __HIP_MEMORY_SCOPE_AGENT) < 4u && ++spins < (1u << 22)) __builtin_amdgcn_s_sleep(1);
            __builtin_amdgcn_fence(__ATOMIC_ACQUIRE, "agent"); }
        __syncthreads();
        int rowc = rowb; asm volatile("" : "+v"(rowc));
        float rstd[2][4];
#pragma unroll
        for (int ai = 0; ai < 2; ++ai)
#pragma unroll
            for (int m = 0; m < 4; ++m) rstd[ai][m] = rsqrtf(__hip_atomic_load(SS + rowc + ai * 128 + m * 16, __ATOMIC_RELAXED, __HIP_MEMORY_SCOPE_AGENT) * (1.0f / D) + EPS);
#pragma unroll
        for (int bj = 0; bj < 2; ++bj)
#pragma unroll
            for (int n = 0; n < 2; ++n) { const int col = col0 + bj * 128 + n * 16; f32x4 gc = *(const f32x4*)(gcol + col); f32x4 sh = {0.f, 0.f, 0.f, 0.f};
                if (XN) { gc = gc * (1.0f + *(const f32x4*)(mod_scale + b * NMOD + col)); sh = *(const f32x4*)(mod_shift + b * NMOD + col); }
#pragma unroll
                for (int ai = 0; ai < 2; ++ai)
#pragma unroll
                    for (int m = 0; m < 4; ++m) { const unsigned off = (unsigned)((rowc + ai * 128 + m * 16) * D + col); const f32x4 v = acc[ai][bj][m][n] * rstd[ai][m] * gc + sh;
                        if (XN) { { const f32x4 a = acc[ai][bj][m][n]; u32x2 q; q.x = pk2(a[0], a[1]); q.y = pk2(a[2], a[3]); *(u32x2*)(x1_bf + off) = q; } u32x2 w; w.x = pk2(v[0], v[1]); w.y = pk2(v[2], v[3]); *(u32x2*)(XN + off) = w; } else *(f32x4*)(out + off) = v; } }
    }
};
struct EpiSwiglu {
    static constexpr bool PERM = true, AFTER_DRAIN = false;
    bf16_t* O;
    __device__ __forceinline__ void operator()(const f32x4 (&acc)[2][2][4][2], const pg8::Unit& u, int wr, int wc, int fr, int fq) const {
        const int row0 = u.pm * 256 + wr * 64 + fr; const int col0 = u.pn * 128 + wc * 32 + 8 * fq;
#pragma unroll
        for (int ai = 0; ai < 2; ++ai)
#pragma unroll
            for (int m = 0; m < 4; ++m) { float r[8];
#pragma unroll
                for (int n = 0; n < 2; ++n)
#pragma unroll
                    for (int e = 0; e < 4; ++e) { const float g = acc[ai][0][m][n][e], up = acc[ai][1][m][n][e]; r[n * 4 + e] = silu_f(g) * up; }
                u32x4 w; w.x = pk2(r[0], r[1]); w.y = pk2(r[2], r[3]); w.z = pk2(r[4], r[5]); w.w = pk2(r[6], r[7]);
                *(u32x4*)(O + (size_t)(row0 + ai * 128 + m * 16) * DFF + col0) = w; }
    }
};

__device__ __forceinline__ void transpose_item(const float* W, int K, int N, bf16_t* WT, int drow0, int k0, int n0, LAS float* scr, int lane) {
    const int kr = lane >> 3, nq = (lane & 7) * 4; f32x4 v[8];
#pragma unroll
    for (int i = 0; i < 8; ++i) { const f32x4 z = {0.f, 0.f, 0.f, 0.f}; v[i] = (n0 + nq < N) ? __builtin_nontemporal_load((const f32x4*)(W + (size_t)(k0 + kr + 8 * i) * N + n0 + nq)) : z; }
#pragma unroll
    for (int i = 0; i < 8; ++i) { LAS float* d = scr + (kr + 8 * i) * 33 + nq; d[0] = v[i][0]; d[1] = v[i][1]; d[2] = v[i][2]; d[3] = v[i][3]; }
    const int c = lane & 7;
#pragma unroll
    for (int j = 0; j < 4; ++j) { const int n = (lane >> 3) + 8 * j; const LAS float* s = scr + (8 * c) * 33 + n;
        u32x4 o; o.x = pk2(s[0 * 33], s[1 * 33]); o.y = pk2(s[2 * 33], s[3 * 33]); o.z = pk2(s[4 * 33], s[5 * 33]); o.w = pk2(s[6 * 33], s[7 * 33]);
        *(u32x4*)(WT + (size_t)(drow0 + n) * K + k0 + 8 * c) = o; }
}

__device__ __forceinline__ void phase0(const Params& P, LAS unsigned char* lds, int tid, int wave, int lane) {
    unsigned char* ws = P.ws;
    float* MOD = (float*)(ws + WS_MOD);
    LAS float* red = (LAS float*)(lds + 81920);
    for (int item = blockIdx.x; item < NMOD / 32; item += gridDim.x) {
        const int col0 = item * 32 + (lane & 7) * 4; const int r = lane >> 3;
        f32x4 a0 = {0.f, 0.f, 0.f, 0.f}, a1 = {0.f, 0.f, 0.f, 0.f};
#pragma unroll 4
        for (int i = 0; i < 16; ++i) { const int k = wave * 128 + r + 8 * i; const f32x4 w = __builtin_nontemporal_load((const f32x4*)(P.w_mod + (size_t)k * NMOD + col0));
            const float s0 = silu_f(P.c[k]), s1 = silu_f(P.c[D + k]); a0 += s0 * w; a1 += s1 * w; }
#pragma unroll
        for (int e = 0; e < 4; ++e) {
#pragma unroll
            for (int o = 8; o < 64; o <<= 1) { a0[e] += __shfl_xor(a0[e], o); a1[e] += __shfl_xor(a1[e], o); } }
        if (lane < 8) {
#pragma unroll
            for (int e = 0; e < 4; ++e) { red[(wave * 8 + lane) * 8 + e] = a0[e]; red[(wave * 8 + lane) * 8 + 4 + e] = a1[e]; } }
        __syncthreads();
        if (tid < 64) { const int q = tid >> 3, e = tid & 7; float s = 0.f;
#pragma unroll
            for (int w = 0; w < 8; ++w) s += red[(w * 8 + q) * 8 + e];
            const int b = e >> 2, col = item * 32 + q * 4 + (e & 3); MOD[b * NMOD + col] = s + P.b_mod[col]; }
        __syncthreads();
    }
    LAS float* scr = (LAS float*)(lds + wave * 8704);
    const int gw = blockIdx.x * NWAVES + wave, NGW = gridDim.x * NWAVES;
    bf16_t* WIN = (bf16_t*)(ws + WS_WIN); bf16_t* WOUT = (bf16_t*)(ws + WS_WOUT); bf16_t* WFI = (bf16_t*)(ws + WS_WFI); bf16_t* WFO = (bf16_t*)(ws + WS_WFO);
    constexpr int NB_IN = 88, I_IN = 16 * NB_IN, I_OUT = 16 * 32, I_FI = 16 * 176, I_FO = 44 * 32;
    if ((int)gridDim.x > NMOD / 32) { const int xw = ((int)blockIdx.x - NMOD / 32) * NWAVES + wave; if (xw >= 0 && xw < 16) transpose_item(P.w_in, D, NIN, WIN, 88 * 32, xw * 64, 88 * 32, scr, lane); }
    else if (gw < 16) transpose_item(P.w_in, D, NIN, WIN, 88 * 32, gw * 64, 88 * 32, scr, lane);
    for (int it = gw; it < I_IN + I_OUT + I_FI + I_FO; it += NGW) {
        int r = it;
        if (r < I_IN) { const int kb = r / NB_IN, nb = r % NB_IN; transpose_item(P.w_in, D, NIN, WIN, nb * 32, kb * 64, nb * 32, scr, lane); continue; } r -= I_IN;
        if (r < I_OUT) { const int kb = r / 32, nb = r % 32; transpose_item(P.w_out, D, D, WOUT, nb * 32, kb * 64, nb * 32, scr, lane); continue; } r -= I_OUT;
        if (r < I_FI) { const int kb = r / 176, nb = r % 176; const int n0 = nb * 32; const int np = n0 < DFF ? n0 : n0 - DFF;
            const int drow0 = (np / 128) * 256 + (n0 < DFF ? 0 : 128) + (np % 128);
            transpose_item(P.w_ffn_in, D, 2 * DFF, WFI, drow0, kb * 64, n0, scr, lane); continue; } r -= I_FI;
        { const int kb = r / 32, nb = r % 32; transpose_item(P.w_ffn_out, DFF, D, WFO, nb * 32, kb * 64, nb * 32, scr, lane); }
    }
}

__device__ __forceinline__ void norm_mod_phase(const float* X, const float* g, const float* MOD, int shift_off, int scale_off, bf16_t* XN, int wave, int lane) {
    const int gw = blockIdx.x * NWAVES + wave, NGW = gridDim.x * NWAVES;
    int curb = -1; f32x4 A[4], B[4];
    for (int m = gw; m < M; m += 2 * NGW) {
        const int b = m >> 13; const int m2 = m + NGW;
        if (b != curb) { curb = b;
#pragma unroll
            for (int j = 0; j < 4; ++j) { const int col = 4 * lane + 256 * j; const f32x4 gv = *(const f32x4*)(g + col), sc = *(const f32x4*)(MOD + b * NMOD + scale_off + col);
                A[j] = gv * (1.0f + sc); B[j] = *(const f32x4*)(MOD + b * NMOD + shift_off + col); } }
        f32x4 v[4], w[4]; float ss = 0.f, ss2 = 0.f;
#pragma unroll
        for (int j = 0; j < 4; ++j) { v[j] = __builtin_nontemporal_load((const f32x4*)(X + (size_t)m * D + 4 * lane + 256 * j)); w[j] = __builtin_nontemporal_load((const f32x4*)(X + (size_t)m2 * D + 4 * lane + 256 * j)); }
#pragma unroll
        for (int j = 0; j < 4; ++j) { ss += (v[j][0] * v[j][0] + v[j][1] * v[j][1]) + (v[j][2] * v[j][2] + v[j][3] * v[j][3]); ss2 += (w[j][0] * w[j][0] + w[j][1] * w[j][1]) + (w[j][2] * w[j][2] + w[j][3] * w[j][3]); }
        const float rstd = rsqrtf(wave_sum(ss) * (1.0f / D) + EPS), rstd2 = rsqrtf(wave_sum(ss2) * (1.0f / D) + EPS);
#pragma unroll
        for (int j = 0; j < 4; ++j) { const f32x4 o = v[j] * rstd * A[j] + B[j]; u32x2 p; p.x = pk2(o[0], o[1]); p.y = pk2(o[2], o[3]);
            *(u32x2*)(XN + (size_t)m * D + 4 * lane + 256 * j) = p;
            const f32x4 o2 = w[j] * rstd2 * A[j] + B[j]; u32x2 p2; p2.x = pk2(o2[0], o2[1]); p2.y = pk2(o2[2], o2[3]);
            *(u32x2*)(XN + (size_t)m2 * D + 4 * lane + 256 * j) = p2; }
    }
}
__device__ __forceinline__ void final_norm_phase(float* X, const float* g, int wave, int lane) {
    const int gw = blockIdx.x * NWAVES + wave, NGW = gridDim.x * NWAVES;
    f32x4 A[4];
#pragma unroll
    for (int j = 0; j < 4; ++j) A[j] = *(const f32x4*)(g + 4 * lane + 256 * j);
    for (int m = gw; m < M; m += NGW) {
        f32x4 v[4]; float ss = 0.f;
#pragma unroll
        for (int j = 0; j < 4; ++j) { v[j] = *(const f32x4*)(X + (size_t)m * D + 4 * lane + 256 * j); ss += (v[j][0] * v[j][0] + v[j][1] * v[j][1]) + (v[j][2] * v[j][2] + v[j][3] * v[j][3]); }
        const float rstd = rsqrtf(wave_sum(ss) * (1.0f / D) + EPS);
#pragma unroll
        for (int j = 0; j < 4; ++j) *(f32x4*)(X + (size_t)m * D + 4 * lane + 256 * j) = v[j] * rstd * A[j];
    }
}

typedef short v4i16_t __attribute__((ext_vector_type(4)));
__device__ __forceinline__ u32x2 tr_read(const LAS bf16_t* p) { return __builtin_bit_cast(u32x2, __builtin_amdgcn_ds_read_tr16_b64_v4i16((LAS v4i16_t*)p)); }

constexpr float ATT_C1 = 0.125f * 1.4426950408889634f;
template <bool MASK, int KT_LO, int KT_HI>
__device__ __forceinline__ void attn_chunk(const int kc, const LAS bf16_t* Ks, const LAS bf16_t* Vs, bf16x8 (&qf)[2][2], f32x4 (&o)[4][2], float (&m_run)[2], float (&l_run)[2],
                                           const float fbase, const float sl8, const int fr, const int fq, const int troff, const bool q_reload, const bf16_t* qnext) {
    f32x4 s[4][2];
    float fb = fbase; asm volatile("" : "+v"(fb));
#pragma unroll
    for (int kt = KT_LO; kt < KT_HI; ++kt) { const LAS bf16_t* kp = Ks + (kc * 64 + kt * 16 + fr) * 72 + fq * 8;
        const bf16x8 a0 = *(const LAS bf16x8*)kp, a1 = *(const LAS bf16x8*)(kp + 32);
#pragma unroll
        for (int qt = 0; qt < 2; ++qt) { const f32x4 z = {0.f, 0.f, 0.f, 0.f}; s[kt][qt] = mfma16(a1, qf[qt][1], mfma16(a0, qf[qt][0], z)); } }
    if (q_reload) {
#pragma unroll
        for (int qt = 0; qt < 2; ++qt)
#pragma unroll
            for (int kk = 0; kk < 2; ++kk) qf[qt][kk] = *(const bf16x8*)(qnext + (size_t)qt * 16 * NPROJ + kk * 32); }
    unsigned pb[2][4][2];
#pragma unroll
    for (int qt = 0; qt < 2; ++qt) {
        float cmax = -1e30f;
#pragma unroll
        for (int kt = KT_LO; kt < KT_HI; ++kt)
#pragma unroll
            for (int i = 0; i < 4; ++i) { const float rel = fb + (float)(kc * 64 + kt * 16 + i - qt * 16); const float ar = fabsf(rel);
                float lg = fmaf(-sl8, ar, s[kt][qt][i]); if (MASK) lg = (ar <= 128.0f) ? lg : -1e30f; s[kt][qt][i] = lg; cmax = fmaxf(cmax, lg); }
        cmax = quad_max(cmax);
        const float m_new = fmaxf(m_run[qt], cmax), alpha = __builtin_amdgcn_exp2f((m_run[qt] - m_new) * ATT_C1), mc = m_new * ATT_C1; m_run[qt] = m_new;
        float psum = 0.f;
#pragma unroll
        for (int kt = KT_LO; kt < KT_HI; ++kt) { float p[4];
#pragma unroll
            for (int i = 0; i < 4; ++i) { p[i] = __builtin_amdgcn_exp2f(fmaf(s[kt][qt][i], ATT_C1, -mc)); psum += p[i]; }
            pb[qt][kt][0] = pk2(p[0], p[1]); pb[qt][kt][1] = pk2(p[2], p[3]); }
        l_run[qt] = l_run[qt] * alpha + psum;
#pragma unroll
        for (int dt = 0; dt < 4; ++dt) o[dt][qt] *= alpha;
    }
#pragma unroll
    for (int ks = KT_LO / 2; ks < KT_HI / 2; ++ks)
#pragma unroll
        for (int dt = 0; dt < 4; ++dt) { const LAS bf16_t* vp = Vs + (kc * 64 + ks * 32) * 80 + troff + dt * 16;
            const u32x2 lo = tr_read(vp), hi = tr_read(vp + 16 * 80); const bf16x8 a = mk8(lo.x, lo.y, hi.x, hi.y);
#pragma unroll
            for (int qt = 0; qt < 2; ++qt) o[dt][qt] = mfma16(a, mk8(pb[qt][2 * ks][0], pb[qt][2 * ks][1], pb[qt][2 * ks + 1][0], pb[qt][2 * ks + 1][1]), o[dt][qt]); }
}

__device__ __forceinline__ void attn_phase(const Params& P, LAS unsigned char* lds, int tid, int wave, int lane, const bool do_atomic) {
    LAS bf16_t* Ks = (LAS bf16_t*)lds;
    LAS bf16_t* Vs = (LAS bf16_t*)(lds + 46080);
    const bf16_t* PROJ = (const bf16_t*)(P.ws + WS_PROJ);
    bf16_t* A2 = (bf16_t*)(P.ws + WS_A2); float* ATTSS = (float*)(P.ws + WS_ATTSS);
    const int fr = lane & 15, fq = lane >> 4, g = wave >> 1, r = wave & 1;
    const int troff = (fq * 4 + ((lane >> 2) & 3)) * 80 + (lane & 3) * 4;
    const float fbase = (float)(fq * 4 - 128 - r * 32 - fr);
    const int G = gridDim.x;
    int u = (G % 8 == 0) ? ((int)blockIdx.x % 8) * (G / 8) + (int)blockIdx.x / 8 : (int)blockIdx.x; if (u >= NB * (SEQ / 64)) return;
    u32x4 rk[5], rv[5];
#define AT_LOADS(uu, kvh_) do { const int b_ = (uu) >> 7, t0_ = ((uu) & 127) * 64, kb_ = t0_ - 128; \
        _Pragma("unroll") for (int i = 0; i < 5; ++i) { const int cidx = tid + 512 * i, key = cidx >> 3, part = cidx & 7, tok = kb_ + key; const u32x4 z = {0u, 0u, 0u, 0u}; rk[i] = z; rv[i] = z; \
            if (tok >= 0 && tok < SEQ) { const bf16_t* rowp = PROJ + (size_t)(b_ * SEQ + tok) * NPROJ; rk[i] = *(const u32x4*)(rowp + 512 + (kvh_) * 64 + part * 8); rv[i] = *(const u32x4*)(rowp + 640 + (kvh_) * 64 + part * 8); } } \
        } while (0)
    AT_LOADS(u, 0);
    bf16x8 qf[2][2];
    { const int b0 = u >> 7, t00 = (u & 127) * 64;
#pragma unroll
      for (int qt = 0; qt < 2; ++qt)
#pragma unroll
          for (int kk = 0; kk < 2; ++kk) qf[qt][kk] = *(const bf16x8*)(PROJ + (size_t)(b0 * SEQ + t00 + r * 32 + qt * 16 + fr) * NPROJ + g * 64 + kk * 32 + fq * 8); }
    for (;;) {
        const int b = u >> 7, qb = u & 127, t0 = qb * 64;
        const int kc_lo = qb == 0 ? 2 : (qb == 1 ? 1 : 0), kc_hi = qb == 127 ? 3 : (qb == 126 ? 4 : 5);
        const int un = u + G; const bool more = un < NB * (SEQ / 64);
#pragma unroll 1
        for (int kvh = 0; kvh < 2; ++kvh) {
            __syncthreads();
#pragma unroll
            for (int i = 0; i < 5; ++i) { const int cidx = tid + 512 * i, key = cidx >> 3, part = cidx & 7; *(LAS u32x4*)(Ks + key * 72 + part * 8) = rk[i]; *(LAS u32x4*)(Vs + key * 80 + part * 8) = rv[i]; }
            __syncthreads();
            const bool qnx = (kvh == 0) || more; const int un_b = un >> 7, un_t0 = (un & 127) * 64;
            const bf16_t* qnext = (kvh == 0) ? PROJ + (size_t)(b * SEQ + t0 + r * 32 + fr) * NPROJ + (4 + g) * 64 + fq * 8
                                             : PROJ + (size_t)(un_b * SEQ + un_t0 + r * 32 + fr) * NPROJ + g * 64 + fq * 8;
            if (!qnx) qnext = PROJ;
            if (kvh == 0) { AT_LOADS(u, 1); } else if (more) { AT_LOADS(un, 0); }
            const int h = kvh * 4 + g;
            const float sl8 = 8.0f * exp2f(-(float)(h + 1));
            float m_run[2], l_run[2]; f32x4 o[4][2];
#pragma unroll
            for (int qt = 0; qt < 2; ++qt) { m_run[qt] = 8.0f * P.sink[h]; l_run[qt] = (fq == 0) ? 1.0f : 0.0f;
#pragma unroll
                for (int dt = 0; dt < 4; ++dt) o[dt][qt] = (f32x4){0.f, 0.f, 0.f, 0.f}; }
            if (r == 0) {
                if (kc_lo <= 0) attn_chunk<true, 0, 4>(0, Ks, Vs, qf, o, m_run, l_run, fbase, sl8, fr, fq, troff, qnx && (kc_hi == 1), qnext);
                if (kc_lo <= 1) attn_chunk<false, 0, 4>(1, Ks, Vs, qf, o, m_run, l_run, fbase, sl8, fr, fq, troff, qnx && (kc_hi == 2), qnext);
                attn_chunk<false, 0, 4>(2, Ks, Vs, qf, o, m_run, l_run, fbase, sl8, fr, fq, troff, qnx && (kc_hi == 3), qnext);
                if (kc_hi > 3) attn_chunk<false, 0, 4>(3, Ks, Vs, qf, o, m_run, l_run, fbase, sl8, fr, fq, troff, qnx && (kc_hi == 4), qnext);
                if (kc_hi > 4) attn_chunk<true, 0, 2>(4, Ks, Vs, qf, o, m_run, l_run, fbase, sl8, fr, fq, troff, qnx && (kc_hi == 5), qnext);
            } else {
                if (kc_lo <= 0) attn_chunk<true, 2, 4>(0, Ks, Vs, qf, o, m_run, l_run, fbase, sl8, fr, fq, troff, qnx && (kc_hi == 1), qnext);
                if (kc_lo <= 1) attn_chunk<false, 0, 4>(1, Ks, Vs, qf, o, m_run, l_run, fbase, sl8, fr, fq, troff, qnx && (kc_hi == 2), qnext);
                attn_chunk<false, 0, 4>(2, Ks, Vs, qf, o, m_run, l_run, fbase, sl8, fr, fq, troff, qnx && (kc_hi == 3), qnext);
                if (kc_hi > 3) attn_chunk<false, 0, 4>(3, Ks, Vs, qf, o, m_run, l_run, fbase, sl8, fr, fq, troff, qnx && (kc_hi == 4), qnext);
                if (kc_hi > 4) attn_chunk<true, 0, 4>(4, Ks, Vs, qf, o, m_run, l_run, fbase, sl8, fr, fq, troff, qnx && (kc_hi == 5), qnext);
            }
#pragma unroll
            for (int qt = 0; qt < 2; ++qt) { const float inv = 1.0f / quad_sum(l_run[qt]); float ss = 0.f;
                const int rr = r * 32 + qt * 16 + fr; const size_t mrow = (size_t)(b * SEQ + t0 + rr);
                bf16_t* orow = A2 + mrow * D;
#pragma unroll
                for (int dt = 0; dt < 4; ++dt) { const f32x4 v = o[dt][qt] * inv; ss += (v[0] * v[0] + v[1] * v[1]) + (v[2] * v[2] + v[3] * v[3]);
                    const int col = h * 64 + dt * 16 + fq * 4; const f32x4 gv = *(const f32x4*)(P.g_attn_out + col); const f32x4 w4 = v * gv;
                    u32x2 w; w.x = pk2(w4[0], w4[1]); w.y = pk2(w4[2], w4[3]); *(u32x2*)(orow + col) = w; }
                ss = quad_sum(ss);
                if (fq == 0 && do_atomic) __hip_atomic_fetch_add(ATTSS + mrow, ss, __ATOMIC_RELAXED, __HIP_MEMORY_SCOPE_AGENT); }
        }
        if (!more) break;
        u = un;
    }
#undef AT_LOADS
}

__device__ __forceinline__ float scan_up_add(float v, int lane) {
#pragma unroll
    for (int o = 1; o < 64; o <<= 1) { const float t = __shfl_up(v, o); v += (lane >= o) ? t : 0.f; }
    return v;
}
__device__ __forceinline__ float scan_down_add(float v, int lane) {
#pragma unroll
    for (int o = 1; o < 64; o <<= 1) { const float t = __shfl_down(v, o); v += (lane + o < 64) ? t : 0.f; }
    return v;
}
__device__ __forceinline__ float scan_up_max(float v, int lane) {
#pragma unroll
    for (int o = 1; o < 64; o <<= 1) { const float t = __shfl_up(v, o); v = (lane >= o) ? fmaxf(v, t) : v; }
    return v;
}
__device__ __forceinline__ float scan_down_max(float v, int lane) {
#pragma unroll
    for (int o = 1; o < 64; o <<= 1) { const float t = __shfl_down(v, o); v = (lane + o < 64) ? fmaxf(v, t) : v; }
    return v;
}
__device__ __forceinline__ float wave_max(float v) {
#pragma unroll
    for (int o = 1; o < 64; o <<= 1) v = fmaxf(v, __shfl_xor(v, o));
    return v;
}
__device__ __forceinline__ void conv8(const u32x4& x0, const u32x4& x1, const u32x4& x2, const float* cw, const float* cb, int ch0, float (&r8)[8]) {
#pragma unroll
    for (int e2 = 0; e2 < 2; ++e2) { const f32x4 w0 = *(const f32x4*)(cw + ch0 + 4 * e2), w1 = *(const f32x4*)(cw + 1024 + ch0 + 4 * e2), w2 = *(const f32x4*)(cw + 2048 + ch0 + 4 * e2), bb = *(const f32x4*)(cb + ch0 + 4 * e2);
#pragma unroll
        for (int e = 0; e < 4; ++e) { const int ee = e2 * 4 + e; const unsigned sh = 16 * (ee & 1);
            const float a0 = bf2f((x0[ee >> 1] >> sh) & 0xffffu), a1 = bf2f((x1[ee >> 1] >> sh) & 0xffffu), a2 = bf2f((x2[ee >> 1] >> sh) & 0xffffu);
            float v = a0 * w0[e]; v += a1 * w1[e]; v += a2 * w2[e]; v += bb[e]; r8[ee] = silu_f(v); } }
}
__device__ __forceinline__ void mstate_unit(const Params& P, LAS unsigned char* lds, int unit, int tid, int wave, int lane) {
    const int b = unit >> 8, c = (unit >> 2) & 63, h = unit & 3;
    LAS bf16_t* Kwf = (LAS bf16_t*)lds; LAS bf16_t* Kwb = (LAS bf16_t*)(lds + 36864); LAS bf16_t* Vs = (LAS bf16_t*)(lds + 73728);
    LAS float* wf = (LAS float*)(lds + 110592); LAS float* wb = wf + 128;
    unsigned char* ws = P.ws;
    const bf16_t* PROJ = (const bf16_t*)(ws + WS_PROJ); const float* GATES = (const float*)(ws + WS_GATES);
    float* GV = (float*)(ws + WS_GV); float* SC = (float*)(ws + WS_SC); float* NC = (float*)(ws + WS_NC); bf16_t* KVC = (bf16_t*)P.out;
    bf16_t* QM = (bf16_t*)(ws + WS_QM); bf16_t* KM = (bf16_t*)(ws + WS_KM);
    const size_t m0 = (size_t)b * SEQ + (size_t)c * 128;
    const int fr = lane & 15, fq = lane >> 4;
    __syncthreads();
    float gi0 = 0.f, gf0 = 0.f, gi1 = 0.f, gf1 = 0.f;
    if (wave < 2) { const float* gp = GATES + (m0 + lane) * 16 + wave * 8 + h; gi0 = gp[0]; gf0 = gp[4]; gi1 = gp[64 * 16]; gf1 = gp[64 * 16 + 4]; }
    u32x4 xk[3][3], xv[3];
#define MS_LOAD(it, j) do { const int idx = tid + 512 * (it), s = idx >> 4, part = idx & 15; const int t = c * 128 + s; const bf16_t* rowm = PROJ + (m0 + s) * NPROJ; \
        const int pk = 1280 + h * 128 + part * 8; const u32x4 z = {0u, 0u, 0u, 0u}; \
        xk[j][1] = *(const u32x4*)(rowm + pk); xv[j] = *(const u32x4*)(rowm + 1792 + h * 128 + part * 8); \
        xk[j][0] = z; xk[j][2] = z; \
        if (t > 0) { xk[j][0] = *(const u32x4*)(rowm - NPROJ + pk); } \
        if (t < SEQ - 1) { xk[j][2] = *(const u32x4*)(rowm + NPROJ + pk); } } while (0)
    MS_LOAD(0, 0); MS_LOAD(1, 1);
    if (wave < 2) {
        const float l0 = logsig_f(gf0), l1 = logsig_f(gf1); float p0, p1, tot;
        if (wave == 0) { p0 = scan_up_add(l0, lane); const float t0 = __shfl(p0, 63); p1 = scan_up_add(l1, lane) + t0; tot = __shfl(p1, 63); }
        else { p1 = scan_down_add(l1, lane); const float t1 = __shfl(p1, 0); p0 = scan_down_add(l0, lane) + t1; tot = __shfl(p0, 0); }
        const float u0 = gi0 - p0, u1 = gi1 - p1; const float umax = wave_max(fmaxf(u0, u1));
        LAS float* wv = wave ? wb : wf; wv[lane] = __expf(u0 - umax); wv[64 + lane] = __expf(u1 - umax);
        float* gv = GV + (size_t)unit * 512 + wave * 128; gv[lane] = u0; gv[64 + lane] = u1; gv[256 + lane] = p0; gv[256 + 64 + lane] = p1;
        if (lane == 0) { float* sc = SC + unit * 4 + wave * 2; sc[0] = tot; sc[1] = tot + umax; }
    }
    __syncthreads();
#define MS_COMPUTE(it, j) do { const int idx = tid + 512 * (it), s = idx >> 4, part = idx & 15; const float wfs = wf[s], wbs = wb[s]; float r8[8]; \
        conv8(xk[j][0], xk[j][1], xk[j][2], P.conv_w, P.conv_b, 512 + h * 128 + part * 8, r8); \
        { u32x4 w; w.x = pk2(r8[0], r8[1]); w.y = pk2(r8[2], r8[3]); w.z = pk2(r8[4], r8[5]); w.w = pk2(r8[6], r8[7]); *(u32x4*)(KM + (m0 + s) * 512 + h * 128 + part * 8) = w; \
          u32x4 a; a.x = pk2(r8[0] * wfs, r8[1] * wfs); a.y = pk2(r8[2] * wfs, r8[3] * wfs); a.z = pk2(r8[4] * wfs, r8[5] * wfs); a.w = pk2(r8[6] * wfs, r8[7] * wfs); *(LAS u32x4*)(Kwf + s * 144 + part * 8) = a; \
          u32x4 bq; bq.x = pk2(r8[0] * wbs, r8[1] * wbs); bq.y = pk2(r8[2] * wbs, r8[3] * wbs); bq.z = pk2(r8[4] * wbs, r8[5] * wbs); bq.w = pk2(r8[6] * wbs, r8[7] * wbs); *(LAS u32x4*)(Kwb + s * 144 + part * 8) = bq; } \
        *(LAS u32x4*)(Vs + s * 144 + part * 8) = xv[j]; } while (0)
    MS_LOAD(2, 2); MS_COMPUTE(0, 0);
    MS_LOAD(3, 0); MS_COMPUTE(1, 1);
    MS_COMPUTE(2, 2); MS_COMPUTE(3, 0);
#undef MS_LOAD
#undef MS_COMPUTE
    __syncthreads();
    {
        const int dir = wave >> 2, wq = wave & 3, vt0 = wq * 2; const LAS bf16_t* Kw = dir ? Kwb : Kwf;
        const int troff = (fq * 4 + ((lane >> 2) & 3)) * 144 + (lane & 3) * 4;
        const unsigned onev = (fr == 0) ? 0x3f803f80u : 0u; const bf16x8 ones = mk8(onev, onev, onev, onev);
        f32x4 acc[2][8], nacc[2];
#pragma unroll
        for (int vi = 0; vi < 2; ++vi) { nacc[vi] = (f32x4){0.f, 0.f, 0.f, 0.f};
#pragma unroll
            for (int kt = 0; kt < 8; ++kt) acc[vi][kt] = (f32x4){0.f, 0.f, 0.f, 0.f}; }
#pragma unroll
        for (int ks = 0; ks < 4; ++ks) { const LAS bf16_t* vp = Vs + ks * 32 * 144 + troff + vt0 * 16; const LAS bf16_t* kp = Kw + ks * 32 * 144 + troff;
            const u32x2 l0 = tr_read(vp), h0 = tr_read(vp + 16 * 144), l1 = tr_read(vp + 16), h1 = tr_read(vp + 16 * 144 + 16);
            const bf16x8 a0 = mk8(l0.x, l0.y, h0.x, h0.y), a1 = mk8(l1.x, l1.y, h1.x, h1.y);
#pragma unroll
            for (int kt = 0; kt < 8; ++kt) { const u32x2 bl = tr_read(kp + kt * 16), bh = tr_read(kp + 16 * 144 + kt * 16); const bf16x8 bb = mk8(bl.x, bl.y, bh.x, bh.y);
                acc[0][kt] = mfma16(a0, bb, acc[0][kt]); acc[1][kt] = mfma16(a1, bb, acc[1][kt]);
                if ((kt >> 1) == wq) nacc[kt & 1] = mfma16(ones, bb, nacc[kt & 1]); } }
        bf16_t* outp = KVC + (size_t)(unit * 2 + dir) * 16384;
#pragma unroll
        for (int vi = 0; vi < 2; ++vi)
#pragma unroll
            for (int kt = 0; kt < 8; ++kt)
#pragma unroll
                for (int i = 0; i < 4; i += 2) { const unsigned pq = pk2(acc[vi][kt][i], acc[vi][kt][i + 1]);
                    outp[((vt0 + vi) * 16 + fq * 4 + i) * 128 + kt * 16 + fr] = (bf16_t)(pq & 0xffffu); outp[((vt0 + vi) * 16 + fq * 4 + i + 1) * 128 + kt * 16 + fr] = (bf16_t)(pq >> 16); }
        if (fq == 0) { float* np = NC + (size_t)(unit * 2 + dir) * 128 + wq * 32 + fr; np[0] = nacc[0][0]; np[16] = nacc[1][0]; }
    }
}

__device__ __forceinline__ void mstate_pair(const Params& P, LAS unsigned char* lds, int uA, int uB, int tid, int wave, int lane) {
    const int grp = wave >> 2, wv = wave & 3, tg = tid & 255;
    const int unit = grp ? uB : uA;
    const int b = unit >> 8, c = (unit >> 2) & 63, h = unit & 3;
    LAS unsigned char* gl = lds + grp * 75776;
    LAS bf16_t* Kr = (LAS bf16_t*)gl; LAS bf16_t* Vs = (LAS bf16_t*)(gl + 36864);
    LAS float* wf = (LAS float*)(gl + 73728); LAS float* wb = wf + 128;
    unsigned char* ws = P.ws;
    const bf16_t* PROJ = (const bf16_t*)(ws + WS_PROJ); const float* GATES = (const float*)(ws + WS_GATES);
    float* GV = (float*)(ws + WS_GV); float* SC = (float*)(ws + WS_SC); float* NC = (float*)(ws + WS_NC); bf16_t* KVC = (bf16_t*)P.out;
    bf16_t* KM = (bf16_t*)(ws + WS_KM);
    const size_t m0 = (size_t)b * SEQ + (size_t)c * 128;
    const int fr = lane & 15, fq = lane >> 4;
    __syncthreads();
    float gi0 = 0.f, gf0 = 0.f, gi1 = 0.f, gf1 = 0.f;
    if (wv < 2) { const float* gp = GATES + (m0 + lane) * 16 + wv * 8 + h; gi0 = gp[0]; gf0 = gp[4]; gi1 = gp[64 * 16]; gf1 = gp[64 * 16 + 4]; }
    u32x4 xk[3][3], xv[3];
#define MP_LOAD(it, j) do { const int idx = tg + 256 * (it), s = idx >> 4, part = idx & 15; const int t = c * 128 + s; const bf16_t* rowm = PROJ + (m0 + s) * NPROJ; \
        const int pk = 1280 + h * 128 + part * 8; const u32x4 z = {0u, 0u, 0u, 0u}; \
        xk[j][1] = *(const u32x4*)(rowm + pk); xv[j] = *(const u32x4*)(rowm + 1792 + h * 128 + part * 8); \
        xk[j][0] = z; xk[j][2] = z; \
        if (t > 0) { xk[j][0] = *(const u32x4*)(rowm - NPROJ + pk); } \
        if (t < SEQ - 1) { xk[j][2] = *(const u32x4*)(rowm + NPROJ + pk); } } while (0)
#define MP_COMPUTE(it, j) do { const int idx = tg + 256 * (it), s = idx >> 4, part = idx & 15; float r8[8]; \
        conv8(xk[j][0], xk[j][1], xk[j][2], P.conv_w, P.conv_b, 512 + h * 128 + part * 8, r8); \
        { u32x4 w; w.x = pk2(r8[0], r8[1]); w.y = pk2(r8[2], r8[3]); w.z = pk2(r8[4], r8[5]); w.w = pk2(r8[6], r8[7]); *(u32x4*)(KM + (m0 + s) * 512 + h * 128 + part * 8) = w; \
          *(LAS u32x4*)(Kr + s * 144 + part * 8) = w; } \
        *(LAS u32x4*)(Vs + s * 144 + part * 8) = xv[j]; } while (0)
    MP_LOAD(0, 0); MP_LOAD(1, 1);
    if (wv < 2) {
        const float l0 = logsig_f(gf0), l1 = logsig_f(gf1); float p0, p1, tot;
        if (wv == 0) { p0 = scan_up_add(l0, lane); const float t0 = __shfl(p0, 63); p1 = scan_up_add(l1, lane) + t0; tot = __shfl(p1, 63); }
        else { p1 = scan_down_add(l1, lane); const float t1 = __shfl(p1, 0); p0 = scan_down_add(l0, lane) + t1; tot = __shfl(p0, 0); }
        const float u0 = gi0 - p0, u1 = gi1 - p1; const float umax = wave_max(fmaxf(u0, u1));
        LAS float* wvp = wv ? wb : wf; wvp[lane] = __expf(u0 - umax); wvp[64 + lane] = __expf(u1 - umax);
        float* gv = GV + (size_t)unit * 512 + wv * 128; gv[lane] = u0; gv[64 + lane] = u1; gv[256 + lane] = p0; gv[256 + 64 + lane] = p1;
        if (lane == 0) { float* sc = SC + unit * 4 + wv * 2; sc[0] = tot; sc[1] = tot + umax; }
    }
    MP_LOAD(2, 2); MP_COMPUTE(0, 0);
    MP_LOAD(3, 0); MP_COMPUTE(1, 1);
    MP_LOAD(4, 1); MP_COMPUTE(2, 2);
    MP_LOAD(5, 2); MP_COMPUTE(3, 0);
    MP_LOAD(6, 0); MP_COMPUTE(4, 1);
    MP_LOAD(7, 1); MP_COMPUTE(5, 2);
    MP_COMPUTE(6, 0); MP_COMPUTE(7, 1);
#undef MP_LOAD
#undef MP_COMPUTE
    __syncthreads();
    const int vt0 = wv * 2;
    const int troff = (fq * 4 + ((lane >> 2) & 3)) * 144 + (lane & 3) * 4;
#pragma unroll 1
    for (int dir = 0; dir < 2; ++dir) {
        const LAS float* wd = dir ? wb : wf;
        f32x4 acc[2][8], nacc[2];
#pragma unroll
        for (int vi = 0; vi < 2; ++vi) { nacc[vi] = (f32x4){0.f, 0.f, 0.f, 0.f};
#pragma unroll
            for (int kt = 0; kt < 8; ++kt) acc[vi][kt] = (f32x4){0.f, 0.f, 0.f, 0.f}; }
#pragma unroll
        for (int ks = 0; ks < 4; ++ks) { const LAS bf16_t* vp = Vs + ks * 32 * 144 + troff + vt0 * 16; const LAS bf16_t* kp = Kr + ks * 32 * 144 + troff;
            const f32x4 wlo = *(const LAS f32x4*)(wd + ks * 32 + fq * 4), whi = *(const LAS f32x4*)(wd + ks * 32 + 16 + fq * 4);
            bf16x8 a[2];
#pragma unroll
            for (int vi = 0; vi < 2; ++vi) { const u32x2 lo = tr_read(vp + vi * 16), hi = tr_read(vp + 16 * 144 + vi * 16);
                a[vi] = mk8(pk2(bf2f(lo.x & 0xffffu) * wlo[0], bf2f(lo.x >> 16) * wlo[1]), pk2(bf2f(lo.y & 0xffffu) * wlo[2], bf2f(lo.y >> 16) * wlo[3]),
                            pk2(bf2f(hi.x & 0xffffu) * whi[0], bf2f(hi.x >> 16) * whi[1]), pk2(bf2f(hi.y & 0xffffu) * whi[2], bf2f(hi.y >> 16) * whi[3])); }
            const bf16x8 onesw = (fr == 0) ? mk8(pk2(wlo[0], wlo[1]), pk2(wlo[2], wlo[3]), pk2(whi[0], whi[1]), pk2(whi[2], whi[3])) : mk8(0u, 0u, 0u, 0u);
#pragma unroll
            for (int kt = 0; kt < 8; ++kt) { const u32x2 bl = tr_read(kp + kt * 16), bh = tr_read(kp + 16 * 144 + kt * 16); const bf16x8 bb = mk8(bl.x, bl.y, bh.x, bh.y);
                acc[0][kt] = mfma16(a[0], bb, acc[0][kt]); acc[1][kt] = mfma16(a[1], bb, acc[1][kt]);
                if ((kt >> 1) == wv) nacc[kt & 1] = mfma16(onesw, bb, nacc[kt & 1]); } }
        bf16_t* outp = KVC + (size_t)(unit * 2 + dir) * 16384;
#pragma unroll
        for (int vi = 0; vi < 2; ++vi)
#pragma unroll
            for (int kt = 0; kt < 8; ++kt)
#pragma unroll
                for (int i = 0; i < 4; i += 2) { const unsigned pq = pk2(acc[vi][kt][i], acc[vi][kt][i + 1]);
                    outp[((vt0 + vi) * 16 + fq * 4 + i) * 128 + kt * 16 + fr] = (bf16_t)(pq & 0xffffu); outp[((vt0 + vi) * 16 + fq * 4 + i + 1) * 128 + kt * 16 + fr] = (bf16_t)(pq >> 16); }
        if (fq == 0) { float* np = NC + (size_t)(unit * 2 + dir) * 128 + wv * 32 + fr; np[0] = nacc[0][0]; np[16] = nacc[1][0]; }
    }
}

__device__ __forceinline__ void scan_phase(const Params& P, int tid) {
    unsigned char* ws = P.ws;
    const bf16_t* KVC = (const bf16_t*)P.out; const float* SC = (const float*)(ws + WS_SC); const float* NC = (const float*)(ws + WS_NC);
    bf16_t* CPREV = (bf16_t*)(ws + WS_XN); float* NPREV = (float*)(ws + WS_NPREV); float* MPREV = (float*)(ws + WS_MPREV);
    for (int blk = blockIdx.x; blk < 256; blk += gridDim.x) {
        const int seq = blk >> 4, e2 = (blk & 15) * NTHREADS + tid, b = seq >> 3, h = (seq >> 1) & 3, dir = seq & 1;
        const int off = (e2 >> 6) * 128 + (e2 & 63) * 2;
        const bool do_n = e2 < 128;
        float c0 = 0.f, c1 = 0.f, nst = 0.f, mst = 0.f;
        for (int jb = 0; jb < 64; jb += 16) {
            f32x2_t kv[16]; float bl[16], am[16], nn[16];
#pragma unroll
            for (int u = 0; u < 16; ++u) { const int j = jb + u, cidx = dir ? 63 - j : j, unit = (b * 64 + cidx) * 4 + h;
                { const unsigned pq = __builtin_nontemporal_load((const unsigned*)(KVC + (size_t)(unit * 2 + dir) * 16384 + off)); kv[u] = (f32x2_t){bf2f(pq & 0xffffu), bf2f(pq >> 16)}; }
                bl[u] = SC[unit * 4 + dir * 2]; am[u] = SC[unit * 4 + dir * 2 + 1]; nn[u] = do_n ? NC[(size_t)(unit * 2 + dir) * 128 + e2] : 0.f; }
#pragma unroll
            for (int u = 0; u < 16; ++u) { const int j = jb + u, cidx = dir ? 63 - j : j, unit = (b * 64 + cidx) * 4 + h;
                *(unsigned*)(CPREV + (size_t)(unit * 2 + dir) * 16384 + off) = pk2(c0, c1);
                if (do_n) NPREV[(size_t)(unit * 2 + dir) * 128 + e2] = nst;
                if (e2 == 0) MPREV[unit * 2 + dir] = mst;
                const float m_new = fmaxf(bl[u] + mst, am[u]); const float dec = __expf(bl[u] + mst - m_new), inj = __expf(am[u] - m_new);
                c0 = dec * c0 + inj * kv[u][0]; c1 = dec * c1 + inj * kv[u][1]; nst = dec * nst + inj * nn[u]; mst = m_new; }
        }
    }
}

__device__ __forceinline__ void mout_unit(const Params& P, LAS unsigned char* lds, int unit, int tid, int wave, int lane) {
    const int b = unit >> 8, c = (unit >> 2) & 63, h = unit & 3;
    LAS bf16_t* Ks = (LAS bf16_t*)lds;
    LAS bf16_t* Vs = (LAS bf16_t*)(lds + 34816);
    LAS bf16_t* Cf = (LAS bf16_t*)(lds + 71680);
    LAS bf16_t* Cb = (LAS bf16_t*)(lds + 106496);
    LAS float* fa = (LAS float*)(lds + 141312);
    LAS float* uf = fa; LAS float* ub = fa + 128; LAS float* Mf = fa + 256; LAS float* Mb = fa + 384; LAS float* inf_ = fa + 512; LAS float* inb = fa + 640;
    LAS float* emf = fa + 768; LAS float* emb = fa + 896; LAS float* npf = fa + 1024; LAS float* npb = fa + 1152;
    unsigned char* ws = P.ws;
    const bf16_t* PROJ = (const bf16_t*)(ws + WS_PROJ); const bf16_t* QM = (const bf16_t*)(ws + WS_QM); const bf16_t* KM = (const bf16_t*)(ws + WS_KM);
    const bf16_t* CPREV = (const bf16_t*)(ws + WS_XN); const float* NPREV = (const float*)(ws + WS_NPREV); const float* MPREV = (const float*)(ws + WS_MPREV);
    const float* GV = (const float*)(ws + WS_GV); bf16_t* A2 = (bf16_t*)(ws + WS_A2);
    const size_t m0 = (size_t)b * SEQ + (size_t)c * 128;
    const int fr = lane & 15, fq = lane >> 4;
    const int t = wave * 16 + fr;
    __syncthreads();
    u32x4 rk[4], rv[4], rcf[4], rcb[4];
#pragma unroll
    for (int it = 0; it < 4; ++it) { const int idx = tid + 512 * it, s = idx >> 4, part = idx & 15;
        rk[it] = *(const u32x4*)(KM + (m0 + s) * 512 + h * 128 + part * 8); rv[it] = *(const u32x4*)(PROJ + (m0 + s) * NPROJ + 1792 + h * 128 + part * 8);
        rcf[it] = __builtin_nontemporal_load((const u32x4*)(CPREV + (size_t)(unit * 2) * 16384 + s * 128 + part * 8)); rcb[it] = __builtin_nontemporal_load((const u32x4*)(CPREV + (size_t)(unit * 2 + 1) * 16384 + s * 128 + part * 8)); }
    u32x4 xq[4][3];
    { const int pos = c * 128 + t; const bf16_t* rowq = PROJ + (m0 + t) * NPROJ + 768 + h * 128 + fq * 8;
#pragma unroll
      for (int kk = 0; kk < 4; ++kk) { const u32x4 z = {0u, 0u, 0u, 0u}; xq[kk][1] = *(const u32x4*)(rowq + kk * 32); xq[kk][0] = z; xq[kk][2] = z;
          if (pos > 0) xq[kk][0] = *(const u32x4*)(rowq - NPROJ + kk * 32); if (pos < SEQ - 1) xq[kk][2] = *(const u32x4*)(rowq + NPROJ + kk * 32); } }
    if (wave < 2) {
        const float* gv = GV + (size_t)unit * 512 + wave * 128; const float u0 = gv[lane], u1 = gv[64 + lane], bc0 = gv[256 + lane], bc1 = gv[256 + 64 + lane];
        const float mp = MPREV[unit * 2 + wave]; float a0, a1;
        if (wave == 0) { a0 = fmaxf(scan_up_max(u0, lane), mp); const float cr = __shfl(a0, 63); a1 = fmaxf(scan_up_max(u1, lane), cr); }
        else { a1 = fmaxf(scan_down_max(u1, lane), mp); const float cr = __shfl(a1, 0); a0 = fmaxf(scan_down_max(u0, lane), cr); }
        LAS float* ua = wave ? ub : uf; LAS float* Ma = wave ? Mb : Mf; LAS float* ia = wave ? inb : inf_; LAS float* ea = wave ? emb : emf;
        ua[lane] = u0; ua[64 + lane] = u1; Ma[lane] = a0; Ma[64 + lane] = a1; ia[lane] = __expf(mp - a0); ia[64 + lane] = __expf(mp - a1);
        ea[lane] = __expf(-(bc0 + a0)); ea[64 + lane] = __expf(-(bc1 + a1));
    } else if (wave == 2) { npf[lane] = NPREV[(size_t)(unit * 2) * 128 + lane]; npf[64 + lane] = NPREV[(size_t)(unit * 2) * 128 + 64 + lane];
        npb[lane] = NPREV[(size_t)(unit * 2 + 1) * 128 + lane]; npb[64 + lane] = NPREV[(size_t)(unit * 2 + 1) * 128 + 64 + lane]; }
#pragma unroll
    for (int it = 0; it < 4; ++it) { const int idx = tid + 512 * it, s = idx >> 4, part = idx & 15;
        *(LAS u32x4*)(Ks + s * 136 + part * 8) = rk[it]; *(LAS u32x4*)(Vs + s * 144 + part * 8) = rv[it];
        *(LAS u32x4*)(Cf + s * 136 + part * 8) = rcf[it]; *(LAS u32x4*)(Cb + s * 136 + part * 8) = rcb[it]; }
    __syncthreads();
    bf16x8 qf[4];
#pragma unroll
    for (int kk = 0; kk < 4; ++kk) { float r8[8]; conv8(xq[kk][0], xq[kk][1], xq[kk][2], P.conv_w, P.conv_b, h * 128 + kk * 32 + fq * 8, r8);
        const float sc = 0.08838834764831845f;
        qf[kk] = mk8(pk2(r8[0] * sc, r8[1] * sc), pk2(r8[2] * sc, r8[3] * sc), pk2(r8[4] * sc, r8[5] * sc), pk2(r8[6] * sc, r8[7] * sc)); }
    float qnf = 0.f, qnb = 0.f;
#pragma unroll
    for (int kk = 0; kk < 4; ++kk) { const u32x4 qq = __builtin_bit_cast(u32x4, qf[kk]);
#pragma unroll
        for (int j = 0; j < 8; ++j) { const float qv = bf2f((qq[j >> 1] >> (16 * (j & 1))) & 0xffffu); const int d = kk * 32 + fq * 8 + j; qnf += qv * npf[d]; qnb += qv * npb[d]; } }
    qnf = quad_sum(qnf); qnb = quad_sum(qnb);
    f32x4 sT[8];
#pragma unroll
    for (int st = 0; st < 8; ++st) { f32x4 a = {0.f, 0.f, 0.f, 0.f};
#pragma unroll
        for (int kk = 0; kk < 4; ++kk) a = mfma16(*(const LAS bf16x8*)(Ks + (st * 16 + fr) * 136 + kk * 32 + fq * 8), qf[kk], a);
        sT[st] = a; }
    const int troff = (fq * 4 + ((lane >> 2) & 3)) * 144 + (lane & 3) * 4;
    f32x4 hsum[8];
#pragma unroll
    for (int vt = 0; vt < 8; ++vt) hsum[vt] = (f32x4){0.f, 0.f, 0.f, 0.f};
#pragma unroll 1
    for (int dir = 0; dir < 2; ++dir) {
        f32x4 acc[8];
        const LAS bf16_t* Cp = dir ? Cb : Cf;
#pragma unroll
        for (int vt = 0; vt < 8; ++vt) { f32x4 a = {0.f, 0.f, 0.f, 0.f};
#pragma unroll
            for (int kk = 0; kk < 4; ++kk) a = mfma16(*(const LAS bf16x8*)(Cp + (vt * 16 + fr) * 136 + kk * 32 + fq * 8), qf[kk], a);
            acc[vt] = a; }
        const float inter = dir ? inb[t] : inf_[t], Mt = dir ? Mb[t] : Mf[t];
#pragma unroll
        for (int vt = 0; vt < 8; ++vt) acc[vt] *= inter;
        float den = 0.f; unsigned pk[8][2];
#pragma unroll
        for (int st = 0; st < 8; ++st) { const f32x4 uu = *(const LAS f32x4*)((dir ? ub : uf) + st * 16 + fq * 4); float p[4];
#pragma unroll
            for (int i = 0; i < 4; ++i) { const int s = st * 16 + fq * 4 + i; const bool ok = dir ? (s >= t) : (s <= t); const float w = ok ? __expf(uu[i] - Mt) : 0.f; p[i] = sT[st][i] * w; den += p[i]; }
            pk[st][0] = pk2(p[0], p[1]); pk[st][1] = pk2(p[2], p[3]); }
        den = quad_sum(den) + inter * (dir ? qnb : qnf);
        const int ks_lo = dir ? (wave >> 1) : 0, ks_hi = dir ? 3 : (wave >> 1);
#pragma unroll
        for (int ks = 0; ks < 4; ++ks) if (ks >= ks_lo && ks <= ks_hi) { const bf16x8 bfrag = mk8(pk[2 * ks][0], pk[2 * ks][1], pk[2 * ks + 1][0], pk[2 * ks + 1][1]);
            const LAS bf16_t* vp = Vs + ks * 32 * 144 + troff;
#pragma unroll
            for (int vt = 0; vt < 8; ++vt) { const u32x2 lo = tr_read(vp + vt * 16), hi = tr_read(vp + 16 * 144 + vt * 16);
                acc[vt] = mfma16(mk8(lo.x, lo.y, hi.x, hi.y), bfrag, acc[vt]); } }
        const float rd = 1.0f / fmaxf(fabsf(den), dir ? emb[t] : emf[t]);
#pragma unroll
        for (int vt = 0; vt < 8; ++vt) hsum[vt] += acc[vt] * rd;
    }
    float ss = 0.f;
#pragma unroll
    for (int vt = 0; vt < 8; ++vt) { const f32x4 v = hsum[vt]; ss += (v[0] * v[0] + v[1] * v[1]) + (v[2] * v[2] + v[3] * v[3]); }
    const float rstd = rsqrtf(quad_sum(ss) * (1.0f / 128.0f) + EPS) * sqrtf(((const float*)(ws + WS_ATTSS))[m0 + t] * (1.0f / 512.0f) + EPS);
#pragma unroll
    for (int vt = 0; vt < 8; ++vt) { const int v0 = h * 128 + vt * 16 + fq * 4; const f32x4 gv = *(const f32x4*)(P.g_mlstm_out + v0);
        const u32x2 om = *(const u32x2*)(PROJ + (m0 + t) * NPROJ + 2304 + v0);
        const float o0 = sigmoid_f(bf2f(om.x & 0xffffu)), o1 = sigmoid_f(bf2f(om.x >> 16)), o2 = sigmoid_f(bf2f(om.y & 0xffffu)), o3 = sigmoid_f(bf2f(om.y >> 16));
        const f32x4 v = hsum[vt] * rstd * gv; u32x2 w; w.x = pk2(v[0] * o0, v[1] * o1); w.y = pk2(v[2] * o2, v[3] * o3);
        *(u32x2*)(A2 + (m0 + t) * D + 512 + v0) = w; }
}

#define XB_TMO      128
#define XB_XCNT(j)  (256  + 64 * (j))
#define XB_XSUB(j)  (1280 + 64 * (j))
#define XB_XGEN(j)  (2304 + 64 * (j))
#define XB_TOP      3328
#define XB_TOPGEN   3392
#define XCD_BAR_WORDS 3456
#define XB_SPIN_CAP (1u << 18)

__device__ __forceinline__ unsigned xb_ld(unsigned* p)              { return __hip_atomic_load(p, __ATOMIC_RELAXED, __HIP_MEMORY_SCOPE_AGENT); }
__device__ __forceinline__ unsigned xb_add(unsigned* p, unsigned v) { return __hip_atomic_fetch_add(p, v, __ATOMIC_RELAXED, __HIP_MEMORY_SCOPE_AGENT); }
__device__ __forceinline__ unsigned xb_xcc_id() { return (unsigned)__builtin_amdgcn_s_getreg((3 << 11) | 20) & 0xFu; }
#define XB_SPIN(cond, bar) do { unsigned _sp = 0; while (cond) { __builtin_amdgcn_s_sleep(1); \
    if ((++_sp & 255u) == 0u) { if (xb_ld(&(bar)[XB_TMO])) break; if (_sp > XB_SPIN_CAP) { atomicAdd(&(bar)[XB_TMO], 1u); break; } } } } while (0)

struct XcdBarrier {
    unsigned* bar; unsigned x;
    volatile LAS unsigned* st;
};

__device__ __forceinline__ XcdBarrier xcd_barrier_post(unsigned* bar, volatile LAS unsigned* st) {
    XcdBarrier b; b.bar = bar; b.x = xb_xcc_id(); b.st = st;
    if (threadIdx.x == 0) (void)xb_add(&bar[XB_XCNT(b.x)], 1u);
    return b;
}
__device__ __forceinline__ void xcd_barrier_complete(unsigned* bar, unsigned x, unsigned& nloc, unsigned& nx) {
    const unsigned G = gridDim.x * gridDim.y * gridDim.z;
    unsigned sum, cnt, mine, sp = 0u;
    for (;;) {
        sum = 0u; cnt = 0u; mine = 0u;
#pragma unroll
        for (unsigned j = 0; j < 16; ++j) { const unsigned c = xb_ld(&bar[XB_XCNT(j)]); sum += c; cnt += (c > 0u) ? 1u : 0u; mine = (j == x) ? c : mine; }
        if (sum == G) break;
        __builtin_amdgcn_s_sleep(1);
        if ((++sp & 255u) == 0u) { if (xb_ld(&bar[XB_TMO])) break; if (sp > XB_SPIN_CAP) { atomicAdd(&bar[XB_TMO], 1u); break; } }
    }
    nloc = mine > 0u ? mine : 1u; nx = cnt > 0u ? cnt : 1u;
}

__device__ __forceinline__ void xcd_barrier(const XcdBarrier& b) {
    asm volatile("s_waitcnt vmcnt(0)" ::: "memory");
    __syncthreads();
    if (threadIdx.x == 0) {
        unsigned* bar = b.bar;
        __builtin_amdgcn_s_waitcnt(0);
        unsigned nloc = b.st[0], nx = b.st[1];
        if (nloc == 0u) { xcd_barrier_complete(bar, b.x, nloc, nx); b.st[0] = nloc; b.st[1] = nx; }
        const unsigned old = xb_add(&bar[XB_XSUB(b.x)], 1u);
        const unsigned gen = old / nloc;
        if (old + 1u == (gen + 1u) * nloc) {
            __builtin_amdgcn_fence(__ATOMIC_RELEASE, "agent");
            asm volatile("s_waitcnt vmcnt(0)" ::: "memory");
            const unsigned og = xb_add(&bar[XB_TOP], 1u);
            const unsigned tg = og / nx;
            if (og + 1u == (tg + 1u) * nx) xb_add(&bar[XB_TOPGEN], 1u);
            else XB_SPIN(xb_ld(&bar[XB_TOPGEN]) == tg, bar);
            __builtin_amdgcn_fence(__ATOMIC_ACQUIRE, "agent");
            xb_add(&bar[XB_XGEN(b.x)], 1u);
            asm volatile("s_waitcnt vmcnt(0)" ::: "memory");
        } else {
            XB_SPIN(xb_ld(&bar[XB_XGEN(b.x)]) == gen, bar);
            __builtin_amdgcn_fence(__ATOMIC_ACQUIRE, "agent");
            asm volatile("s_waitcnt vmcnt(0)" ::: "memory");
        }
    }
    __syncthreads();
}

__global__ void __launch_bounds__(NTHREADS) hybrid_fwd(Params P) {
    extern __shared__ __attribute__((aligned(16))) unsigned char lds_raw[];
    LAS unsigned char* lds = (LAS unsigned char*)lds_raw;
    cg::grid_group grid = cg::this_grid();
    const int tid = threadIdx.x, lane = tid & 63, wave = __builtin_amdgcn_readfirstlane(tid >> 6);
    volatile LAS unsigned* bst = (volatile LAS unsigned*)(lds + LDS_BYTES - 64);
    if (tid < 2) bst[tid] = 0u;
    __syncthreads();
    XcdBarrier bar = xcd_barrier_post((unsigned*)(P.ws + WS_BAR), bst);
    if (P.ph_lo < 0) grid.sync();
    unsigned char* ws = P.ws;
    const int vcu = ((int)gridDim.x % 8 == 0) ? ((int)blockIdx.x % 8) * ((int)gridDim.x / 8) + (int)blockIdx.x / 8 : (int)blockIdx.x;
    const float* MOD = (const float*)(ws + WS_MOD);
    bf16_t* XN = (bf16_t*)(ws + WS_XN);
#ifndef WGM_P2
#define WGM_P2 8
#endif
#ifndef WGM_P6
#define WGM_P6 8
#endif
#ifndef WGM_P8
#define WGM_P8 2
#endif
#ifndef WGM_P9
#define WGM_P9 8
#endif
#ifndef DUP_MASK
#define DUP_MASK 0
#endif
#ifndef PH_MASK
#define PH_MASK 0x7ff
#endif
#define IN(k) (((PH_MASK >> (k)) & 1) && P.ph_lo <= (k) && (k) < P.ph_hi)
#define SEAM(k) do { if (IN(k) && IN((k) + 1)) xcd_barrier(bar); } while (0)
    if (IN(0)) { for (int rep = 0; rep < 1 + ((DUP_MASK >> 0) & 1); ++rep) { phase0(P, lds, tid, wave, lane); __syncthreads(); } } SEAM(0);
    if (IN(1)) { for (int i = blockIdx.x * NTHREADS + tid; i < M; i += gridDim.x * NTHREADS) { ((float*)(ws + WS_ATTSS))[i] = 0.f; ((float*)(ws + WS_SS2))[i] = 0.f; ((float*)(ws + WS_SS3))[i] = 0.f; }
        for (int rep = 0; rep < 1 + ((DUP_MASK >> 1) & 1); ++rep) norm_mod_phase(P.x, P.g_norm1, MOD, 0, 1024, XN, wave, lane); } SEAM(1);
    if (IN(2)) for (int rep = 0; rep < 1 + ((DUP_MASK >> 2) & 1); ++rep) {
        pg8::Gemm g{XN, (const bf16_t*)(ws + WS_WIN), M, NPROJ, D}; pg8::StaticOrder S; S.init(M, NPROJ, (int)gridDim.x, (int)blockIdx.x, WGM_P2);
        EpiProj E{(bf16_t*)(ws + WS_PROJ), (float*)(ws + WS_GATES), P.b_gates};
        pg8::gemm_phase<EpiProj, pg8::StaticOrder, true, true>(lds, g, S, E);
    } SEAM(2);
    if (IN(3)) {
        for (int rep = 0; rep < 1 + ((DUP_MASK >> 11) & 1); ++rep) attn_phase(P, lds, tid, wave, lane, rep == 0);
        for (int rep = 0; rep < 1 + ((DUP_MASK >> 12) & 1); ++rep)
        for (int u = vcu; u < 256; u += gridDim.x) mstate_pair(P, lds, u, u + 256, tid, wave, lane);
    } SEAM(3);
    if (IN(4)) { for (int rep = 0; rep < 1 + ((DUP_MASK >> 4) & 1); ++rep) scan_phase(P, tid); } SEAM(4);
    if (IN(5)) { for (int rep = 0; rep < 1 + ((DUP_MASK >> 5) & 1); ++rep) for (int u = vcu; u < 512; u += gridDim.x) mout_unit(P, lds, u, tid, wave, lane); } SEAM(5);
    if (IN(6)) for (int rep = 0; rep < 1 + ((DUP_MASK >> 6) & 1); ++rep) {
        __syncthreads();
        pg8::Gemm g{(const bf16_t*)(ws + WS_A2), (const bf16_t*)(ws + WS_WOUT), M, D, D}; pg8::StaticOrder S; S.init(M, D, (int)gridDim.x, (int)blockIdx.x, WGM_P6);
        EpiResidNorm E{P.x, P.out, MOD + 2048, (const float*)(ws + WS_ATTSS), (float*)(ws + WS_SS2), (unsigned*)(ws + WS_CNT), P.g_norm2, MOD + 4096, MOD + 3072, XN, nullptr, (bf16_t*)(ws + WS_QM)};
        pg8::gemm_phase<EpiResidNorm, pg8::StaticOrder, false, true>(lds, g, S, E);
    } do { if (IN(6) && IN(8)) xcd_barrier(bar); } while (0);
    if (IN(8)) for (int rep = 0; rep < 1 + ((DUP_MASK >> 8) & 1); ++rep) {
        pg8::Gemm g{XN, (const bf16_t*)(ws + WS_WFI), M, 2 * DFF, D}; pg8::StaticOrder S; S.init(M, 2 * DFF, (int)gridDim.x, (int)blockIdx.x, WGM_P8);
        EpiSwiglu E{(bf16_t*)(ws + WS_PROJ)};
        pg8::gemm_phase<EpiSwiglu, pg8::StaticOrder, true, true>(lds, g, S, E);
    } SEAM(8);
    if (IN(9)) {
        pg8::Gemm g{(const bf16_t*)(ws + WS_PROJ), (const bf16_t*)(ws + WS_WFO), M, D, DFF}; pg8::StaticOrder S; S.init(M, D, (int)gridDim.x, (int)blockIdx.x, WGM_P9);
        EpiResidNorm E{nullptr, P.out, MOD + 5120, nullptr, (float*)(ws + WS_SS3), (unsigned*)(ws + WS_CNT) + 1024, P.g_final, nullptr, nullptr, nullptr, (const bf16_t*)(ws + WS_QM), nullptr};
        pg8::gemm_phase<EpiResidNorm, pg8::StaticOrder, false, true>(lds, g, S, E);
    }
#undef IN
#undef SEAM
}

#ifndef MK_LAUNCHES
#define MK_LAUNCHES 1
#endif
extern "C" void kernel_launch(void* const* d_in, const int* in_sizes, int n_in, void* d_out, int out_size, void* d_ws, size_t ws_size, hipStream_t stream) {
    static int ready = 0;
    if (!ready) {
        if (n_in != 17 || out_size != M * D || ws_size < WS_END) { fprintf(stderr, "kernel_launch: unexpected shapes (n_in %d out %d ws %zu)\n", n_in, out_size, ws_size); ready = -1; return; }
        if (hipFuncSetAttribute((const void*)hybrid_fwd, hipFuncAttributeMaxDynamicSharedMemorySize, LDS_BYTES) != hipSuccess) { fprintf(stderr, "kernel_launch: hipFuncSetAttribute failed\n"); ready = -1; return; }
        ready = 1;
    }
    if (ready < 0) return;
    Params p{};
    const float** pp = (const float**)&p;
    for (int i = 0; i < 17; ++i) pp[i] = (const float*)d_in[i];
    p.out = (float*)d_out; p.ws = (unsigned char*)d_ws;
    (void)hipMemsetAsync((unsigned char*)d_ws + WS_BAR, 0, 32768, stream);
#if MK_LAUNCHES == 1
    p.ph_lo = 0; p.ph_hi = NPHASES;
    void* args[] = {&p};
    hipError_t e = hipLaunchCooperativeKernel((const void*)hybrid_fwd, dim3(256), dim3(NTHREADS), args, LDS_BYTES, stream);
    if (e != hipSuccess) fprintf(stderr, "cooperative launch failed: %s\n", hipGetErrorString(e));
#else
    for (int k = 0; k < NPHASES; ++k) { p.ph_lo = k; p.ph_hi = k + 1; void* args[] = {&p};
        hipError_t e = hipLaunchCooperativeKernel((const void*)hybrid_fwd, dim3(256), dim3(NTHREADS), args, LDS_BYTES, stream);
        if (e != hipSuccess) fprintf(stderr, "launch %d failed: %s\n", k, hipGetErrorString(e)); }
#endif
}
```
